# Optimizing an MI355X kernel written in HIP

```python
import jax, jax.numpy as jnp
from jax import lax
import numpy as np

D_MODEL = 2048
BATCH = 2
SEQ = 4096
DEPTH = 1
DEC_BATCH = 32
DEC_SEQ = 1
PAST_LEN = 16384
PAGE_SIZE = 128

N_HEADS = 16
N_KV_HEADS = 2
HEAD_DIM = 64
GROUP = N_HEADS // N_KV_HEADS
ATTN_WIDTH = N_HEADS * HEAD_DIM
KV_WIDTH = N_KV_HEADS * HEAD_DIM
WINDOW = 128
BLOCK = WINDOW
ROPE_THETA = 10000.0
CONV_WIDTH = D_MODEL // 2
CONV_K = 3
D_FF = 5632
PLE_DIM = 256
RMS_EPS = 1e-6
IN_COLS = ATTN_WIDTH + 2 * KV_WIDTH + 3 * CONV_WIDTH + 2 * D_MODEL

kernel_name = "hybrid_swa_sink_shortconv_convffn_step"


def rmsnorm(x, g):
    xf = x.astype(jnp.float32)
    y = xf * lax.rsqrt(jnp.mean(xf * xf, axis=-1, keepdims=True) + RMS_EPS)
    return (y * g.astype(jnp.float32)).astype(x.dtype)


def rope(x, pos):
    half = HEAD_DIM // 2
    inv = ROPE_THETA ** (-jnp.arange(half, dtype=jnp.float32) / half)
    ang = pos.astype(jnp.float32)[:, None] * inv[None, :]
    cos = jnp.cos(ang)[None, :, None, :]
    sin = jnp.sin(ang)[None, :, None, :]
    xf = x.astype(jnp.float32)
    x1, x2 = xf[..., :half], xf[..., half:]
    return jnp.concatenate([x1 * cos - x2 * sin, x2 * cos + x1 * sin], axis=-1).astype(x.dtype)


def causal_dwconv(u, prev, w):
    full = jnp.concatenate([prev.astype(u.dtype), u], axis=1)
    T = u.shape[1]
    out = w[0] * full[:, 0:T]
    for k in range(1, CONV_K):
        out = out + w[k] * full[:, k:k + T]
    return out, full[:, -(CONV_K - 1):]


def sink_attention(q, k, v, mask, sinks):
    scale = HEAD_DIM ** -0.5
    s = jnp.einsum('nbqkgd,nbckd->nbkgqc', q, k).astype(jnp.float32) * scale
    s = jnp.where(mask[None, :, None, None], s, -jnp.inf)
    sink = sinks.astype(jnp.float32).reshape(N_KV_HEADS, GROUP)[None, None, :, :, None, None]
    sink = jnp.broadcast_to(sink, s.shape[:-1] + (1,))
    pr = jax.nn.softmax(jnp.concatenate([s, sink], axis=-1), axis=-1)[..., :-1]
    return jnp.einsum('nbkgqc,nbckd->nbqkgd', pr.astype(v.dtype), v)


def window_attention_prompt(q, k, v, sinks):
    N, T = q.shape[:2]
    nb = T // BLOCK
    qb = q.reshape(N, nb, BLOCK, N_KV_HEADS, GROUP, HEAD_DIM)
    kb = k.reshape(N, nb, BLOCK, N_KV_HEADS, HEAD_DIM)
    vb = v.reshape(N, nb, BLOCK, N_KV_HEADS, HEAD_DIM)

    def with_prev(xb):
        prev = jnp.pad(xb[:, :-1], ((0, 0), (1, 0), (0, 0), (0, 0), (0, 0)))
        return jnp.concatenate([prev, xb], axis=2)

    qi = jnp.arange(BLOCK)[:, None]
    ci = jnp.arange(2 * BLOCK)[None, :]
    rel = BLOCK + qi - ci
    band = (rel >= 0) & (rel < WINDOW)
    blk = jnp.arange(nb)[:, None, None]
    mask = band[None] & ((blk > 0) | (ci >= BLOCK)[None])
    o = sink_attention(qb, with_prev(kb), with_prev(vb), mask, sinks)
    return o.reshape(N, T, ATTN_WIDTH)


def window_attention_sample(q, k, v, buf_k, buf_v, sinks):
    N, T = q.shape[:2]
    kf = jnp.concatenate([buf_k.astype(k.dtype), k], axis=1)
    vf = jnp.concatenate([buf_v.astype(v.dtype), v], axis=1)
    qpos = PAST_LEN + jnp.arange(T)
    kpos = PAST_LEN - WINDOW + jnp.arange(WINDOW + T)
    rel = qpos[:, None] - kpos[None, :]
    mask = ((rel >= 0) & (rel < WINDOW))[None]
    o = sink_attention(q.reshape(N, 1, T, N_KV_HEADS, GROUP, HEAD_DIM), kf[:, None], vf[:, None], mask, sinks)
    return o.reshape(N, T, ATTN_WIDTH), kf[:, -WINDOW:], vf[:, -WINDOW:]


def layer(x, p, pos, prev_k, prev_v, prev_conv, prev_ffn, w, prompt):
    (g_mix_pre, g_mix_post, g_ffn_pre, g_ffn_post, w_in, sinks, conv_w, w_attn_branch,
     w_conv_branch, b_gate, w_o, w_ffn_up, ffn_conv_w, ffn_conv_b, w_ffn_down, w_ple, w_ple_gate) = w
    N, T = x.shape[:2]
    h = rmsnorm(x, g_mix_pre)
    proj = h @ w_in
    splits = [ATTN_WIDTH, ATTN_WIDTH + KV_WIDTH, ATTN_WIDTH + 2 * KV_WIDTH,
              ATTN_WIDTH + 2 * KV_WIDTH + CONV_WIDTH, ATTN_WIDTH + 2 * KV_WIDTH + 2 * CONV_WIDTH,
              ATTN_WIDTH + 2 * KV_WIDTH + 3 * CONV_WIDTH, ATTN_WIDTH + 2 * KV_WIDTH + 3 * CONV_WIDTH + D_MODEL]
    q, k, v, cb, cc, cu, ga, gb = jnp.split(proj, splits, axis=-1)
    q = rope(q.reshape(N, T, N_HEADS, HEAD_DIM), pos)
    k = rope(k.reshape(N, T, N_KV_HEADS, HEAD_DIM), pos)
    v = v.reshape(N, T, N_KV_HEADS, HEAD_DIM)
    if prompt:
        a = window_attention_prompt(q, k, v, sinks)
        new_k, new_v = k[:, -WINDOW:], v[:, -WINDOW:]
        prev_conv = jnp.zeros((N, CONV_K - 1, CONV_WIDTH), x.dtype)
        prev_ffn = jnp.zeros((N, CONV_K - 1, D_FF), x.dtype)
    else:
        a, new_k, new_v = window_attention_sample(q, k, v, prev_k, prev_v, sinks)
    conv_out, new_conv = causal_dwconv(cc * cu, prev_conv, conv_w)
    b_out = cb * conv_out
    branch_a = a @ w_attn_branch
    branch_b = b_out @ w_conv_branch
    merged = jax.nn.sigmoid(ga + b_gate[0]) * branch_a + jax.nn.sigmoid(gb + b_gate[1]) * branch_b
    x = x + rmsnorm(merged @ w_o, g_mix_post)
    h2 = rmsnorm(x, g_ffn_pre)
    up, gt = jnp.split(h2 @ w_ffn_up, 2, axis=-1)
    uc, new_ffn = causal_dwconv(up, prev_ffn, ffn_conv_w)
    f = (jax.nn.gelu(uc + ffn_conv_b, approximate=True) * gt) @ w_ffn_down
    x = x + rmsnorm(f, g_ffn_post)
    x = x + jax.nn.sigmoid(x @ w_ple_gate) * (p @ w_ple)
    return x, new_k, new_v, new_conv, new_ffn


def setup_inputs(seed: int = 0) -> dict:
    key = jax.random.key(seed)
    ks = jax.random.split(key, 26)
    f32 = jnp.float32

    def nrm(k, shape, scale=1.0):
        return jax.random.normal(k, shape, f32) * scale

    def gain(k):
        return 1.0 + 0.05 * jax.random.normal(k, (DEPTH, D_MODEL), f32)

    return {
        "x_prompt": nrm(ks[0], (BATCH, SEQ, D_MODEL)),
        "x_sample": nrm(ks[1], (DEC_BATCH, DEC_SEQ, D_MODEL)),
        "state_attn_k": nrm(ks[2], (DEPTH, DEC_BATCH, WINDOW, N_KV_HEADS, HEAD_DIM)),
        "state_attn_v": nrm(ks[3], (DEPTH, DEC_BATCH, WINDOW, N_KV_HEADS, HEAD_DIM)),
        "state_conv": nrm(ks[4], (DEPTH, DEC_BATCH, CONV_K - 1, CONV_WIDTH)),
        "state_ffn_conv": nrm(ks[5], (DEPTH, DEC_BATCH, CONV_K - 1, D_FF)),
        "p_prompt": nrm(ks[6], (DEPTH, BATCH, SEQ, PLE_DIM)),
        "p_sample": nrm(ks[7], (DEPTH, DEC_BATCH, DEC_SEQ, PLE_DIM)),
        "norm_mix_pre": gain(ks[8]),
        "norm_mix_post": gain(ks[9]),
        "norm_ffn_pre": gain(ks[10]),
        "norm_ffn_post": gain(ks[11]),
        "w_in": nrm(ks[12], (DEPTH, D_MODEL, IN_COLS), D_MODEL ** -0.5),
        "attn_sinks": nrm(ks[13], (DEPTH, N_HEADS), 0.5),
        "conv_w": nrm(ks[14], (DEPTH, CONV_K, CONV_WIDTH), CONV_K ** -0.5),
        "w_attn_branch": nrm(ks[15], (DEPTH, ATTN_WIDTH, D_MODEL), ATTN_WIDTH ** -0.5),
        "w_conv_branch": nrm(ks[16], (DEPTH, CONV_WIDTH, D_MODEL), CONV_WIDTH ** -0.5),
        "b_gate": nrm(ks[17], (DEPTH, 2, D_MODEL), 0.02),
        "w_o": nrm(ks[18], (DEPTH, D_MODEL, D_MODEL), D_MODEL ** -0.5),
        "w_ffn_up": nrm(ks[19], (DEPTH, D_MODEL, 2 * D_FF), D_MODEL ** -0.5),
        "ffn_conv_w": nrm(ks[20], (DEPTH, CONV_K, D_FF), CONV_K ** -0.5),
        "ffn_conv_b": nrm(ks[21], (DEPTH, D_FF), 0.02),
        "w_ffn_down": nrm(ks[22], (DEPTH, D_FF, D_MODEL), D_FF ** -0.5),
        "w_ple": nrm(ks[23], (DEPTH, PLE_DIM, D_MODEL), PLE_DIM ** -0.5),
        "w_ple_gate": nrm(ks[24], (DEPTH, D_MODEL, D_MODEL), D_MODEL ** -0.5),
    }


def reference(x_prompt, x_sample, state_attn_k, state_attn_v, state_conv, state_ffn_conv,
              p_prompt, p_sample, norm_mix_pre, norm_mix_post, norm_ffn_pre, norm_ffn_post,
              w_in, attn_sinks, conv_w, w_attn_branch, w_conv_branch, b_gate, w_o,
              w_ffn_up, ffn_conv_w, ffn_conv_b, w_ffn_down, w_ple, w_ple_gate):
    pos_prompt = jnp.arange(SEQ, dtype=jnp.int32)
    pos_sample = PAST_LEN + jnp.arange(DEC_SEQ, dtype=jnp.int32)
    xp, xs = x_prompt, x_sample
    kp_l, vp_l, cp_l, fp_l = [], [], [], []
    ks_l, vs_l, cs_l, fs_l = [], [], [], []
    for i in range(DEPTH):
        w = (norm_mix_pre[i], norm_mix_post[i], norm_ffn_pre[i], norm_ffn_post[i], w_in[i],
             attn_sinks[i], conv_w[i], w_attn_branch[i], w_conv_branch[i], b_gate[i], w_o[i],
             w_ffn_up[i], ffn_conv_w[i], ffn_conv_b[i], w_ffn_down[i], w_ple[i], w_ple_gate[i])
        xp, kp, vp, cp, fp = layer(xp, p_prompt[i], pos_prompt, None, None, None, None, w, True)
        xs, kss, vss, css, fss = layer(xs, p_sample[i], pos_sample, state_attn_k[i], state_attn_v[i],
                                       state_conv[i], state_ffn_conv[i], w, False)
        kp_l.append(kp); vp_l.append(vp); cp_l.append(cp); fp_l.append(fp)
        ks_l.append(kss); vs_l.append(vss); cs_l.append(css); fs_l.append(fss)
    new_k_p = jnp.stack(kp_l, 0)
    new_v_p = jnp.stack(vp_l, 0)
    new_c_p = jnp.stack(cp_l, 0)
    new_f_p = jnp.stack(fp_l, 0)
    new_k_s = jnp.stack(ks_l, 0)
    new_v_s = jnp.stack(vs_l, 0)
    new_c_s = jnp.stack(cs_l, 0)
    new_f_s = jnp.stack(fs_l, 0)
    return (xp, xs, new_k_p, new_v_p, new_c_p, new_f_p, new_k_s, new_v_s, new_c_s, new_f_s)
```

```cpp
#include <hip/hip_runtime.h>
#include <hip/hip_cooperative_groups.h>
#include <cstdio>
#include <cstdint>
namespace cg = cooperative_groups;


#ifndef MK_N_LAUNCHES
#define MK_N_LAUNCHES 1
#define REPMASK 0x00
#endif

#define LAS __attribute__((address_space(3)))
#define GAS __attribute__((address_space(1)))
typedef unsigned short bf16_t;
typedef short bf16x8 __attribute__((ext_vector_type(8)));
typedef float f32x4 __attribute__((ext_vector_type(4)));
typedef float f32x16 __attribute__((ext_vector_type(16)));
typedef unsigned u32x4 __attribute__((ext_vector_type(4)));
typedef unsigned u32x2 __attribute__((ext_vector_type(2)));

constexpr int DM = 2048, SEQ = 4096, MP = 8192, MS = 32, MT = MP + MS;
constexpr int DFF = 5632, INC = 8448, CW = 1024, PLE = 256;
constexpr int P1C = 4352;
constexpr int C_K = 1024, C_V = 1152, C_CB = 1280, C_CC = 2304, C_CU = 3328;
constexpr float EPS = 1e-6f;
constexpr size_t O_YP = 0, O_YS = 16777216, O_KP = 16842752, O_VP = 16875520, O_CP = 16908288, O_FP = 16912384,
                 O_KS = 16934912, O_VS = 17459200, O_CS = 17983488, O_FS = 18049024;
constexpr size_t MiB = 1u << 20;
constexpr size_t WS_ROPE = 1 * MiB;
constexpr size_t WS_WIN = 4 * MiB, WS_WM = 37 * MiB, WS_WO = 45 * MiB, WS_WUP = 53 * MiB, WS_WDN = 97 * MiB, WS_WG = 119 * MiB, WS_WP = 127 * MiB;
constexpr size_t WS_H = 128 * MiB;
constexpr size_t WS_R = 161 * MiB;
constexpr size_t WS_PROJ1 = WS_R, WS_PROJ2 = 230 * MiB, WS_AB = 295 * MiB;
constexpr size_t WS_MERGED = WS_R, WS_MO = 230 * MiB;
constexpr size_t WS_SA = 4 * MiB;
constexpr size_t WS_SG = 10 * MiB;
constexpr size_t WS_UAS = 13 * MiB, WS_UGS = 13 * MiB + 512 * 1024;
constexpr size_t WS_PP = 16 * MiB;
constexpr size_t WS_FIN = WS_R;
constexpr size_t WS_F = 250 * MiB;
constexpr size_t WS_X1B = 295 * MiB;
constexpr size_t WS_PB = 340 * MiB;
constexpr size_t WS_END = 345 * MiB;
constexpr int LDS_BYTES = 147456;
constexpr int NPHASE = 11;

struct Args { const float* in[25]; float* out; unsigned char* ws; int ph_lo, ph_hi; };

__device__ __forceinline__ unsigned cvt_pk_bf16(float lo, float hi) { unsigned r; asm("v_cvt_pk_bf16_f32 %0, %1, %2" : "=v"(r) : "v"(lo), "v"(hi)); return r; }
__device__ __forceinline__ float bflo(unsigned w) { return __uint_as_float(w << 16); }
__device__ __forceinline__ float bfhi(unsigned w) { return __uint_as_float(w & 0xffff0000u); }
__device__ __forceinline__ float bf1(bf16_t b) { return __uint_as_float(((unsigned)b) << 16); }
__device__ __forceinline__ void unpack8(u32x4 w, float* f) { f[0] = bflo(w.x); f[1] = bfhi(w.x); f[2] = bflo(w.y); f[3] = bfhi(w.y); f[4] = bflo(w.z); f[5] = bfhi(w.z); f[6] = bflo(w.w); f[7] = bfhi(w.w); }
__device__ __forceinline__ u32x4 pack8(f32x4 lo, f32x4 hi) { u32x4 w; w.x = cvt_pk_bf16(lo[0], lo[1]); w.y = cvt_pk_bf16(lo[2], lo[3]); w.z = cvt_pk_bf16(hi[0], hi[1]); w.w = cvt_pk_bf16(hi[2], hi[3]); return w; }
__device__ __forceinline__ u32x4 pack8a(const float* f) { u32x4 w; w.x = cvt_pk_bf16(f[0], f[1]); w.y = cvt_pk_bf16(f[2], f[3]); w.z = cvt_pk_bf16(f[4], f[5]); w.w = cvt_pk_bf16(f[6], f[7]); return w; }
__device__ __forceinline__ int fresh_lane() { int l; asm volatile("v_mbcnt_lo_u32_b32 %0, -1, 0\n\tv_mbcnt_hi_u32_b32 %0, -1, %0" : "=v"(l)); return l; }
__device__ __forceinline__ float wave_sum(float v) {
#pragma unroll
    for (int o = 1; o < 64; o <<= 1) v += __shfl_xor(v, o);
    return v;
}
__device__ __forceinline__ float wave_max(float v) {
#pragma unroll
    for (int o = 1; o < 64; o <<= 1) v = fmaxf(v, __shfl_xor(v, o));
    return v;
}
__device__ __forceinline__ float rcpf_(float x) { return __builtin_amdgcn_rcpf(x); }
__device__ __forceinline__ float sigm(float x) { return rcpf_(1.f + __expf(-x)); }
__device__ __forceinline__ float gelu_tanh(float x) { const float u = 0.7978845608028654f * (x + 0.044715f * x * x * x); return x * rcpf_(1.f + __expf(-2.f * u)); }
__device__ __forceinline__ const GAS float* x_row(const Args& a, int row) {
    return row < MP ? (const GAS float*)a.in[0] + (size_t)row * DM : (const GAS float*)a.in[1] + (size_t)(row - MP) * DM;
}

__device__ __forceinline__ void load_gates(const Args& a, int row, int col0, float* ea, float* eb) {
    const GAS bf16_t* p2 = (const GAS bf16_t*)(a.ws + WS_PROJ2) + (size_t)row * 4096 + col0;
    const u32x4 wa = *(const GAS u32x4*)p2, wb = *(const GAS u32x4*)(p2 + 2048);
    const GAS float* bg = (const GAS float*)a.in[17] + col0;
    const f32x4 b0l = *(const GAS f32x4*)bg, b0h = *(const GAS f32x4*)(bg + 4), b1l = *(const GAS f32x4*)(bg + 2048), b1h = *(const GAS f32x4*)(bg + 2052);
    float ga[8], gb[8]; unpack8(wa, ga); unpack8(wb, gb);
#pragma unroll
    for (int e = 0; e < 4; ++e) {
        ea[e] = fminf(__expf(-(ga[e] + b0l[e])), 1e30f); ea[e + 4] = fminf(__expf(-(ga[e + 4] + b0h[e])), 1e30f);
        eb[e] = fminf(__expf(-(gb[e] + b1l[e])), 1e30f); eb[e + 4] = fminf(__expf(-(gb[e + 4] + b1h[e])), 1e30f);
    }
}

template <int MODE>
__device__ __forceinline__ void epi8(const Args& a, int row, int col0, f32x4 lo, f32x4 hi) {
    unsigned char* ws = a.ws;
    if constexpr (MODE == 1) {
        GAS bf16_t* p = col0 < P1C ? (GAS bf16_t*)(ws + WS_PROJ1) + (size_t)row * P1C + col0 : (GAS bf16_t*)(ws + WS_PROJ2) + (size_t)row * 4096 + (col0 - P1C);
        *(GAS u32x4*)p = pack8(lo, hi);
    } else if constexpr (MODE == 3) {
        float ea[8], eb[8]; load_gates(a, row, col0, ea, eb);
#pragma unroll
        for (int e = 0; e < 4; ++e) { lo[e] = lo[e] * rcpf_(1.f + eb[e]); hi[e] = hi[e] * rcpf_(1.f + eb[e + 4]); }
        *(GAS u32x4*)((GAS bf16_t*)(ws + WS_MERGED) + (size_t)row * DM + col0) = pack8(lo, hi);
    } else if constexpr (MODE == 30) {
        *(GAS u32x4*)((GAS bf16_t*)(ws + WS_MERGED) + (size_t)row * DM + col0) = pack8(lo, hi);
    } else if constexpr (MODE == 4) {
        *(GAS u32x4*)((GAS bf16_t*)(ws + WS_MO) + (size_t)row * DM + col0) = pack8(lo, hi);
    } else if constexpr (MODE == 6) {
        const int ch = (col0 >> 8) * 128 + (col0 & 127);
        if (((col0 >> 7) & 1) == 0) {
            *(GAS u32x4*)((GAS bf16_t*)(ws + WS_UAS) + (size_t)(row - MP) * DFF + ch) = pack8(lo, hi);
            GAS float* o = (GAS float*)a.out + O_FS + (size_t)((row - MP) * 2 + 1) * DFF + ch; *(GAS f32x4*)o = lo; *(GAS f32x4*)(o + 4) = hi;
        } else {
            *(GAS u32x4*)((GAS bf16_t*)(ws + WS_UGS) + (size_t)(row - MP) * DFF + ch) = pack8(lo, hi);
        }
    } else if constexpr (MODE == 8) {
        *(GAS u32x4*)((GAS bf16_t*)(ws + WS_F) + (size_t)row * DM + col0) = pack8(lo, hi);
    } else if constexpr (MODE == 9) {
        *(GAS u32x4*)((GAS bf16_t*)(ws + WS_PP) + (size_t)row * DM + col0) = pack8(lo, hi);
    } else if constexpr (MODE == 10) {
        GAS float* o = (GAS float*)a.out + (size_t)row * DM + col0;
        const u32x4 xw = *(const GAS u32x4*)((const GAS bf16_t*)(ws + WS_H) + (size_t)row * DM + col0);
        const u32x4 pw = *(const GAS u32x4*)((const GAS bf16_t*)(ws + WS_PP) + (size_t)row * DM + col0);
        float pp[8], xx[8]; unpack8(pw, pp); unpack8(xw, xx); f32x4 y0, y1;
#pragma unroll
        for (int e = 0; e < 4; ++e) { y0[e] = xx[e] + sigm(lo[e]) * pp[e]; y1[e] = xx[e + 4] + sigm(hi[e]) * pp[e + 4]; }
        *(GAS f32x4*)o = y0; *(GAS f32x4*)(o + 4) = y1;
    }
}

__device__ __forceinline__ void glds_s(const char* sbase, unsigned voff, unsigned lds_dst) {
    unsigned keep;
    asm volatile("s_mov_b32 %0, m0\n\ts_mov_b32 m0, %3\n\ts_nop 0\n\tglobal_load_lds_dwordx4 %1, %2\n\ts_mov_b32 m0, %0" : "=&s"(keep) : "v"(voff), "s"(sbase), "s"(lds_dst) : "memory");
}
namespace pg8 {
constexpr int BM = 256, BK = 64, HALF = 128, HTB = HALF * BK * 2, STAGE_BYTES = 8 * HTB, NXCD = 8, WGM = 8;
__host__ __device__ __forceinline__ int lds_byte(int r, int c) { const int st = (r >> 4) * 2 + (c >> 5), rr = r & 15, cc = c & 31, ob = rr * 64 + cc * 2; return st * 1024 + (ob ^ (((ob >> 9) & 1) << 5)); }
__host__ __device__ __forceinline__ void stage_rc(int b, int& R, int& C) { const int st = b / 1024, sb = b % 1024, swz = sb ^ (((sb >> 9) & 1) << 5); R = (st >> 1) * 16 + swz / 64; C = (st & 1) * 32 + (swz % 64) / 2; }
__host__ __device__ __forceinline__ int perm32(int rho) { const int n = rho >> 4, i = rho & 15; return 8 * (i >> 2) + 4 * n + (i & 3); }
struct Unit { int pm, pn; };
struct StaticOrder {
    int nM, nN, nwg, G, c;
    __device__ void init(int M, int N, int G_, int c_) { nM = M / BM; nN = N / BM; nwg = nM * nN; G = G_; c = c_; }
    __device__ bool next(int i, Unit& u) const {
        const long L = (long)i * G + c; if (L >= nwg) return false;
        int wgid = (int)L; { const int q = nwg / NXCD, r = nwg % NXCD, xcd = wgid % NXCD, off = wgid / NXCD; wgid = (xcd < r ? xcd * (q + 1) : r * (q + 1) + (xcd - r) * q) + off; }
        const int nig = WGM * nN, gid = wgid / nig, fm = gid * WGM, gsz = (nM - fm) < WGM ? (nM - fm) : WGM;
        u.pm = fm + ((wgid % nig) % gsz); u.pn = (wgid % nig) / gsz; return true;
    }
};

template <int MODE>
__device__ __forceinline__ void tile_epi(const Args& a, const f32x4 (&acc)[2][2][4][2], const Unit& u, int wr, int wc, int fr, int fq) {
#pragma unroll
    for (int ai = 0; ai < 2; ++ai)
#pragma unroll
        for (int m = 0; m < 4; ++m)
#pragma unroll
            for (int bj = 0; bj < 2; ++bj)
                epi8<MODE>(a, u.pm * BM + ai * HALF + wr * 64 + m * 16 + fr, u.pn * BM + bj * HALF + wc * 32 + 8 * fq, acc[ai][bj][m][0], acc[ai][bj][m][1]);
}
template <int CTRL> __device__ __forceinline__ float dppf(float old, float src) {
    return __int_as_float(__builtin_amdgcn_update_dpp(__float_as_int(old), __float_as_int(src), CTRL, 0xf, 0xf, false));
}
__device__ __forceinline__ void tile_epi6(const Args& a, const f32x4 (&acc)[2][2][4][2], const Unit& u, int wr, int wc, int fr, int fq) {
    const int ch0 = u.pn * 128 + wc * 32 + 8 * fq;
    const GAS float* cw = (const GAS float*)a.in[20] + ch0; const GAS float* cbp = (const GAS float*)a.in[21] + ch0;
    float w0[8], w1[8], w2[8], bb[8];
    { const f32x4 a0 = *(const GAS f32x4*)cw, a1 = *(const GAS f32x4*)(cw + 4), b0 = *(const GAS f32x4*)(cw + DFF), b1 = *(const GAS f32x4*)(cw + DFF + 4), c0v = *(const GAS f32x4*)(cw + 2 * DFF), c1v = *(const GAS f32x4*)(cw + 2 * DFF + 4),
                  d0 = *(const GAS f32x4*)cbp, d1 = *(const GAS f32x4*)(cbp + 4);
#pragma unroll
      for (int e = 0; e < 4; ++e) { w0[e] = a0[e]; w0[e + 4] = a1[e]; w1[e] = b0[e]; w1[e + 4] = b1[e]; w2[e] = c0v[e]; w2[e + 4] = c1v[e]; bb[e] = d0[e]; bb[e + 4] = d1[e]; } }
    GAS bf16_t* FIN = (GAS bf16_t*)(a.ws + WS_FIN); GAS bf16_t* SA = (GAS bf16_t*)(a.ws + WS_SA); GAS bf16_t* SG = (GAS bf16_t*)(a.ws + WS_SG);
#pragma unroll
    for (int ai = 0; ai < 2; ++ai)
#pragma unroll
        for (int m = 0; m < 4; ++m) {
            const int row = u.pm * BM + ai * HALF + wr * 64 + m * 16 + fr, grp = row >> 6;
            float ov[8];
#pragma unroll
            for (int n = 0; n < 2; ++n)
#pragma unroll
                for (int e = 0; e < 4; ++e) {
                    const float cur = acc[ai][0][m][n][e];
                    float r1 = 0.f, r2 = 0.f;
                    if (m > 0) { const float pv = acc[ai][0][m > 0 ? m - 1 : 0][n][e]; r1 = dppf<0x121>(0.f, pv); r2 = dppf<0x122>(0.f, pv); }
                    const float p1 = dppf<0x111>(r1, cur), p2 = dppf<0x112>(r2, cur);
                    const int k = 4 * n + e;
                    ov[k] = gelu_tanh(w0[k] * p2 + w1[k] * p1 + w2[k] * cur + bb[k]) * acc[ai][1][m][n][e];
                }
            if (m == 0 && fr < 2) {
                *(GAS u32x4*)(SA + ((size_t)grp * 4 + 2 + fr) * DFF + ch0) = pack8(acc[ai][0][m][0], acc[ai][0][m][1]);
                *(GAS u32x4*)(SG + ((size_t)grp * 2 + fr) * DFF + ch0) = pack8(acc[ai][1][m][0], acc[ai][1][m][1]);
            } else {
                *(GAS u32x4*)(FIN + (size_t)row * DFF + ch0) = pack8a(ov);
            }
            if (m == 3 && fr >= 14) {
                *(GAS u32x4*)(SA + ((size_t)grp * 4 + (fr - 14)) * DFF + ch0) = pack8(acc[ai][0][m][0], acc[ai][0][m][1]);
                const int t = row & (SEQ - 1);
                if (t >= SEQ - 2) { GAS float* o = (GAS float*)a.out + O_FP + (size_t)((row >> 12) * 2 + (t - (SEQ - 2))) * DFF + ch0; *(GAS f32x4*)o = acc[ai][0][m][0]; *(GAS f32x4*)(o + 4) = acc[ai][0][m][1]; }
            }
        }
}
__device__ __forceinline__ void mid_scale(const Args& a, f32x4 (&acc)[2][2][4][2], const Unit& u, int wr, int wc, int fr, int fq) {
    int z = 0; asm volatile("" : "+v"(z));
    fr += z;
#pragma unroll
    for (int ai = 0; ai < 2; ++ai)
#pragma unroll
        for (int m = 0; m < 4; ++m)
#pragma unroll
            for (int bj = 0; bj < 2; ++bj) {
                float ea[8], eb[8]; load_gates(a, u.pm * BM + ai * HALF + wr * 64 + m * 16 + fr, u.pn * BM + bj * HALF + wc * 32 + 8 * fq, ea, eb);
#pragma unroll
                for (int e = 0; e < 4; ++e) { acc[ai][bj][m][0][e] *= (1.f + eb[e]) * rcpf_(1.f + ea[e]); acc[ai][bj][m][1][e] *= (1.f + eb[e + 4]) * rcpf_(1.f + ea[e + 4]); }
                __builtin_amdgcn_sched_barrier(0);
            }
}

template <int MODE, int N, int K>
__device__ __forceinline__ void gemm_phase(LAS unsigned char* lds, const Args& args, const bf16_t* gA, const bf16_t* gBt, int G, int bid, int wid_in) {
    const int wid = wid_in, lane = fresh_lane(), tid = wid * 64 + lane, wr = wid >> 2, wc = wid & 3, fr = lane & 15, fq = lane >> 4;
    const int nt = K / BK;
    StaticOrder S; S.init(MP, N, G, bid);
    unsigned voffA, voffB;
    { int R, C; stage_rc(tid * 16, R, C); const int Rb = (R & ~31) + perm32(R & 31); voffA = (unsigned)(R * K + C) * 2u; voffB = (unsigned)(Rb * K + C) * 2u; }
    const unsigned ldsbase = (unsigned)(size_t)lds;
    const size_t kstep = (size_t)(BK * 2);
    const size_t hstep = (size_t)HALF * K * 2;
    const size_t tstep = 2 * hstep;
    const unsigned ldsw = (unsigned)wid * 1024u;
    const int aoff = lds_byte(wr * 64 + fr, fq * 8), boff = lds_byte(wc * 32 + fr, fq * 8);
#define PG8_SA(b, h) (((b) * 2 + (h)) * HTB)
#define PG8_SB(b, h) ((4 + (b) * 2 + (h)) * HTB)
#define PG8_STAGE(bufoff, gbase, voff) do { glds_s((const char*)(gbase), (voff), ldsbase + (unsigned)(bufoff) + ldsw); \
        glds_s((const char*)(gbase) + (size_t)64 * K * 2, (voff), ldsbase + (unsigned)(bufoff) + ldsw + 8192u); } while (0)
#define PG8_LDA(dst, b, h) do { _Pragma("unroll") for (int m = 0; m < 4; ++m) _Pragma("unroll") for (int k = 0; k < 2; ++k) dst[m][k] = *(const LAS bf16x8*)(lds + PG8_SA(b, h) + aoff + m * 2048 + k * 1024); } while (0)
#define PG8_LDB(dst, b, h) do { _Pragma("unroll") for (int n = 0; n < 2; ++n) _Pragma("unroll") for (int k = 0; k < 2; ++k) dst[n][k] = *(const LAS bf16x8*)(lds + PG8_SB(b, h) + boff + n * 2048 + k * 1024); } while (0)
#define PG8_MMA(ai, bj, At, Bt) do { __builtin_amdgcn_s_setprio(1); _Pragma("unroll") for (int m = 0; m < 4; ++m) _Pragma("unroll") for (int n = 0; n < 2; ++n) _Pragma("unroll") for (int k = 0; k < 2; ++k) \
        acc[ai][bj][m][n] = __builtin_amdgcn_mfma_f32_16x16x32_bf16(Bt[n][k], At[m][k], acc[ai][bj][m][n], 0, 0, 0); __builtin_amdgcn_s_setprio(0); } while (0)
#define PG8_WAIT_V(n) asm volatile("s_waitcnt vmcnt(" #n ")" ::: "memory")
#define PG8_WAIT_L(n) asm volatile("s_waitcnt lgkmcnt(" #n ")" ::: "memory")
#define PG8_BAR __builtin_amdgcn_s_barrier()
#define PG8_SCHED __builtin_amdgcn_sched_barrier(0)
    Unit cur, nxt; int ui = 0;
    if (!S.next(0, cur)) return;
    f32x4 acc[2][2][4][2];
#pragma unroll
    for (int a = 0; a < 2; ++a)
#pragma unroll
        for (int b = 0; b < 2; ++b)
#pragma unroll
            for (int m = 0; m < 4; ++m)
#pragma unroll
                for (int n = 0; n < 2; ++n) acc[a][b][m][n] = (f32x4){0.f, 0.f, 0.f, 0.f};
    bf16x8 At[4][2], B0[2][2], B1[2][2];
    const char* cA = (const char*)gA + (size_t)cur.pm * tstep; const char* cB = (const char*)gBt + (size_t)cur.pn * tstep;
    PG8_STAGE(PG8_SB(0, 0), cB, voffB); PG8_STAGE(PG8_SB(0, 1), cB + hstep, voffB); PG8_STAGE(PG8_SA(0, 0), cA, voffA); PG8_STAGE(PG8_SA(0, 1), cA + hstep, voffA);
    if (wr == 1) PG8_BAR;
    PG8_WAIT_V(2); PG8_BAR;
    PG8_STAGE(PG8_SB(1, 0), cB + kstep, voffB); PG8_STAGE(PG8_SA(1, 0), cA + kstep, voffA); PG8_STAGE(PG8_SB(1, 1), cB + hstep + kstep, voffB);
    PG8_WAIT_V(6); PG8_BAR;
    for (;;) {
        const bool has_next = S.next(ui + 1, nxt);
        const char* nA = has_next ? (const char*)gA + (size_t)nxt.pm * tstep : cA; const char* nB = has_next ? (const char*)gBt + (size_t)nxt.pn * tstep : cB;
        for (int t = 0; t < nt; t += 2) {
            const bool last = (t == nt - 2);
            const char* a1 = cA + (size_t)(t + 1) * kstep;
            const char* a2 = last ? nA : cA + (size_t)(t + 2) * kstep; const char* b2 = last ? nB : cB + (size_t)(t + 2) * kstep;
            const char* a3 = a2 + kstep; const char* b3 = b2 + kstep;
            if constexpr (MODE == 3) { if (t == (nt >> 1)) { mid_scale(args, acc, cur, wr, wc, fr, fq); PG8_SCHED; } }
            PG8_LDB(B0, 0, 0); PG8_LDB(B1, 0, 1); PG8_SCHED; PG8_LDA(At, 0, 0); PG8_STAGE(PG8_SA(1, 1), a1 + hstep, voffA);
            PG8_WAIT_V(8); PG8_WAIT_L(0); PG8_BAR; PG8_MMA(0, 0, At, B0); PG8_MMA(0, 1, At, B1); PG8_BAR; PG8_SCHED;
            PG8_LDA(At, 0, 1); PG8_STAGE(PG8_SB(0, 0), b2, voffB); PG8_STAGE(PG8_SB(0, 1), b2 + hstep, voffB); PG8_STAGE(PG8_SA(0, 0), a2, voffA);
            PG8_WAIT_V(8); PG8_WAIT_L(0); PG8_BAR; PG8_MMA(1, 0, At, B0); PG8_MMA(1, 1, At, B1); PG8_BAR; PG8_SCHED;
            PG8_LDB(B0, 1, 0); PG8_LDB(B1, 1, 1); PG8_SCHED; PG8_LDA(At, 1, 0); PG8_STAGE(PG8_SA(0, 1), a2 + hstep, voffA);
            PG8_WAIT_V(8); PG8_WAIT_L(0); PG8_BAR; PG8_MMA(0, 0, At, B0); PG8_MMA(0, 1, At, B1); PG8_BAR; PG8_SCHED;
            PG8_LDA(At, 1, 1); PG8_STAGE(PG8_SB(1, 0), b3, voffB); PG8_STAGE(PG8_SB(1, 1), b3 + hstep, voffB); PG8_STAGE(PG8_SA(1, 0), a3, voffA);
            PG8_WAIT_V(8); PG8_WAIT_L(0); PG8_BAR; PG8_MMA(1, 0, At, B0); PG8_MMA(1, 1, At, B1); PG8_BAR; PG8_SCHED;
        }
        if (wr == 0) PG8_BAR;
        if constexpr (MODE == 6) tile_epi6(args, acc, cur, wr, wc, fr, fq); else tile_epi<MODE>(args, acc, cur, wr, wc, fr, fq);
        if (!has_next) break;
#pragma unroll
        for (int a = 0; a < 2; ++a)
#pragma unroll
            for (int b = 0; b < 2; ++b)
#pragma unroll
                for (int m = 0; m < 4; ++m)
#pragma unroll
                    for (int n = 0; n < 2; ++n) acc[a][b][m][n] = (f32x4){0.f, 0.f, 0.f, 0.f};
        cur = nxt; cA = nA; cB = nB; ++ui;
        if (wr == 1) PG8_BAR;
    }
    PG8_WAIT_V(0);
    PG8_BAR;
#undef PG8_SA
#undef PG8_SB
#undef PG8_STAGE
#undef PG8_LDA
#undef PG8_LDB
#undef PG8_MMA
#undef PG8_WAIT_V
#undef PG8_WAIT_L
#undef PG8_BAR
#undef PG8_SCHED
}
}

template <int MODE, int N, int K>
__device__ __forceinline__ void skinny_gemm(LAS unsigned char* lds, const Args& args, const bf16_t* A, const bf16_t* Bt, int G, int bid, int wid_in) {
    const int wid = wid_in, lane = fresh_lane(), tid = wid * 64 + lane, fr = lane & 15, fq = lane >> 4;
    LAS float* P = (LAS float*)lds;
    constexpr int nitems = N / 16, kw = K / 8, NS = kw / 32;
    constexpr int GRP = (NS % 11 == 0) ? 11 : ((NS % 8 == 0) ? 8 : NS);
    static_assert(kw % 32 == 0 && NS % GRP == 0, "skinny K split");
    for (int it = G - 1 - bid; it < nitems; it += G) {
        const int n0 = it * 16;
        const GAS bf16_t* ap = (const GAS bf16_t*)A + (size_t)fr * K + wid * kw + 8 * fq;
        const GAS bf16_t* bp = (const GAS bf16_t*)Bt + (size_t)(n0 + fr) * K + wid * kw + 8 * fq;
        f32x4 acc0 = {0.f, 0.f, 0.f, 0.f}, acc1 = acc0;
#pragma unroll 1
        for (int g = 0; g < NS; g += GRP) {
            bf16x8 a0[GRP], a1[GRP], bv[GRP];
#pragma unroll
            for (int i = 0; i < GRP; ++i) { const int k = (g + i) * 32; a0[i] = *(const GAS bf16x8*)(ap + k); a1[i] = *(const GAS bf16x8*)(ap + (size_t)16 * K + k); bv[i] = *(const GAS bf16x8*)(bp + k); }
#pragma unroll
            for (int i = 0; i < GRP; ++i) { acc0 = __builtin_amdgcn_mfma_f32_16x16x32_bf16(a0[i], bv[i], acc0, 0, 0, 0); acc1 = __builtin_amdgcn_mfma_f32_16x16x32_bf16(a1[i], bv[i], acc1, 0, 0, 0); }
        }
#pragma unroll
        for (int j = 0; j < 4; ++j) { P[(wid * 32 + 4 * fq + j) * 17 + fr] = acc0[j]; P[(wid * 32 + 16 + 4 * fq + j) * 17 + fr] = acc1[j]; }
        __syncthreads();
        if (tid < 64) {
            const int r = tid >> 1, c0 = (tid & 1) * 8;
            f32x4 l0 = {0.f, 0.f, 0.f, 0.f}, h0 = l0, l1 = l0, h1 = l0;
#pragma unroll
            for (int w = 0; w < 4; ++w)
#pragma unroll
                for (int e = 0; e < 4; ++e) {
                    l0[e] += P[(w * 32 + r) * 17 + c0 + e]; h0[e] += P[(w * 32 + r) * 17 + c0 + 4 + e];
                    l1[e] += P[((w + 4) * 32 + r) * 17 + c0 + e]; h1[e] += P[((w + 4) * 32 + r) * 17 + c0 + 4 + e];
                }
            const int row = MP + r, col0 = n0 + c0;
            if constexpr (MODE == 3) {
                float ea[8], eb[8]; load_gates(args, row, col0, ea, eb); f32x4 lo, hi;
#pragma unroll
                for (int e = 0; e < 4; ++e) { lo[e] = l0[e] * rcpf_(1.f + ea[e]) + l1[e] * rcpf_(1.f + eb[e]); hi[e] = h0[e] * rcpf_(1.f + ea[e + 4]) + h1[e] * rcpf_(1.f + eb[e + 4]); }
                epi8<30>(args, row, col0, lo, hi);
            } else {
                epi8<MODE>(args, row, col0, l0 + l1, h0 + h1);
            }
        }
        __syncthreads();
    }
}

__device__ __forceinline__ void p0_transpose_item(const GAS float* W, int K, int N, GAS bf16_t* WT, int ldt, int k_off, int up_mode, LAS float* scr, int item, int lane) {
    const int nblk = N / 32, kb = item / nblk, nb = item % nblk, k0 = 64 * kb, n0 = 32 * nb;
    int rowbase = n0;
    if (up_mode) rowbase = n0 < DFF ? (n0 >> 7) * 256 + (n0 & 127) : ((n0 - DFF) >> 7) * 256 + 128 + ((n0 - DFF) & 127);
    {
        const int r8 = lane >> 3, c4 = (lane & 7) * 4;
        f32x4 v[8];
#pragma unroll
        for (int i = 0; i < 8; ++i) v[i] = *(const GAS f32x4*)(W + (size_t)(k0 + 8 * i + r8) * N + n0 + c4);
#pragma unroll
        for (int i = 0; i < 8; ++i) { LAS float* d = scr + (8 * i + r8) * 33 + c4; d[0] = v[i].x; d[1] = v[i].y; d[2] = v[i].z; d[3] = v[i].w; }
    }
    asm volatile("s_waitcnt lgkmcnt(0)" ::: "memory");
    const int c = lane & 7;
#pragma unroll
    for (int j = 0; j < 4; ++j) { const int n = (lane >> 3) + 8 * j; const LAS float* s = scr + (8 * c) * 33 + n;
        u32x4 o; o.x = cvt_pk_bf16(s[0 * 33], s[1 * 33]); o.y = cvt_pk_bf16(s[2 * 33], s[3 * 33]); o.z = cvt_pk_bf16(s[4 * 33], s[5 * 33]); o.w = cvt_pk_bf16(s[6 * 33], s[7 * 33]);
        *(GAS u32x4*)(WT + (size_t)(rowbase + n) * ldt + k_off + k0 + 8 * c) = o; }
    asm volatile("s_waitcnt lgkmcnt(0)" ::: "memory");
}

template <int SET>
__device__ __forceinline__ void late_weights(const Args& a, LAS unsigned char* lds, int w0, int nw, int wid_in) {
    const int lane = fresh_lane();
    unsigned char* ws = a.ws;
    LAS float* scr = (LAS float*)(lds + wid_in * 16384);
    constexpr int I_BR = 16 * 64, I_O = 32 * 64, I_UP = 32 * 352, I_DN = 88 * 64, I_G = 32 * 64, I_P = 4 * 64;
    if constexpr (SET == 1) {
        for (int it = w0; it < 2 * I_BR + I_O + I_P + I_UP; it += nw) {
            int r = it;
            if (r < I_BR) { p0_transpose_item((const GAS float*)a.in[15], 1024, 2048, (GAS bf16_t*)(ws + WS_WM), 2048, 0, 0, scr, r, lane); continue; } r -= I_BR;
            if (r < I_BR) { p0_transpose_item((const GAS float*)a.in[16], 1024, 2048, (GAS bf16_t*)(ws + WS_WM), 2048, 1024, 0, scr, r, lane); continue; } r -= I_BR;
            if (r < I_O) { p0_transpose_item((const GAS float*)a.in[18], 2048, 2048, (GAS bf16_t*)(ws + WS_WO), 2048, 0, 0, scr, r, lane); continue; } r -= I_O;
            if (r < I_P) { p0_transpose_item((const GAS float*)a.in[23], PLE, 2048, (GAS bf16_t*)(ws + WS_WP), PLE, 0, 0, scr, r, lane); continue; } r -= I_P;
            p0_transpose_item((const GAS float*)a.in[19], 2048, 2 * DFF, (GAS bf16_t*)(ws + WS_WUP), 2048, 0, 1, scr, r, lane);
        }
    } else {
        for (int it = w0; it < I_DN + I_G; it += nw) {
            int r = it;
            if (r < I_DN) { p0_transpose_item((const GAS float*)a.in[22], DFF, 2048, (GAS bf16_t*)(ws + WS_WDN), DFF, 0, 0, scr, r, lane); continue; } r -= I_DN;
            p0_transpose_item((const GAS float*)a.in[24], 2048, 2048, (GAS bf16_t*)(ws + WS_WG), 2048, 0, 0, scr, r, lane);
        }
    }
}
__device__ __forceinline__ void p0_prologue(const Args& a, LAS unsigned char* lds, int bid, int G, int wid_in) {
    const int wid = wid_in, lane = fresh_lane(), tid = wid * 64 + lane;
    const int gw = bid * 8 + wid, NGW = G * 8, gtid = bid * 512 + tid, GT = G * 512;
    unsigned char* ws = a.ws;
    LAS float* scr = (LAS float*)(lds + wid * 16384);
    constexpr int I_IN = 32 * 264;
    for (int it = gw; it < I_IN; it += NGW) p0_transpose_item((const GAS float*)a.in[12], 2048, INC, (GAS bf16_t*)(ws + WS_WIN), 2048, 0, 0, scr, it, lane);
    if (gw < MT) {
        f32x4 g[8];
        { const GAS f32x4* gp = (const GAS f32x4*)a.in[8] + lane;
#pragma unroll
          for (int j = 0; j < 8; ++j) g[j] = gp[64 * j]; }
        int m = gw; f32x4 v[8];
        { const GAS f32x4* xr = (const GAS f32x4*)x_row(a, m) + lane;
#pragma unroll
          for (int j = 0; j < 8; ++j) v[j] = xr[64 * j]; }
        for (;;) {
            const int mn = m + NGW; const bool has = mn < MT; const int mp = has ? mn : m;
            f32x4 nv[8];
            { const GAS f32x4* xr = (const GAS f32x4*)x_row(a, mp) + lane;
#pragma unroll
              for (int j = 0; j < 8; ++j) nv[j] = xr[64 * j]; }
            float s = 0.f;
#pragma unroll
            for (int j = 0; j < 8; ++j) s += (v[j].x * v[j].x + v[j].y * v[j].y) + (v[j].z * v[j].z + v[j].w * v[j].w);
            const float rstd = 1.f / sqrtf(wave_sum(s) * (1.f / DM) + EPS);
            GAS u32x2* o = (GAS u32x2*)((GAS bf16_t*)(ws + WS_H) + (size_t)m * DM) + lane;
#pragma unroll
            for (int j = 0; j < 8; ++j) { u32x2 w; w.x = cvt_pk_bf16(v[j].x * rstd * g[j].x, v[j].y * rstd * g[j].y); w.y = cvt_pk_bf16(v[j].z * rstd * g[j].z, v[j].w * rstd * g[j].w); o[64 * j] = w; }
            if (!has) break;
#pragma unroll
            for (int j = 0; j < 8; ++j) v[j] = nv[j];
            m = mn;
        }
    }
    for (int i = gtid; i < MT * 32; i += GT) {
        const int row = i >> 5, c8 = (i & 31) * 8;
        const GAS float* src = row < MP ? (const GAS float*)a.in[6] + (size_t)row * PLE + c8 : (const GAS float*)a.in[7] + (size_t)(row - MP) * PLE + c8;
        const f32x4 lo = *(const GAS f32x4*)src, hi = *(const GAS f32x4*)(src + 4);
        *(GAS u32x4*)((GAS bf16_t*)(ws + WS_PB) + (size_t)row * PLE + c8) = pack8(lo, hi);
    }
    for (int i = gtid; i < 4097 * 32; i += GT) {
        const int pi = i >> 5, fi = i & 31; const int pos = pi < 4096 ? pi : 16384;
        double inv = 1.0; for (int k = 0; k < fi; ++k) inv *= 0.7498942093324559;
        const float ang = (float)pos * (float)inv;
        double f = (double)ang * 0.15915494309189535; f -= __builtin_rint(f);
        GAS float* o = (GAS float*)(ws + WS_ROPE) + (size_t)i * 2;
        o[0] = __builtin_amdgcn_cosf((float)f); o[1] = __builtin_amdgcn_sinf((float)f);
    }
    for (int i = gtid; i < MS * CW; i += GT) { const int b = i / CW, c = i % CW; ((GAS float*)a.out)[O_CS + (size_t)(b * 2) * CW + c] = ((const GAS float*)a.in[4])[(size_t)(b * 2 + 1) * CW + c]; }
    for (int i = gtid; i < MS * DFF; i += GT) { const int b = i / DFF, c = i % DFF; ((GAS float*)a.out)[O_FS + (size_t)(b * 2) * DFF + c] = ((const GAS float*)a.in[5])[(size_t)(b * 2 + 1) * DFF + c]; }
}

constexpr int QS = 72, VS = 280;
__device__ __forceinline__ void rope8r(const f32x4* t, const float* x1, const float* x2, float sc, float* o1, float* o2) {
    const float c[8] = {t[0].x, t[0].z, t[1].x, t[1].z, t[2].x, t[2].z, t[3].x, t[3].z}, s[8] = {t[0].y, t[0].w, t[1].y, t[1].w, t[2].y, t[2].w, t[3].y, t[3].w};
#pragma unroll
    for (int e = 0; e < 8; ++e) { o1[e] = (x1[e] * c[e] - x2[e] * s[e]) * sc; o2[e] = (x2[e] * c[e] + x1[e] * s[e]) * sc; }
}
struct AttnRegs { u32x4 q1[4], q2[4], kc1, kc2, kp1, kp2, vv[4]; f32x4 rq[4], rp[4]; };
__device__ __forceinline__ void attn_load(const Args& a, int u, int tid, AttnRegs& R) {
    const int hq = u & 1, kv = (u >> 1) & 1, j = (u >> 2) & 31, n = u >> 7, h0 = kv * 8 + hq * 4;
    const GAS bf16_t* P1 = (const GAS bf16_t*)(a.ws + WS_PROJ1);
    const GAS float* ROPE = (const GAS float*)(a.ws + WS_ROPE);
    const bool hasprev = j > 0;
    const int r = tid >> 2, g = tid & 3, posq = j * 128 + r, posp = hasprev ? posq - 128 : posq;
    const GAS bf16_t* rowq = P1 + (size_t)(n * SEQ + posq) * P1C;
    const GAS bf16_t* rowp = P1 + (size_t)(n * SEQ + posp) * P1C;
#pragma unroll
    for (int i = 0; i < 4; ++i) { R.q1[i] = *(const GAS u32x4*)(rowq + (h0 + i) * 64 + 8 * g); R.q2[i] = *(const GAS u32x4*)(rowq + (h0 + i) * 64 + 32 + 8 * g); }
    R.kc1 = *(const GAS u32x4*)(rowq + C_K + kv * 64 + 8 * g); R.kc2 = *(const GAS u32x4*)(rowq + C_K + kv * 64 + 32 + 8 * g);
    R.kp1 = *(const GAS u32x4*)(rowp + C_K + kv * 64 + 8 * g); R.kp2 = *(const GAS u32x4*)(rowp + C_K + kv * 64 + 32 + 8 * g);
    const GAS f32x4* rq = (const GAS f32x4*)(ROPE + (size_t)(posq * 32 + 8 * g) * 2);
    const GAS f32x4* rp = (const GAS f32x4*)(ROPE + (size_t)(posp * 32 + 8 * g) * 2);
#pragma unroll
    for (int i = 0; i < 4; ++i) { R.rq[i] = rq[i]; R.rp[i] = rp[i]; }
    const int vk = tid >> 3, dg = tid & 7;
#pragma unroll
    for (int ps = 0; ps < 4; ++ps) {
        const int c = ps * 64 + vk; const int pos = (ps < 2) ? (hasprev ? j * 128 - 128 + c : j * 128 + c) : j * 128 - 128 + c;
        R.vv[ps] = *(const GAS u32x4*)(P1 + (size_t)(n * SEQ + pos) * P1C + C_V + kv * 64 + 8 * dg);
    }
}
constexpr int QBUF = 128 * QS;
__device__ __forceinline__ void attn_write_q(LAS bf16_t* Qb, const AttnRegs& R, int i, int tid) {
    const int r = tid >> 2, g = tid & 3;
    float x1[8], x2[8], o1[8], o2[8];
    unpack8(R.q1[i], x1); unpack8(R.q2[i], x2); rope8r(R.rq, x1, x2, 0.125f, o1, o2);
    *(LAS u32x4*)(Qb + r * QS + 8 * g) = pack8a(o1); *(LAS u32x4*)(Qb + r * QS + 32 + 8 * g) = pack8a(o2);
}

__device__ __forceinline__ void attn_prompt_unit(const Args& a, LAS unsigned char* lds, int u, int wid_in) {
    const int wid = wid_in, lane = fresh_lane(), tid = wid * 64 + lane, fr = lane & 15, fq = lane >> 4;
    const int hq = u & 1, kv = (u >> 1) & 1, j = (u >> 2) & 31, n = u >> 7, h0 = kv * 8 + hq * 4;
    LAS bf16_t* Qs0 = (LAS bf16_t*)lds; LAS bf16_t* Ks = Qs0 + 2 * QBUF; LAS bf16_t* Vt = Ks + 256 * QS;
    const bool wr_state = (j == 31) && (hq == 0);
    const bool hasprev = j > 0;
    AttnRegs R; attn_load(a, u, tid, R);
    {
        const int r = tid >> 2, g = tid & 3, vk = tid >> 3, dg = tid & 7;
        float x1[8], x2[8], o1[8], o2[8];
        attn_write_q(Qs0, R, 0, tid);
        unpack8(R.kc1, x1); unpack8(R.kc2, x2); rope8r(R.rq, x1, x2, 1.f, o1, o2);
        if (wr_state) {
            GAS float* o = (GAS float*)a.out + O_KP + ((size_t)(n * 128 + r) * 2 + kv) * 64 + 8 * g;
            *(GAS f32x4*)o = (f32x4){o1[0], o1[1], o1[2], o1[3]}; *(GAS f32x4*)(o + 4) = (f32x4){o1[4], o1[5], o1[6], o1[7]};
            *(GAS f32x4*)(o + 32) = (f32x4){o2[0], o2[1], o2[2], o2[3]}; *(GAS f32x4*)(o + 36) = (f32x4){o2[4], o2[5], o2[6], o2[7]};
        }
        *(LAS u32x4*)(Ks + (128 + r) * QS + 8 * g) = pack8a(o1); *(LAS u32x4*)(Ks + (128 + r) * QS + 32 + 8 * g) = pack8a(o2);
        unpack8(R.kp1, x1); unpack8(R.kp2, x2); rope8r(R.rp, x1, x2, hasprev ? 1.f : 0.f, o1, o2);
        *(LAS u32x4*)(Ks + r * QS + 8 * g) = pack8a(o1); *(LAS u32x4*)(Ks + r * QS + 32 + 8 * g) = pack8a(o2);
#pragma unroll
        for (int ps = 0; ps < 4; ++ps) {
            const int c = ps * 64 + vk;
            u32x4 w = R.vv[ps];
            if (ps < 2 && !hasprev) w = (u32x4){0u, 0u, 0u, 0u};
            const unsigned ww[4] = {w.x, w.y, w.z, w.w};
#pragma unroll
            for (int e = 0; e < 4; ++e) { Vt[(8 * dg + 2 * e) * VS + c] = (bf16_t)(ww[e] & 0xffffu); Vt[(8 * dg + 2 * e + 1) * VS + c] = (bf16_t)(ww[e] >> 16); }
            if (ps >= 2 && wr_state) {
                float v[8]; unpack8(w, v);
                GAS float* o = (GAS float*)a.out + O_VP + ((size_t)(n * 128 + (c - 128)) * 2 + kv) * 64 + 8 * dg;
                *(GAS f32x4*)o = (f32x4){v[0], v[1], v[2], v[3]}; *(GAS f32x4*)(o + 4) = (f32x4){v[4], v[5], v[6], v[7]};
            }
        }
    }
    for (int i = tid; i < 64 * 24; i += 512) Vt[(i / 24) * VS + 256 + (i % 24)] = 0;
    __syncthreads();
#pragma unroll
    for (int hi = 0; hi < 4; ++hi) {
    const int h = h0 + hi;
    LAS bf16_t* Qs = Qs0 + (hi & 1) * QBUF;
    if (hi < 3) attn_write_q(Qs0 + ((hi + 1) & 1) * QBUF, R, hi + 1, tid);
    const bf16x8 bq0 = *(const LAS bf16x8*)(Qs + (16 * wid + fr) * QS + 8 * fq), bq1 = *(const LAS bf16x8*)(Qs + (16 * wid + fr) * QS + 32 + 8 * fq);
    f32x4 s[9], s2[9];
#pragma unroll
    for (int b = 0; b < 9; ++b) {
        const int kb = wid + b;
        const bf16x8 k0 = *(const LAS bf16x8*)(Ks + (16 * kb + fr) * QS + 8 * fq), k1 = *(const LAS bf16x8*)(Ks + (16 * kb + fr) * QS + 32 + 8 * fq);
        const f32x4 z = {0.f, 0.f, 0.f, 0.f};
        s[b] = __builtin_amdgcn_mfma_f32_16x16x32_bf16(k0, bq0, z, 0, 0, 0);
        s2[b] = __builtin_amdgcn_mfma_f32_16x16x32_bf16(k1, bq1, z, 0, 0, 0);
    }
    __builtin_amdgcn_sched_barrier(0);
    asm volatile("s_nop 7\n\ts_nop 7" ::: "memory");
#pragma unroll
    for (int b = 0; b < 9; ++b) { asm volatile("" : "+v"(s[b]), "+v"(s2[b])); s[b] = s[b] + s2[b]; }
    const float sink = ((const GAS float*)a.in[13])[h];
    const int qi = 16 * wid + fr;
    float mx = sink;
#pragma unroll
    for (int b = 0; b < 9; ++b)
#pragma unroll
        for (int e = 0; e < 4; ++e) {
            const int c = 16 * (wid + b) + 4 * fq + e;
            const bool ok = (c > qi) && (c <= qi + 128) && (j > 0 || c >= 128);
            s[b][e] = ok ? s[b][e] : -1e30f;
            mx = fmaxf(mx, s[b][e]);
        }
    mx = fmaxf(mx, __shfl_xor(mx, 16)); mx = fmaxf(mx, __shfl_xor(mx, 32));
    float sum = 0.f;
#pragma unroll
    for (int b = 0; b < 9; ++b)
#pragma unroll
        for (int e = 0; e < 4; ++e) { const float p = s[b][e] > -1e29f ? __expf(s[b][e] - mx) : 0.f; s[b][e] = p; sum += p; }
    sum += __shfl_xor(sum, 16); sum += __shfl_xor(sum, 32);
    const float inv = 1.f / (sum + __expf(sink - mx));
    f32x4 ot[5][4];
#pragma unroll
    for (int pi = 0; pi < 5; ++pi) {
        const int kb0 = wid + 2 * pi, kb1 = kb0 + 1;
        u32x4 pw; pw.x = cvt_pk_bf16(s[2 * pi][0], s[2 * pi][1]); pw.y = cvt_pk_bf16(s[2 * pi][2], s[2 * pi][3]);
        if (pi < 4) { pw.z = cvt_pk_bf16(s[2 * pi + 1 < 9 ? 2 * pi + 1 : 8][0], s[2 * pi + 1 < 9 ? 2 * pi + 1 : 8][1]); pw.w = cvt_pk_bf16(s[2 * pi + 1 < 9 ? 2 * pi + 1 : 8][2], s[2 * pi + 1 < 9 ? 2 * pi + 1 : 8][3]); }
        else { pw.z = 0u; pw.w = 0u; }
        const bf16x8 pb = __builtin_bit_cast(bf16x8, pw);
#pragma unroll
        for (int d = 0; d < 4; ++d) {
            const u32x2 lo = *(const LAS u32x2*)(Vt + (16 * d + fr) * VS + 16 * kb0 + 4 * fq), hi = *(const LAS u32x2*)(Vt + (16 * d + fr) * VS + 16 * kb1 + 4 * fq);
            const u32x4 vw = {lo.x, lo.y, hi.x, hi.y};
            const f32x4 zz = {0.f, 0.f, 0.f, 0.f};
            ot[pi][d] = __builtin_amdgcn_mfma_f32_16x16x32_bf16(__builtin_bit_cast(bf16x8, vw), pb, zz, 0, 0, 0);
        }
    }
    __builtin_amdgcn_sched_barrier(0);
    asm volatile("s_nop 7\n\ts_nop 7" ::: "memory");
    f32x4 o[4];
#pragma unroll
    for (int d = 0; d < 4; ++d) {
#pragma unroll
        for (int pi = 0; pi < 5; ++pi) asm volatile("" : "+v"(ot[pi][d]));
        o[d] = ((ot[0][d] + ot[1][d]) + (ot[2][d] + ot[3][d])) + ot[4][d];
    }
    GAS bf16_t* dst = (GAS bf16_t*)(a.ws + WS_AB) + (size_t)(n * SEQ + j * 128 + qi) * DM + h * 64 + 4 * fq;
#pragma unroll
    for (int d = 0; d < 4; ++d) { u32x2 w; w.x = cvt_pk_bf16(o[d][0] * inv, o[d][1] * inv); w.y = cvt_pk_bf16(o[d][2] * inv, o[d][3] * inv); *(GAS u32x2*)(dst + 16 * d) = w; }
    __syncthreads();
    }
}

__device__ __forceinline__ void attn_sample_unit(const Args& a, LAS unsigned char* lds, int b, int wid_in) {
    const int wid = wid_in, lane = fresh_lane(), tid = wid * 64 + lane;
    LAS float* qf = (LAS float*)lds;
    LAS float* kn = qf + 1024;
    LAS float* vn = kn + 128;
    LAS float* S = vn + 128;
    LAS float* KV = (LAS float*)(lds + 16384);
    constexpr int KS_ = 129;
    const GAS bf16_t* prow = (const GAS bf16_t*)(a.ws + WS_PROJ1) + (size_t)(MP + b) * P1C;
    const GAS float* rp = (const GAS float*)(a.ws + WS_ROPE) + (size_t)4096 * 64;
    const GAS float* sk = (const GAS float*)a.in[2] + (size_t)b * 128 * 128 + 128;
    const GAS float* sv = (const GAS float*)a.in[3] + (size_t)b * 128 * 128 + 128;
    GAS float* ok = (GAS float*)a.out + O_KS + (size_t)b * 16384;
    GAS float* ov = (GAS float*)a.out + O_VS + (size_t)b * 16384;
    f32x4 kreg[8], vreg[8];
#pragma unroll
    for (int q = 0; q < 8; ++q) { const int i4 = tid + 512 * q; const bool ok_ = i4 < 127 * 32; const int j4 = ok_ ? i4 : 0;
        kreg[q] = *(const GAS f32x4*)(sk + (size_t)j4 * 4); vreg[q] = *(const GAS f32x4*)(sv + (size_t)j4 * 4); }
    {
        const int h = tid >> 5, i = tid & 31; const float c = rp[2 * i], s = rp[2 * i + 1];
        const float x1 = bf1(prow[h * 64 + i]), x2 = bf1(prow[h * 64 + 32 + i]);
        qf[h * 64 + i] = (x1 * c - x2 * s) * 0.125f; qf[h * 64 + 32 + i] = (x2 * c + x1 * s) * 0.125f;
        if (tid < 64) { const float y1 = bf1(prow[C_K + h * 64 + i]), y2 = bf1(prow[C_K + h * 64 + 32 + i]); kn[h * 64 + i] = y1 * c - y2 * s; kn[h * 64 + 32 + i] = y2 * c + y1 * s; }
        if (tid < 128) vn[tid] = bf1(prow[C_V + tid]);
    }
#pragma unroll
    for (int q = 0; q < 8; ++q) { const int i4 = tid + 512 * q; if (i4 < 127 * 32) { const int i = i4 >> 5, c4 = (i4 & 31) * 4; LAS float* d = KV + i * KS_ + c4;
        d[0] = kreg[q].x; d[1] = kreg[q].y; d[2] = kreg[q].z; d[3] = kreg[q].w; *(GAS f32x4*)(ok + (size_t)i4 * 4) = kreg[q]; *(GAS f32x4*)(ov + (size_t)i4 * 4) = vreg[q]; } }
    __syncthreads();
    if (tid < 128) { KV[127 * KS_ + tid] = kn[tid]; ok[127 * 128 + tid] = kn[tid]; ov[127 * 128 + tid] = vn[tid]; }
    __syncthreads();
#pragma unroll
    for (int cc = 0; cc < 4; ++cc) {
        const int idx = tid + 512 * cc, h = idx >> 7, i = idx & 127, kv = h >> 3;
        float d = 0.f;
#pragma unroll 16
        for (int e = 0; e < 64; ++e) d += KV[i * KS_ + kv * 64 + e] * qf[h * 64 + e];
        S[h * 128 + i] = d;
    }
    __syncthreads();
#pragma unroll
    for (int hh = 0; hh < 2; ++hh) {
        const int h = wid * 2 + hh; const float sink = ((const GAS float*)a.in[13])[h];
        const float s0 = S[h * 128 + lane], s1 = S[h * 128 + 64 + lane];
        const float mx = fmaxf(wave_max(fmaxf(s0, s1)), sink);
        const float p0 = __expf(s0 - mx), p1 = __expf(s1 - mx);
        const float inv = 1.f / (wave_sum(p0 + p1) + __expf(sink - mx));
        S[h * 128 + lane] = p0 * inv; S[h * 128 + 64 + lane] = p1 * inv;
    }
#pragma unroll
    for (int q = 0; q < 8; ++q) { const int i4 = tid + 512 * q; if (i4 < 127 * 32) { const int i = i4 >> 5, c4 = (i4 & 31) * 4; LAS float* d = KV + i * KS_ + c4;
        d[0] = vreg[q].x; d[1] = vreg[q].y; d[2] = vreg[q].z; d[3] = vreg[q].w; } }
    if (tid < 128) KV[127 * KS_ + tid] = vn[tid];
    __syncthreads();
#pragma unroll
    for (int cc = 0; cc < 2; ++cc) {
        const int idx = tid + 512 * cc, h = idx >> 6, d = idx & 63, kv = h >> 3;
        float acc = 0.f;
#pragma unroll 16
        for (int i = 0; i < 128; ++i) acc += S[h * 128 + i] * KV[i * KS_ + kv * 64 + d];
        ((GAS bf16_t*)(a.ws + WS_AB))[(size_t)(MP + b) * DM + h * 64 + d] = (bf16_t)(cvt_pk_bf16(acc, 0.f) & 0xffffu);
    }
    __syncthreads();
}

__device__ __forceinline__ void convb_item(const Args& a, int item, int lane) {
    const int rb = item >> 1, c0 = (item & 1) * 512 + lane * 8, row0 = rb * 8;
    const GAS bf16_t* P1 = (const GAS bf16_t*)(a.ws + WS_PROJ1);
    const GAS float* cw = (const GAS float*)a.in[14] + c0;
    float w0[8], w1[8], w2[8];
    { const f32x4 a0 = *(const GAS f32x4*)cw, a1 = *(const GAS f32x4*)(cw + 4), b0 = *(const GAS f32x4*)(cw + CW), b1 = *(const GAS f32x4*)(cw + CW + 4), c0v = *(const GAS f32x4*)(cw + 2 * CW), c1v = *(const GAS f32x4*)(cw + 2 * CW + 4);
#pragma unroll
      for (int e = 0; e < 4; ++e) { w0[e] = a0[e]; w0[e + 4] = a1[e]; w1[e] = b0[e]; w1[e + 4] = b1[e]; w2[e] = c0v[e]; w2[e + 4] = c1v[e]; } }
    float p2[8], p1[8];
    const bool prompt = row0 < MP;
    const bool halo = prompt && (row0 & (SEQ - 1)) != 0;
    const int hr = halo ? row0 - 2 : row0;
    const u32x4 hx0 = *(const GAS u32x4*)(P1 + (size_t)hr * P1C + C_CC + c0), hy0 = *(const GAS u32x4*)(P1 + (size_t)hr * P1C + C_CU + c0);
    const u32x4 hx1 = *(const GAS u32x4*)(P1 + (size_t)(hr + 1) * P1C + C_CC + c0), hy1 = *(const GAS u32x4*)(P1 + (size_t)(hr + 1) * P1C + C_CU + c0);
    u32x4 vb[8], vc[8], vu[8];
#pragma unroll
    for (int r = 0; r < 8; ++r) { const GAS bf16_t* pr = P1 + (size_t)(row0 + r) * P1C + c0; vb[r] = *(const GAS u32x4*)(pr + C_CB); vc[r] = *(const GAS u32x4*)(pr + C_CC); vu[r] = *(const GAS u32x4*)(pr + C_CU); }
    { float x[8], y[8]; unpack8(hx0, x); unpack8(hy0, y);
#pragma unroll
      for (int e = 0; e < 8; ++e) p2[e] = halo ? x[e] * y[e] : 0.f;
      unpack8(hx1, x); unpack8(hy1, y);
#pragma unroll
      for (int e = 0; e < 8; ++e) p1[e] = halo ? x[e] * y[e] : 0.f; }
#pragma unroll
    for (int r = 0; r < 8; ++r) {
        const int row = row0 + r;
        if (!prompt) {
            const GAS float* st = (const GAS float*)a.in[4] + (size_t)(row - MP) * 2 * CW + c0;
            const f32x4 s0 = *(const GAS f32x4*)st, s1 = *(const GAS f32x4*)(st + 4), s2 = *(const GAS f32x4*)(st + CW), s3 = *(const GAS f32x4*)(st + CW + 4);
#pragma unroll
            for (int e = 0; e < 4; ++e) { p2[e] = s0[e]; p2[e + 4] = s1[e]; p1[e] = s2[e]; p1[e + 4] = s3[e]; }
        }
        float cb[8], x[8], y[8], cx[8], ov[8];
        unpack8(vb[r], cb); unpack8(vc[r], x); unpack8(vu[r], y);
#pragma unroll
        for (int e = 0; e < 8; ++e) { cx[e] = x[e] * y[e]; ov[e] = cb[e] * (w0[e] * p2[e] + w1[e] * p1[e] + w2[e] * cx[e]); }
        *(GAS u32x4*)((GAS bf16_t*)(a.ws + WS_AB) + (size_t)row * DM + 1024 + c0) = pack8a(ov);
        GAS float* so = nullptr;
        if (prompt) { const int t = row & (SEQ - 1); if (t >= SEQ - 2) so = (GAS float*)a.out + O_CP + (size_t)((row >> 12) * 2 + (t - (SEQ - 2))) * CW + c0; }
        else so = (GAS float*)a.out + O_CS + (size_t)((row - MP) * 2 + 1) * CW + c0;
        if (so) { *(GAS f32x4*)so = (f32x4){cx[0], cx[1], cx[2], cx[3]}; *(GAS f32x4*)(so + 4) = (f32x4){cx[4], cx[5], cx[6], cx[7]}; }
#pragma unroll
        for (int e = 0; e < 8; ++e) { p2[e] = p1[e]; p1[e] = cx[e]; }
    }
}

template <bool FIRST>
__device__ __forceinline__ void resnorm_rows(const Args& a, int gw, int NGW, int lane) {
    f32x4 g1[8], g2[8];
    { const GAS f32x4* p1 = (const GAS f32x4*)a.in[FIRST ? 9 : 11] + lane; const GAS f32x4* p2 = (const GAS f32x4*)a.in[10] + lane;
#pragma unroll
      for (int j = 0; j < 8; ++j) { g1[j] = p1[64 * j]; g2[j] = FIRST ? p2[64 * j] : (f32x4){0.f, 0.f, 0.f, 0.f}; } }
    int m = gw; if (m >= MT) return;
    const GAS bf16_t* SRC = (const GAS bf16_t*)(a.ws + (FIRST ? WS_MO : WS_F));
    const GAS bf16_t* X1B = (const GAS bf16_t*)(a.ws + WS_X1B);
    f32x4 v[8], x[8];
    { const GAS u32x2* sr = (const GAS u32x2*)(SRC + (size_t)m * DM) + lane;
#pragma unroll
      for (int j = 0; j < 8; ++j) { const u32x2 w = sr[64 * j]; v[j] = (f32x4){bflo(w.x), bfhi(w.x), bflo(w.y), bfhi(w.y)}; }
      if (FIRST) { const GAS f32x4* xr = (const GAS f32x4*)x_row(a, m) + lane;
#pragma unroll
        for (int j = 0; j < 8; ++j) x[j] = xr[64 * j]; }
      else { const GAS u32x2* xr = (const GAS u32x2*)(X1B + (size_t)m * DM) + lane;
#pragma unroll
        for (int j = 0; j < 8; ++j) { const u32x2 w = xr[64 * j]; x[j] = (f32x4){bflo(w.x), bfhi(w.x), bflo(w.y), bfhi(w.y)}; } } }
    for (;;) {
        const int mn = m + NGW; const bool has = mn < MT; const int mp = has ? mn : m;
        u32x2 nw[8]; f32x4 nx[8]; u32x2 nxb[8];
        { const GAS u32x2* sr = (const GAS u32x2*)(SRC + (size_t)mp * DM) + lane;
#pragma unroll
          for (int j = 0; j < 8; ++j) nw[j] = sr[64 * j];
          if (FIRST) { const GAS f32x4* xr = (const GAS f32x4*)x_row(a, mp) + lane;
#pragma unroll
            for (int j = 0; j < 8; ++j) nx[j] = xr[64 * j]; }
          else { const GAS u32x2* xr = (const GAS u32x2*)(X1B + (size_t)mp * DM) + lane;
#pragma unroll
            for (int j = 0; j < 8; ++j) nxb[j] = xr[64 * j]; } }
        float s = 0.f;
#pragma unroll
        for (int j = 0; j < 8; ++j) s += (v[j].x * v[j].x + v[j].y * v[j].y) + (v[j].z * v[j].z + v[j].w * v[j].w);
        const float rstd = 1.f / sqrtf(wave_sum(s) * (1.f / DM) + EPS);
        float s2 = 0.f;
        GAS u32x2* xo = (GAS u32x2*)((GAS bf16_t*)(a.ws + (FIRST ? WS_X1B : WS_H)) + (size_t)m * DM) + lane;
#pragma unroll
        for (int j = 0; j < 8; ++j) { v[j] = x[j] + v[j] * rstd * g1[j]; u32x2 w; w.x = cvt_pk_bf16(v[j].x, v[j].y); w.y = cvt_pk_bf16(v[j].z, v[j].w); xo[64 * j] = w;
            s2 += (v[j].x * v[j].x + v[j].y * v[j].y) + (v[j].z * v[j].z + v[j].w * v[j].w); }
        if (FIRST) {
            GAS u32x2* ho = (GAS u32x2*)((GAS bf16_t*)(a.ws + WS_H) + (size_t)m * DM) + lane;
            const float rstd2 = 1.f / sqrtf(wave_sum(s2) * (1.f / DM) + EPS);
#pragma unroll
            for (int j = 0; j < 8; ++j) { u32x2 w; w.x = cvt_pk_bf16(v[j].x * rstd2 * g2[j].x, v[j].y * rstd2 * g2[j].y); w.y = cvt_pk_bf16(v[j].z * rstd2 * g2[j].z, v[j].w * rstd2 * g2[j].w); ho[64 * j] = w; }
        }
        if (!has) break;
#pragma unroll
        for (int j = 0; j < 8; ++j) { v[j] = (f32x4){bflo(nw[j].x), bfhi(nw[j].x), bflo(nw[j].y), bfhi(nw[j].y)};
            x[j] = FIRST ? nx[j] : (f32x4){bflo(nxb[j].x), bfhi(nxb[j].x), bflo(nxb[j].y), bfhi(nxb[j].y)}; }
        m = mn;
    }
}

__device__ __forceinline__ void ffnfix_item(const Args& a, int item, int lane) {
    const int c0 = (item % 11) * 512 + lane * 8, q = item / 11;
    const GAS float* cw = (const GAS float*)a.in[20] + c0;
    const GAS float* cbp = (const GAS float*)a.in[21] + c0;
    float w0[8], w1[8], w2[8], bb[8];
    { const f32x4 a0 = *(const GAS f32x4*)cw, a1 = *(const GAS f32x4*)(cw + 4), b0 = *(const GAS f32x4*)(cw + DFF), b1 = *(const GAS f32x4*)(cw + DFF + 4), c0v = *(const GAS f32x4*)(cw + 2 * DFF), c1v = *(const GAS f32x4*)(cw + 2 * DFF + 4),
                  d0 = *(const GAS f32x4*)cbp, d1 = *(const GAS f32x4*)(cbp + 4);
#pragma unroll
      for (int e = 0; e < 4; ++e) { w0[e] = a0[e]; w0[e + 4] = a1[e]; w1[e] = b0[e]; w1[e + 4] = b1[e]; w2[e] = c0v[e]; w2[e + 4] = c1v[e]; bb[e] = d0[e]; bb[e + 4] = d1[e]; } }
    GAS bf16_t* FIN = (GAS bf16_t*)(a.ws + WS_FIN);
    float p2[8], p1[8], x0[8], x1[8], g0[8], g1[8], ov[8];
    if (q < 128) {
        const GAS bf16_t* SA = (const GAS bf16_t*)(a.ws + WS_SA); const GAS bf16_t* SG = (const GAS bf16_t*)(a.ws + WS_SG);
        const int r0 = q * 64; const bool halo = (r0 & (SEQ - 1)) != 0; const int qp = halo ? q - 1 : q;
        const u32x4 h0 = *(const GAS u32x4*)(SA + ((size_t)qp * 4 + 0) * DFF + c0), h1 = *(const GAS u32x4*)(SA + ((size_t)qp * 4 + 1) * DFF + c0);
        const u32x4 a0 = *(const GAS u32x4*)(SA + ((size_t)q * 4 + 2) * DFF + c0), a1 = *(const GAS u32x4*)(SA + ((size_t)q * 4 + 3) * DFF + c0);
        const u32x4 gg0 = *(const GAS u32x4*)(SG + ((size_t)q * 2 + 0) * DFF + c0), gg1 = *(const GAS u32x4*)(SG + ((size_t)q * 2 + 1) * DFF + c0);
        unpack8(h0, p2); unpack8(h1, p1); unpack8(a0, x0); unpack8(a1, x1); unpack8(gg0, g0); unpack8(gg1, g1);
#pragma unroll
        for (int e = 0; e < 8; ++e) { p2[e] = halo ? p2[e] : 0.f; p1[e] = halo ? p1[e] : 0.f; }
#pragma unroll
        for (int e = 0; e < 8; ++e) ov[e] = gelu_tanh(w0[e] * p2[e] + w1[e] * p1[e] + w2[e] * x0[e] + bb[e]) * g0[e];
        *(GAS u32x4*)(FIN + (size_t)r0 * DFF + c0) = pack8a(ov);
#pragma unroll
        for (int e = 0; e < 8; ++e) ov[e] = gelu_tanh(w0[e] * p1[e] + w1[e] * x0[e] + w2[e] * x1[e] + bb[e]) * g1[e];
        *(GAS u32x4*)(FIN + (size_t)(r0 + 1) * DFF + c0) = pack8a(ov);
    } else {
        const int b = q - 128;
        const GAS float* st = (const GAS float*)a.in[5] + (size_t)b * 2 * DFF + c0;
        const f32x4 s0 = *(const GAS f32x4*)st, s1 = *(const GAS f32x4*)(st + 4), s2 = *(const GAS f32x4*)(st + DFF), s3 = *(const GAS f32x4*)(st + DFF + 4);
        const u32x4 a0 = *(const GAS u32x4*)((const GAS bf16_t*)(a.ws + WS_UAS) + (size_t)b * DFF + c0), gg0 = *(const GAS u32x4*)((const GAS bf16_t*)(a.ws + WS_UGS) + (size_t)b * DFF + c0);
        unpack8(a0, x0); unpack8(gg0, g0);
#pragma unroll
        for (int e = 0; e < 4; ++e) { p2[e] = s0[e]; p2[e + 4] = s1[e]; p1[e] = s2[e]; p1[e + 4] = s3[e]; }
#pragma unroll
        for (int e = 0; e < 8; ++e) ov[e] = gelu_tanh(w0[e] * p2[e] + w1[e] * p1[e] + w2[e] * x0[e] + bb[e]) * g0[e];
        *(GAS u32x4*)(FIN + (size_t)(MP + b) * DFF + c0) = pack8a(ov);
    }
}

#define XB_TMO      128
#define XB_XCNT(j)  (256  + 64 * (j))
#define XB_XSUB(j)  (1280 + 64 * (j))
#define XB_XGEN(j)  (2304 + 64 * (j))
#define XB_TOP      3328
#define XB_TOPGEN   3392
#define XCD_BAR_WORDS 3456
#define XB_SPIN_CAP (1u << 18)
__device__ __forceinline__ unsigned xb_ld(unsigned* p)              { return __hip_atomic_load(p, __ATOMIC_RELAXED, __HIP_MEMORY_SCOPE_AGENT); }
__device__ __forceinline__ unsigned xb_add(unsigned* p, unsigned v) { return __hip_atomic_fetch_add(p, v, __ATOMIC_RELAXED, __HIP_MEMORY_SCOPE_AGENT); }
__device__ __forceinline__ unsigned xb_xcc_id() { return (unsigned)__builtin_amdgcn_s_getreg((3 << 11) | 20) & 0xFu; }
#define XB_SPIN(cond, bar) do { unsigned _sp = 0; while (cond) { __builtin_amdgcn_s_sleep(1); \
    if ((++_sp & 255u) == 0u) { if (xb_ld(&(bar)[XB_TMO])) break; if (_sp > XB_SPIN_CAP) { atomicAdd(&(bar)[XB_TMO], 1u); break; } } } } while (0)
__device__ __forceinline__ void xcd_barrier_complete(unsigned* bar, unsigned x, unsigned G, unsigned& nloc, unsigned& nx) {
    unsigned sum, cnt, mine, sp = 0u;
    for (;;) {
        sum = 0u; cnt = 0u; mine = 0u;
#pragma unroll
        for (unsigned j = 0; j < 16; ++j) { const unsigned c = xb_ld(&bar[XB_XCNT(j)]); sum += c; cnt += (c > 0u) ? 1u : 0u; mine = (j == x) ? c : mine; }
        if (sum == G) break;
        __builtin_amdgcn_s_sleep(1);
        if ((++sp & 255u) == 0u) { if (xb_ld(&bar[XB_TMO])) break; if (sp > XB_SPIN_CAP) { atomicAdd(&bar[XB_TMO], 1u); break; } }
    }
    nloc = mine > 0u ? mine : 1u; nx = cnt > 0u ? cnt : 1u;
}
__device__ __forceinline__ void grid_barrier(unsigned* bar, volatile LAS unsigned* st, unsigned G, int wid_in) {
    asm volatile("s_waitcnt vmcnt(0)" ::: "memory");
    __syncthreads();
    if (wid_in == 0 && fresh_lane() == 0) {
        __builtin_amdgcn_s_waitcnt(0);
        const unsigned x = xb_xcc_id();
        unsigned nloc = st[0], nx = st[1];
        if (nloc == 0u) { xcd_barrier_complete(bar, x, G, nloc, nx); st[0] = nloc; st[1] = nx; }
        const unsigned old = xb_add(&bar[XB_XSUB(x)], 1u);
        const unsigned gen = old / nloc;
        if (old + 1u == (gen + 1u) * nloc) {
            __builtin_amdgcn_fence(__ATOMIC_RELEASE, "agent");
            asm volatile("s_waitcnt vmcnt(0)" ::: "memory");
            const unsigned og = xb_add(&bar[XB_TOP], 1u);
            const unsigned tg = og / nx;
            if (og + 1u == (tg + 1u) * nx) xb_add(&bar[XB_TOPGEN], 1u);
            else XB_SPIN(xb_ld(&bar[XB_TOPGEN]) == tg, bar);
            __builtin_amdgcn_fence(__ATOMIC_ACQUIRE, "agent");
            xb_add(&bar[XB_XGEN(x)], 1u);
            asm volatile("s_waitcnt vmcnt(0)" ::: "memory");
        } else {
            XB_SPIN(xb_ld(&bar[XB_XGEN(x)]) == gen, bar);
            __builtin_amdgcn_fence(__ATOMIC_ACQUIRE, "agent");
            asm volatile("s_waitcnt vmcnt(0)" ::: "memory");
        }
    }
    __syncthreads();
}

template <int MODE, int N, int K>
__device__ __forceinline__ void gemm_job(LAS unsigned char* lds, const Args& a, size_t offA, size_t offB, int G, int bid, int wid) {
    const bf16_t* A = (const bf16_t*)(a.ws + offA); const bf16_t* Bt = (const bf16_t*)(a.ws + offB);
    pg8::gemm_phase<MODE, N, K>(lds, a, A, Bt, G, bid, wid);
    skinny_gemm<MODE, N, K>(lds, a, A + (size_t)MP * K, Bt, G, bid, wid);
}

__global__ void __launch_bounds__(512, 2) hybrid_fwd(Args a) {
    __shared__ __attribute__((aligned(16))) unsigned char lds_raw[LDS_BYTES];
    LAS unsigned char* lds = (LAS unsigned char*)lds_raw;
    const int wid = __builtin_amdgcn_readfirstlane((int)threadIdx.x >> 6);
    const int G = gridDim.x, bid = blockIdx.x, gw = bid * 8 + wid, NGW = G * 8;
    const int lo = a.ph_lo, hi = a.ph_hi;
    if (lo > 1000) { __threadfence(); cg::this_grid().sync(); }
    if (hi - lo > 1) {
        if (wid == 0) { const int l = fresh_lane(); if (l < 2) ((volatile LAS unsigned*)(lds + 131072))[l] = 0u; if (l == 0) (void)xb_add((unsigned*)a.ws + XB_XCNT(xb_xcc_id()), 1u); }
        __syncthreads();
    }
#define IN(k) (lo <= (k) && (k) < hi)
#define SEAM(k) do { if (IN(k) && IN((k) + 1)) grid_barrier((unsigned*)a.ws, (volatile LAS unsigned*)(lds + 131072), (unsigned)G, wid); } while (0)
#ifdef PROBE_PHASE
    if (IN(100)) {
        const int gtid = bid * 512 + wid * 64 + fresh_lane(), GT = G * 512;
        const GAS bf16_t* b16 = (const GAS bf16_t*)(a.ws + 4 * MiB); const size_t n = (size_t)(341 * MiB / 2), NOUT = 16842752;
        for (size_t i = gtid; i < NOUT; i += GT) { float acc = 0.f; for (size_t k = i; k < n; k += NOUT) acc += bf1(b16[k]); ((GAS float*)a.out)[i] = acc; }
    }
#endif
    if (IN(0)) p0_prologue(a, lds, bid, G, wid);
    SEAM(0);
    if (IN(1)) {
        gemm_job<1, INC, 2048>(lds, a, WS_H, WS_WIN, G, bid, wid);
        constexpr int NFULL = (MP / 256) * (INC / 256) % 256;
        const int first = (G == 256) ? NFULL : 0;
        if (bid >= first) late_weights<1>(a, lds, (bid - first) * 8 + wid, (G - first) * 8, wid);
    }
    SEAM(1);
    if (IN(2)) {
#ifndef SKIP_PA
        for (int u = bid; u < 256; u += G) attn_prompt_unit(a, lds, u, wid);
#endif
        if (bid >= G - MS) attn_sample_unit(a, lds, G - 1 - bid, wid);
        for (int it = gw; it < (MT / 8) * 2; it += NGW) convb_item(a, it, fresh_lane());
    }
    SEAM(2);
    if (IN(3)) gemm_job<3, 2048, 2048>(lds, a, WS_AB, WS_WM, G, bid, wid);
    SEAM(3);
    if (IN(4)) gemm_job<4, 2048, 2048>(lds, a, WS_MERGED, WS_WO, G, bid, wid);
    SEAM(4);
    if (IN(5)) resnorm_rows<true>(a, gw, NGW, fresh_lane());
    SEAM(5);
    if (IN(6)) {
        gemm_job<6, 2 * DFF, 2048>(lds, a, WS_H, WS_WUP, G, bid, wid);
        constexpr int NFULL = (MP / 256) * (2 * DFF / 256) % 256;
        const int first = (G == 256) ? NFULL : 0;
        if (bid >= first) {
            late_weights<2>(a, lds, (bid - first) * 8 + wid, (G - first) * 8, wid);
            __syncthreads();
            gemm_job<9, 2048, PLE>(lds, a, WS_PB, WS_WP, G - first, bid - first, wid);
        }
    }
    SEAM(6);
    if (IN(7)) { for (int it = gw; it < (128 + MS) * 11; it += NGW) ffnfix_item(a, it, fresh_lane()); }
    SEAM(7);
    if (IN(8)) gemm_job<8, 2048, DFF>(lds, a, WS_FIN, WS_WDN, G, bid, wid);
    SEAM(8);
    if (IN(9)) resnorm_rows<false>(a, gw, NGW, fresh_lane());
    SEAM(9);
    if (IN(10)) gemm_job<10, 2048, 2048>(lds, a, WS_H, WS_WG, G, bid, wid);
#undef IN
#undef SEAM
}

extern "C" void kernel_launch(void* const* d_in, const int* in_sizes, int n_in, void* d_out, int out_size, void* d_ws, size_t ws_size, hipStream_t stream) {
    static int grid = 0;
    if (grid == 0) {
        if (n_in != 25 || ws_size < WS_END) { fprintf(stderr, "kernel_launch: unexpected n_in %d / ws_size %zu\n", n_in, ws_size); grid = -1; return; }
        int dev = 0, cus = 0, per_cu = 0;
        if (hipGetDevice(&dev) != hipSuccess || hipDeviceGetAttribute(&cus, hipDeviceAttributeMultiprocessorCount, dev) != hipSuccess) { grid = -1; return; }
        if (hipOccupancyMaxActiveBlocksPerMultiprocessor(&per_cu, (const void*)hybrid_fwd, 512, 0) != hipSuccess || per_cu < 1) { fprintf(stderr, "kernel_launch: occupancy query says %d\n", per_cu); per_cu = 1; }
        (void)hipGetLastError();
        grid = cus;
    }
    if (grid < 0) return;
    if (hipMemsetAsync(d_ws, 0, 16384, stream) != hipSuccess) { fprintf(stderr, "kernel_launch: memset failed\n"); return; }
    Args a{};
    for (int i = 0; i < 25; ++i) a.in[i] = (const float*)d_in[i];
    a.out = (float*)d_out; a.ws = (unsigned char*)d_ws;
#if MK_N_LAUNCHES == 1
    a.ph_lo = 0; a.ph_hi = NPHASE;
    void* kargs[] = {&a};
    hipError_t e = hipLaunchCooperativeKernel((const void*)hybrid_fwd, dim3(grid), dim3(512), kargs, 0, stream);
    if (e != hipSuccess) fprintf(stderr, "cooperative launch failed: %s (grid %d)\n", hipGetErrorString(e), grid);
#else
#ifdef PROBE_PHASE
    for (int ph = 0; ph <= PROBE_PHASE; ++ph) { a.ph_lo = ph; a.ph_hi = ph + 1; hipLaunchKernelGGL(hybrid_fwd, dim3(grid), dim3(512), 0, stream, a); }
    a.ph_lo = 100; a.ph_hi = 101; hipLaunchKernelGGL(hybrid_fwd, dim3(grid), dim3(512), 0, stream, a);
#else
    for (int ph = 0; ph < NPHASE; ++ph) {
        a.ph_lo = ph; a.ph_hi = ph + 1;
        for (int rep = 0; rep < 1 + ((REPMASK >> ph) & 1); ++rep)
            hipLaunchKernelGGL(hybrid_fwd, dim3(grid), dim3(512), 0, stream, a);
    }
#endif
#endif
}
```

```cpp
#include <hip/hip_runtime.h>
#include <hip/hip_cooperative_groups.h>
#include <cstdio>
#include <cstdint>
namespace cg = cooperative_groups;


#ifndef MK_N_LAUNCHES
#define MK_N_LAUNCHES 1
#define REPMASK 0x00
#endif

#define LAS __attribute__((address_space(3)))
#define GAS __attribute__((address_space(1)))
typedef unsigned short bf16_t;
typedef short bf16x8 __attribute__((ext_vector_type(8)));
typedef float f32x4 __attribute__((ext_vector_type(4)));
typedef float f32x16 __attribute__((ext_vector_type(16)));
typedef unsigned u32x4 __attribute__((ext_vector_type(4)));
typedef unsigned u32x2 __attribute__((ext_vector_type(2)));

constexpr int DM = 2048, SEQ = 4096, MP = 8192, MS = 32, MT = MP + MS;
constexpr int DFF = 5632, INC = 8448, CW = 1024, PLE = 256;
constexpr int P1C = 4352;
constexpr int C_K = 1024, C_V = 1152, C_CB = 1280, C_CC = 2304, C_CU = 3328;
constexpr float EPS = 1e-6f;
constexpr size_t O_YP = 0, O_YS = 16777216, O_KP = 16842752, O_VP = 16875520, O_CP = 16908288, O_FP = 16912384,
                 O_KS = 16934912, O_VS = 17459200, O_CS = 17983488, O_FS = 18049024;
constexpr size_t MiB = 1u << 20;
constexpr size_t WS_ROPE = 1 * MiB;
constexpr size_t WS_WIN = 4 * MiB, WS_WM = 37 * MiB, WS_WO = 45 * MiB, WS_WUP = 53 * MiB, WS_WDN = 97 * MiB, WS_WG = 119 * MiB, WS_WP = 127 * MiB;
constexpr size_t WS_H = 128 * MiB;
constexpr size_t WS_R = 161 * MiB;
constexpr size_t WS_PROJ1 = WS_R, WS_PROJ2 = 230 * MiB, WS_AB = 295 * MiB;
constexpr size_t WS_MERGED = WS_R, WS_MO = 230 * MiB;
constexpr size_t WS_SA = 4 * MiB;
constexpr size_t WS_SG = 10 * MiB;
constexpr size_t WS_UAS = 13 * MiB, WS_UGS = 13 * MiB + 512 * 1024;
constexpr size_t WS_PP = 16 * MiB;
constexpr size_t WS_FIN = WS_R;
constexpr size_t WS_F = 250 * MiB;
constexpr size_t WS_X1B = 295 * MiB;
constexpr size_t WS_PB = 340 * MiB;
constexpr size_t WS_END = 345 * MiB;
constexpr int LDS_BYTES = 147456;
constexpr int NPHASE = 11;

struct Args { const float* in[25]; float* out; unsigned char* ws; int ph_lo, ph_hi; };

__device__ __forceinline__ unsigned cvt_pk_bf16(float lo, float hi) { unsigned r; asm("v_cvt_pk_bf16_f32 %0, %1, %2" : "=v"(r) : "v"(lo), "v"(hi)); return r; }
__device__ __forceinline__ float bflo(unsigned w) { return __uint_as_float(w << 16); }
__device__ __forceinline__ float bfhi(unsigned w) { return __uint_as_float(w & 0xffff0000u); }
__device__ __forceinline__ float bf1(bf16_t b) { return __uint_as_float(((unsigned)b) << 16); }
__device__ __forceinline__ void unpack8(u32x4 w, float* f) { f[0] = bflo(w.x); f[1] = bfhi(w.x); f[2] = bflo(w.y); f[3] = bfhi(w.y); f[4] = bflo(w.z); f[5] = bfhi(w.z); f[6] = bflo(w.w); f[7] = bfhi(w.w); }
__device__ __forceinline__ u32x4 pack8(f32x4 lo, f32x4 hi) { u32x4 w; w.x = cvt_pk_bf16(lo[0], lo[1]); w.y = cvt_pk_bf16(lo[2], lo[3]); w.z = cvt_pk_bf16(hi[0], hi[1]); w.w = cvt_pk_bf16(hi[2], hi[3]); return w; }
__device__ __forceinline__ u32x4 pack8a(const float* f) { u32x4 w; w.x = cvt_pk_bf16(f[0], f[1]); w.y = cvt_pk_bf16(f[2], f[3]); w.z = cvt_pk_bf16(f[4], f[5]); w.w = cvt_pk_bf16(f[6], f[7]); return w; }
__device__ __forceinline__ int fresh_lane() { int l; asm volatile("v_mbcnt_lo_u32_b32 %0, -1, 0\n\tv_mbcnt_hi_u32_b32 %0, -1, %0" : "=v"(l)); return l; }
__device__ __forceinline__ float wave_sum(float v) {
#pragma unroll
    for (int o = 1; o < 64; o <<= 1) v += __shfl_xor(v, o);
    return v;
}
__device__ __forceinline__ float wave_max(float v) {
#pragma unroll
    for (int o = 1; o < 64; o <<= 1) v = fmaxf(v, __shfl_xor(v, o));
    return v;
}
__device__ __forceinline__ float rcpf_(float x) { return __builtin_amdgcn_rcpf(x); }
__device__ __forceinline__ float sigm(float x) { return rcpf_(1.f + __expf(-x)); }
__device__ __forceinline__ float gelu_tanh(float x) { const float u = 0.7978845608028654f * (x + 0.044715f * x * x * x); return x * rcpf_(1.f + __expf(-2.f * u)); }
__device__ __forceinline__ const GAS float* x_row(const Args& a, int row) {
    return row < MP ? (const GAS float*)a.in[0] + (size_t)row * DM : (const GAS float*)a.in[1] + (size_t)(row - MP) * DM;
}

__device__ __forceinline__ void load_gates(const Args& a, int row, int col0, float* ea, float* eb) {
    const GAS bf16_t* p2 = (const GAS bf16_t*)(a.ws + WS_PROJ2) + (size_t)row * 4096 + col0;
    const u32x4 wa = *(const GAS u32x4*)p2, wb = *(const GAS u32x4*)(p2 + 2048);
    const GAS float* bg = (const GAS float*)a.in[17] + col0;
    const f32x4 b0l = *(const GAS f32x4*)bg, b0h = *(const GAS f32x4*)(bg + 4), b1l = *(const GAS f32x4*)(bg + 2048), b1h = *(const GAS f32x4*)(bg + 2052);
    float ga[8], gb[8]; unpack8(wa, ga); unpack8(wb, gb);
#pragma unroll
    for (int e = 0; e < 4; ++e) {
        ea[e] = fminf(__expf(-(ga[e] + b0l[e])), 1e30f); ea[e + 4] = fminf(__expf(-(ga[e + 4] + b0h[e])), 1e30f);
        eb[e] = fminf(__expf(-(gb[e] + b1l[e])), 1e30f); eb[e + 4] = fminf(__expf(-(gb[e + 4] + b1h[e])), 1e30f);
    }
}

template <int MODE>
__device__ __forceinline__ void epi8(const Args& a, int row, int col0, f32x4 lo, f32x4 hi) {
    unsigned char* ws = a.ws;
    if constexpr (MODE == 1) {
        GAS bf16_t* p = col0 < P1C ? (GAS bf16_t*)(ws + WS_PROJ1) + (size_t)row * P1C + col0 : (GAS bf16_t*)(ws + WS_PROJ2) + (size_t)row * 4096 + (col0 - P1C);
        *(GAS u32x4*)p = pack8(lo, hi);
    } else if constexpr (MODE == 3) {
        float ea[8], eb[8]; load_gates(a, row, col0, ea, eb);
#pragma unroll
        for (int e = 0; e < 4; ++e) { lo[e] = lo[e] * rcpf_(1.f + eb[e]); hi[e] = hi[e] * rcpf_(1.f + eb[e + 4]); }
        *(GAS u32x4*)((GAS bf16_t*)(ws + WS_MERGED) + (size_t)row * DM + col0) = pack8(lo, hi);
    } else if constexpr (MODE == 30) {
        *(GAS u32x4*)((GAS bf16_t*)(ws + WS_MERGED) + (size_t)row * DM + col0) = pack8(lo, hi);
    } else if constexpr (MODE == 4) {
        *(GAS u32x4*)((GAS bf16_t*)(ws + WS_MO) + (size_t)row * DM + col0) = pack8(lo, hi);
    } else if constexpr (MODE == 6) {
        const int ch = (col0 >> 8) * 128 + (col0 & 127);
        if (((col0 >> 7) & 1) == 0) {
            *(GAS u32x4*)((GAS bf16_t*)(ws + WS_UAS) + (size_t)(row - MP) * DFF + ch) = pack8(lo, hi);
            GAS float* o = (GAS float*)a.out + O_FS + (size_t)((row - MP) * 2 + 1) * DFF + ch; *(GAS f32x4*)o = lo; *(GAS f32x4*)(o + 4) = hi;
        } else {
            *(GAS u32x4*)((GAS bf16_t*)(ws + WS_UGS) + (size_t)(row - MP) * DFF + ch) = pack8(lo, hi);
        }
    } else if constexpr (MODE == 8) {
        *(GAS u32x4*)((GAS bf16_t*)(ws + WS_F) + (size_t)row * DM + col0) = pack8(lo, hi);
    } else if constexpr (MODE == 9) {
        *(GAS u32x4*)((GAS bf16_t*)(ws + WS_PP) + (size_t)row * DM + col0) = pack8(lo, hi);
    } else if constexpr (MODE == 10) {
        GAS float* o = (GAS float*)a.out + (size_t)row * DM + col0;
        const u32x4 xw = *(const GAS u32x4*)((const GAS bf16_t*)(ws + WS_H) + (size_t)row * DM + col0);
        const u32x4 pw = *(const GAS u32x4*)((const GAS bf16_t*)(ws + WS_PP) + (size_t)row * DM + col0);
        float pp[8], xx[8]; unpack8(pw, pp); unpack8(xw, xx); f32x4 y0, y1;
#pragma unroll
        for (int e = 0; e < 4; ++e) { y0[e] = xx[e] + sigm(lo[e]) * pp[e]; y1[e] = xx[e + 4] + sigm(hi[e]) * pp[e + 4]; }
        *(GAS f32x4*)o = y0; *(GAS f32x4*)(o + 4) = y1;
    }
}

__device__ __forceinline__ void glds_s(const char* sbase, unsigned voff, unsigned lds_dst) {
    unsigned keep;
    asm volatile("s_mov_b32 %0, m0\n\ts_mov_b32 m0, %3\n\ts_nop 0\n\tglobal_load_lds_dwordx4 %1, %2\n\ts_mov_b32 m0, %0" : "=&s"(keep) : "v"(voff), "s"(sbase), "s"(lds_dst) : "memory");
}
namespace pg8 {
constexpr int BM = 256, BK = 64, HALF = 128, HTB = HALF * BK * 2, STAGE_BYTES = 8 * HTB, NXCD = 8, WGM = 8;
__host__ __device__ __forceinline__ int lds_byte(int r, int c) { const int st = (r >> 4) * 2 + (c >> 5), rr = r & 15, cc = c & 31, ob = rr * 64 + cc * 2; return st * 1024 + (ob ^ (((ob >> 9) & 1) << 5)); }
__host__ __device__ __forceinline__ void stage_rc(int b, int& R, int& C) { const int st = b / 1024, sb = b % 1024, swz = sb ^ (((sb >> 9) & 1) << 5); R = (st >> 1) * 16 + swz / 64; C = (st & 1) * 32 + (swz % 64) / 2; }
__host__ __device__ __forceinline__ int perm32(int rho) { const int n = rho >> 4, i = rho & 15; return 8 * (i >> 2) + 4 * n + (i & 3); }
struct Unit { int pm, pn; };
struct StaticOrder {
    int nM, nN, nwg, G, c;
    __device__ void init(int M, int N, int G_, int c_) { nM = M / BM; nN = N / BM; nwg = nM * nN; G = G_; c = c_; }
    __device__ bool next(int i, Unit& u) const {
        const long L = (long)i * G + c; if (L >= nwg) return false;
        int wgid = (int)L; { const int q = nwg / NXCD, r = nwg % NXCD, xcd = wgid % NXCD, off = wgid / NXCD; wgid = (xcd < r ? xcd * (q + 1) : r * (q + 1) + (xcd - r) * q) + off; }
        const int nig = WGM * nN, gid = wgid / nig, fm = gid * WGM, gsz = (nM - fm) < WGM ? (nM - fm) : WGM;
        u.pm = fm + ((wgid % nig) % gsz); u.pn = (wgid % nig) / gsz; return true;
    }
};

template <int MODE>
__device__ __forceinline__ void tile_epi(const Args& a, const f32x4 (&acc)[2][2][4][2], const Unit& u, int wr, int wc, int fr, int fq) {
#pragma unroll
    for (int ai = 0; ai < 2; ++ai)
#pragma unroll
        for (int m = 0; m < 4; ++m)
#pragma unroll
            for (int bj = 0; bj < 2; ++bj)
                epi8<MODE>(a, u.pm * BM + ai * HALF + wr * 64 + m * 16 + fr, u.pn * BM + bj * HALF + wc * 32 + 8 * fq, acc[ai][bj][m][0], acc[ai][bj][m][1]);
}
template <int CTRL> __device__ __forceinline__ float dppf(float old, float src) {
    return __int_as_float(__builtin_amdgcn_update_dpp(__float_as_int(old), __float_as_int(src), CTRL, 0xf, 0xf, false));
}
__device__ __forceinline__ void tile_epi6(const Args& a, const f32x4 (&acc)[2][2][4][2], const Unit& u, int wr, int wc, int fr, int fq) {
    const int ch0 = u.pn * 128 + wc * 32 + 8 * fq;
    const GAS float* cw = (const GAS float*)a.in[20] + ch0; const GAS float* cbp = (const GAS float*)a.in[21] + ch0;
    float w0[8], w1[8], w2[8], bb[8];
    { const f32x4 a0 = *(const GAS f32x4*)cw, a1 = *(const GAS f32x4*)(cw + 4), b0 = *(const GAS f32x4*)(cw + DFF), b1 = *(const GAS f32x4*)(cw + DFF + 4), c0v = *(const GAS f32x4*)(cw + 2 * DFF), c1v = *(const GAS f32x4*)(cw + 2 * DFF + 4),
                  d0 = *(const GAS f32x4*)cbp, d1 = *(const GAS f32x4*)(cbp + 4);
#pragma unroll
      for (int e = 0; e < 4; ++e) { w0[e] = a0[e]; w0[e + 4] = a1[e]; w1[e] = b0[e]; w1[e + 4] = b1[e]; w2[e] = c0v[e]; w2[e + 4] = c1v[e]; bb[e] = d0[e]; bb[e + 4] = d1[e]; } }
    GAS bf16_t* FIN = (GAS bf16_t*)(a.ws + WS_FIN); GAS bf16_t* SA = (GAS bf16_t*)(a.ws + WS_SA); GAS bf16_t* SG = (GAS bf16_t*)(a.ws + WS_SG);
#pragma unroll
    for (int ai = 0; ai < 2; ++ai)
#pragma unroll
        for (int m = 0; m < 4; ++m) {
            const int row = u.pm * BM + ai * HALF + wr * 64 + m * 16 + fr, grp = row >> 6;
            float ov[8];
#pragma unroll
            for (int n = 0; n < 2; ++n)
#pragma unroll
                for (int e = 0; e < 4; ++e) {
                    const float cur = acc[ai][0][m][n][e];
                    float r1 = 0.f, r2 = 0.f;
                    if (m > 0) { const float pv = acc[ai][0][m > 0 ? m - 1 : 0][n][e]; r1 = dppf<0x121>(0.f, pv); r2 = dppf<0x122>(0.f, pv); }
                    const float p1 = dppf<0x111>(r1, cur), p2 = dppf<0x112>(r2, cur);
                    const int k = 4 * n + e;
                    ov[k] = gelu_tanh(w0[k] * p2 + w1[k] * p1 + w2[k] * cur + bb[k]) * acc[ai][1][m][n][e];
                }
            if (m == 0 && fr < 2) {
                *(GAS u32x4*)(SA + ((size_t)grp * 4 + 2 + fr) * DFF + ch0) = pack8(acc[ai][0][m][0], acc[ai][0][m][1]);
                *(GAS u32x4*)(SG + ((size_t)grp * 2 + fr) * DFF + ch0) = pack8(acc[ai][1][m][0], acc[ai][1][m][1]);
            } else {
                *(GAS u32x4*)(FIN + (size_t)row * DFF + ch0) = pack8a(ov);
            }
            if (m == 3 && fr >= 14) {
                *(GAS u32x4*)(SA + ((size_t)grp * 4 + (fr - 14)) * DFF + ch0) = pack8(acc[ai][0][m][0], acc[ai][0][m][1]);
                const int t = row & (SEQ - 1);
                if (t >= SEQ - 2) { GAS float* o = (GAS float*)a.out + O_FP + (size_t)((row >> 12) * 2 + (t - (SEQ - 2))) * DFF + ch0; *(GAS f32x4*)o = acc[ai][0][m][0]; *(GAS f32x4*)(o + 4) = acc[ai][0][m][1]; }
            }
        }
}
__device__ __forceinline__ void mid_scale(const Args& a, f32x4 (&acc)[2][2][4][2], const Unit& u, int wr, int wc, int fr, int fq) {
    int z = 0; asm volatile("" : "+v"(z));
    fr += z;
#pragma unroll
    for (int ai = 0; ai < 2; ++ai)
#pragma unroll
        for (int m = 0; m < 4; ++m)
#pragma unroll
            for (int bj = 0; bj < 2; ++bj) {
                float ea[8], eb[8]; load_gates(a, u.pm * BM + ai * HALF + wr * 64 + m * 16 + fr, u.pn * BM + bj * HALF + wc * 32 + 8 * fq, ea, eb);
#pragma unroll
                for (int e = 0; e < 4; ++e) { acc[ai][bj][m][0][e] *= (1.f + eb[e]) * rcpf_(1.f + ea[e]); acc[ai][bj][m][1][e] *= (1.f + eb[e + 4]) * rcpf_(1.f + ea[e + 4]); }
                __builtin_amdgcn_sched_barrier(0);
            }
}

template <int MODE, int N, int K>
__device__ __forceinline__ void gemm_phase(LAS unsigned char* lds, const Args& args, const bf16_t* gA, const bf16_t* gBt, int G, int bid, int wid_in) {
    const int wid = wid_in, lane = fresh_lane(), tid = wid * 64 + lane, wr = wid >> 2, wc = wid & 3, fr = lane & 15, fq = lane >> 4;
    const int nt = K / BK;
    StaticOrder S; S.init(MP, N, G, bid);
    unsigned voffA, voffB;
    { int R, C; stage_rc(tid * 16, R, C); const int Rb = (R & ~31) + perm32(R & 31); voffA = (unsigned)(R * K + C) * 2u; voffB = (unsigned)(Rb * K + C) * 2u; }
    const unsigned ldsbase = (unsigned)(size_t)lds;
    const size_t kstep = (size_t)(BK * 2);
    const size_t hstep = (size_t)HALF * K * 2;
    const size_t tstep = 2 * hstep;
    const unsigned ldsw = (unsigned)wid * 1024u;
    const int aoff = lds_byte(wr * 64 + fr, fq * 8), boff = lds_byte(wc * 32 + fr, fq * 8);
#define PG8_SA(b, h) (((b) * 2 + (h)) * HTB)
#define PG8_SB(b, h) ((4 + (b) * 2 + (h)) * HTB)
#define PG8_STAGE(bufoff, gbase, voff) do { glds_s((const char*)(gbase), (voff), ldsbase + (unsigned)(bufoff) + ldsw); \
        glds_s((const char*)(gbase) + (size_t)64 * K * 2, (voff), ldsbase + (unsigned)(bufoff) + ldsw + 8192u); } while (0)
#define PG8_LDA(dst, b, h) do { _Pragma("unroll") for (int m = 0; m < 4; ++m) _Pragma("unroll") for (int k = 0; k < 2; ++k) dst[m][k] = *(const LAS bf16x8*)(lds + PG8_SA(b, h) + aoff + m * 2048 + k * 1024); } while (0)
#define PG8_LDB(dst, b, h) do { _Pragma("unroll") for (int n = 0; n < 2; ++n) _Pragma("unroll") for (int k = 0; k < 2; ++k) dst[n][k] = *(const LAS bf16x8*)(lds + PG8_SB(b, h) + boff + n * 2048 + k * 1024); } while (0)
#define PG8_MMA(ai, bj, At, Bt) do { __builtin_amdgcn_s_setprio(1); _Pragma("unroll") for (int m = 0; m < 4; ++m) _Pragma("unroll") for (int n = 0; n < 2; ++n) _Pragma("unroll") for (int k = 0; k < 2; ++k) \
        acc[ai][bj][m][n] = __builtin_amdgcn_mfma_f32_16x16x32_bf16(Bt[n][k], At[m][k], acc[ai][bj][m][n], 0, 0, 0); __builtin_amdgcn_s_setprio(0); } while (0)
#define PG8_WAIT_V(n) asm volatile("s_waitcnt vmcnt(" #n ")" ::: "memory")
#define PG8_WAIT_L(n) asm volatile("s_waitcnt lgkmcnt(" #n ")" ::: "memory")
#define PG8_BAR __builtin_amdgcn_s_barrier()
#define PG8_SCHED __builtin_amdgcn_sched_barrier(0)
    Unit cur, nxt; int ui = 0;
    if (!S.next(0, cur)) return;
    f32x4 acc[2][2][4][2];
#pragma unroll
    for (int a = 0; a < 2; ++a)
#pragma unroll
        for (int b = 0; b < 2; ++b)
#pragma unroll
            for (int m = 0; m < 4; ++m)
#pragma unroll
                for (int n = 0; n < 2; ++n) acc[a][b][m][n] = (f32x4){0.f, 0.f, 0.f, 0.f};
    bf16x8 At[4][2], B0[2][2], B1[2][2];
    const char* cA = (const char*)gA + (size_t)cur.pm * tstep; const char* cB = (const char*)gBt + (size_t)cur.pn * tstep;
    PG8_STAGE(PG8_SB(0, 0), cB, voffB); PG8_STAGE(PG8_SB(0, 1), cB + hstep, voffB); PG8_STAGE(PG8_SA(0, 0), cA, voffA); PG8_STAGE(PG8_SA(0, 1), cA + hstep, voffA);
    if (wr == 1) PG8_BAR;
    PG8_WAIT_V(2); PG8_BAR;
    PG8_STAGE(PG8_SB(1, 0), cB + kstep, voffB); PG8_STAGE(PG8_SA(1, 0), cA + kstep, voffA); PG8_STAGE(PG8_SB(1, 1), cB + hstep + kstep, voffB);
    PG8_WAIT_V(6); PG8_BAR;
    for (;;) {
        const bool has_next = S.next(ui + 1, nxt);
        const char* nA = has_next ? (const char*)gA + (size_t)nxt.pm * tstep : cA; const char* nB = has_next ? (const char*)gBt + (size_t)nxt.pn * tstep : cB;
        for (int t = 0; t < nt; t += 2) {
            const bool last = (t == nt - 2);
            const char* a1 = cA + (size_t)(t + 1) * kstep;
            const char* a2 = last ? nA : cA + (size_t)(t + 2) * kstep; const char* b2 = last ? nB : cB + (size_t)(t + 2) * kstep;
            const char* a3 = a2 + kstep; const char* b3 = b2 + kstep;
            if constexpr (MODE == 3) { if (t == (nt >> 1)) { mid_scale(args, acc, cur, wr, wc, fr, fq); PG8_SCHED; } }
            PG8_LDB(B0, 0, 0); PG8_LDB(B1, 0, 1); PG8_SCHED; PG8_LDA(At, 0, 0); PG8_STAGE(PG8_SA(1, 1), a1 + hstep, voffA);
            PG8_WAIT_V(8); PG8_WAIT_L(0); PG8_BAR; PG8_MMA(0, 0, At, B0); PG8_MMA(0, 1, At, B1); PG8_BAR; PG8_SCHED;
            PG8_LDA(At, 0, 1); PG8_STAGE(PG8_SB(0, 0), b2, voffB); PG8_STAGE(PG8_SB(0, 1), b2 + hstep, voffB); PG8_STAGE(PG8_SA(0, 0), a2, voffA);
            PG8_WAIT_V(8); PG8_WAIT_L(0); PG8_BAR; PG8_MMA(1, 0, At, B0); PG8_MMA(1, 1, At, B1); PG8_BAR; PG8_SCHED;
            PG8_LDB(B0, 1, 0); PG8_LDB(B1, 1, 1); PG8_SCHED; PG8_LDA(At, 1, 0); PG8_STAGE(PG8_SA(0, 1), a2 + hstep, voffA);
            PG8_WAIT_V(8); PG8_WAIT_L(0); PG8_BAR; PG8_MMA(0, 0, At, B0); PG8_MMA(0, 1, At, B1); PG8_BAR; PG8_SCHED;
            PG8_LDA(At, 1, 1); PG8_STAGE(PG8_SB(1, 0), b3, voffB); PG8_STAGE(PG8_SB(1, 1), b3 + hstep, voffB); PG8_STAGE(PG8_SA(1, 0), a3, voffA);
            PG8_WAIT_V(8); PG8_WAIT_L(0); PG8_BAR; PG8_MMA(1, 0, At, B0); PG8_MMA(1, 1, At, B1); PG8_BAR; PG8_SCHED;
        }
        if (wr == 0) PG8_BAR;
        if constexpr (MODE == 6) tile_epi6(args, acc, cur, wr, wc, fr, fq); else tile_epi<MODE>(args, acc, cur, wr, wc, fr, fq);
        if (!has_next) break;
#pragma unroll
        for (int a = 0; a < 2; ++a)
#pragma unroll
            for (int b = 0; b < 2; ++b)
#pragma unroll
                for (int m = 0; m < 4; ++m)
#pragma unroll
                    for (int n = 0; n < 2; ++n) acc[a][b][m][n] = (f32x4){0.f, 0.f, 0.f, 0.f};
        cur = nxt; cA = nA; cB = nB; ++ui;
        if (wr == 1) PG8_BAR;
    }
    PG8_WAIT_V(0);
    PG8_BAR;
#undef PG8_SA
#undef PG8_SB
#undef PG8_STAGE
#undef PG8_LDA
#undef PG8_LDB
#undef PG8_MMA
#undef PG8_WAIT_V
#undef PG8_WAIT_L
#undef PG8_BAR
#undef PG8_SCHED
}
}

template <int MODE, int N, int K>
__device__ __forceinline__ void skinny_gemm(LAS unsigned char* lds, const Args& args, const bf16_t* A, const bf16_t* Bt, int G, int bid, int wid_in) {
    const int wid = wid_in, lane = fresh_lane(), tid = wid * 64 + lane, fr = lane & 15, fq = lane >> 4;
    LAS float* P = (LAS float*)lds;
    constexpr int nitems = N / 16, kw = K / 8, NS = kw / 32;
    constexpr int GRP = (NS % 11 == 0) ? 11 : ((NS % 8 == 0) ? 8 : NS);
    static_assert(kw % 32 == 0 && NS % GRP == 0, "skinny K split");
    for (int it = G - 1 - bid; it < nitems; it += G) {
        const int n0 = it * 16;
        const GAS bf16_t* ap = (const GAS bf16_t*)A + (size_t)fr * K + wid * kw + 8 * fq;
        const GAS bf16_t* bp = (const GAS bf16_t*)Bt + (size_t)(n0 + fr) * K + wid * kw + 8 * fq;
        f32x4 acc0 = {0.f, 0.f, 0.f, 0.f}, acc1 = acc0;
#pragma unroll 1
        for (int g = 0; g < NS; g += GRP) {
            bf16x8 a0[GRP], a1[GRP], bv[GRP];
#pragma unroll
            for (int i = 0; i < GRP; ++i) { const int k = (g + i) * 32; a0[i] = *(const GAS bf16x8*)(ap + k); a1[i] = *(const GAS bf16x8*)(ap + (size_t)16 * K + k); bv[i] = *(const GAS bf16x8*)(bp + k); }
#pragma unroll
            for (int i = 0; i < GRP; ++i) { acc0 = __builtin_amdgcn_mfma_f32_16x16x32_bf16(a0[i], bv[i], acc0, 0, 0, 0); acc1 = __builtin_amdgcn_mfma_f32_16x16x32_bf16(a1[i], bv[i], acc1, 0, 0, 0); }
        }
#pragma unroll
        for (int j = 0; j < 4; ++j) { P[(wid * 32 + 4 * fq + j) * 17 + fr] = acc0[j]; P[(wid * 32 + 16 + 4 * fq + j) * 17 + fr] = acc1[j]; }
        __syncthreads();
        if (tid < 64) {
            const int r = tid >> 1, c0 = (tid & 1) * 8;
            f32x4 l0 = {0.f, 0.f, 0.f, 0.f}, h0 = l0, l1 = l0, h1 = l0;
#pragma unroll
            for (int w = 0; w < 4; ++w)
#pragma unroll
                for (int e = 0; e < 4; ++e) {
                    l0[e] += P[(w * 32 + r) * 17 + c0 + e]; h0[e] += P[(w * 32 + r) * 17 + c0 + 4 + e];
                    l1[e] += P[((w + 4) * 32 + r) * 17 + c0 + e]; h1[e] += P[((w + 4) * 32 + r) * 17 + c0 + 4 + e];
                }
            const int row = MP + r, col0 = n0 + c0;
            if constexpr (MODE == 3) {
                float ea[8], eb[8]; load_gates(args, row, col0, ea, eb); f32x4 lo, hi;
#pragma unroll
                for (int e = 0; e < 4; ++e) { lo[e] = l0[e] * rcpf_(1.f + ea[e]) + l1[e] * rcpf_(1.f + eb[e]); hi[e] = h0[e] * rcpf_(1.f + ea[e + 4]) + h1[e] * rcpf_(1.f + eb[e + 4]); }
                epi8<30>(args, row, col0, lo, hi);
            } else {
                epi8<MODE>(args, row, col0, l0 + l1, h0 + h1);
            }
        }
        __syncthreads();
    }
}

__device__ __forceinline__ void p0_transpose_item(const GAS float* W, int K, int N, GAS bf16_t* WT, int ldt, int k_off, int up_mode, LAS float* scr, int item, int lane) {
    const int nblk = N / 32, kb = item / nblk, nb = item % nblk, k0 = 64 * kb, n0 = 32 * nb;
    int rowbase = n0;
    if (up_mode) rowbase = n0 < DFF ? (n0 >> 7) * 256 + (n0 & 127) : ((n0 - DFF) >> 7) * 256 + 128 + ((n0 - DFF) & 127);
    {
        const int r8 = lane >> 3, c4 = (lane & 7) * 4;
        f32x4 v[8];
#pragma unroll
        for (int i = 0; i < 8; ++i) v[i] = __builtin_nontemporal_load((const GAS f32x4*)(W + (size_t)(k0 + 8 * i + r8) * N + n0 + c4));
#pragma unroll
        for (int i = 0; i < 8; ++i) { LAS float* d = scr + (8 * i + r8) * 33 + c4; d[0] = v[i].x; d[1] = v[i].y; d[2] = v[i].z; d[3] = v[i].w; }
    }
    asm volatile("s_waitcnt lgkmcnt(0)" ::: "memory");
    const int c = lane & 7;
#pragma unroll
    for (int j = 0; j < 4; ++j) { const int n = (lane >> 3) + 8 * j; const LAS float* s = scr + (8 * c) * 33 + n;
        u32x4 o; o.x = cvt_pk_bf16(s[0 * 33], s[1 * 33]); o.y = cvt_pk_bf16(s[2 * 33], s[3 * 33]); o.z = cvt_pk_bf16(s[4 * 33], s[5 * 33]); o.w = cvt_pk_bf16(s[6 * 33], s[7 * 33]);
        *(GAS u32x4*)(WT + (size_t)(rowbase + n) * ldt + k_off + k0 + 8 * c) = o; }
    asm volatile("s_waitcnt lgkmcnt(0)" ::: "memory");
}

template <int SET>
__device__ __forceinline__ void late_weights(const Args& a, LAS unsigned char* lds, int w0, int nw, int wid_in) {
    const int lane = fresh_lane();
    unsigned char* ws = a.ws;
    LAS float* scr = (LAS float*)(lds + wid_in * 16384);
    constexpr int I_BR = 16 * 64, I_O = 32 * 64, I_UP = 32 * 352, I_DN = 88 * 64, I_G = 32 * 64, I_P = 4 * 64;
    if constexpr (SET == 1) {
        for (int it = w0; it < 2 * I_BR + I_O + I_P + I_UP; it += nw) {
            int r = it;
            if (r < I_BR) { p0_transpose_item((const GAS float*)a.in[15], 1024, 2048, (GAS bf16_t*)(ws + WS_WM), 2048, 0, 0, scr, r, lane); continue; } r -= I_BR;
            if (r < I_BR) { p0_transpose_item((const GAS float*)a.in[16], 1024, 2048, (GAS bf16_t*)(ws + WS_WM), 2048, 1024, 0, scr, r, lane); continue; } r -= I_BR;
            if (r < I_O) { p0_transpose_item((const GAS float*)a.in[18], 2048, 2048, (GAS bf16_t*)(ws + WS_WO), 2048, 0, 0, scr, r, lane); continue; } r -= I_O;
            if (r < I_P) { p0_transpose_item((const GAS float*)a.in[23], PLE, 2048, (GAS bf16_t*)(ws + WS_WP), PLE, 0, 0, scr, r, lane); continue; } r -= I_P;
            p0_transpose_item((const GAS float*)a.in[19], 2048, 2 * DFF, (GAS bf16_t*)(ws + WS_WUP), 2048, 0, 1, scr, r, lane);
        }
    } else {
        for (int it = w0; it < I_DN + I_G; it += nw) {
            int r = it;
            if (r < I_DN) { p0_transpose_item((const GAS float*)a.in[22], DFF, 2048, (GAS bf16_t*)(ws + WS_WDN), DFF, 0, 0, scr, r, lane); continue; } r -= I_DN;
            p0_transpose_item((const GAS float*)a.in[24], 2048, 2048, (GAS bf16_t*)(ws + WS_WG), 2048, 0, 0, scr, r, lane);
        }
    }
}
__device__ __forceinline__ void p0_prologue(const Args& a, LAS unsigned char* lds, int bid, int G, int wid_in) {
    const int wid = wid_in, lane = fresh_lane(), tid = wid * 64 + lane;
    const int gw = bid * 8 + wid, NGW = G * 8, gtid = bid * 512 + tid, GT = G * 512;
    unsigned char* ws = a.ws;
    LAS float* scr = (LAS float*)(lds + wid * 16384);
    constexpr int I_IN = 32 * 264;
    for (int it = gw; it < I_IN; it += NGW) p0_transpose_item((const GAS float*)a.in[12], 2048, INC, (GAS bf16_t*)(ws + WS_WIN), 2048, 0, 0, scr, it, lane);
    if (gw < MT) {
        f32x4 g[8];
        { const GAS f32x4* gp = (const GAS f32x4*)a.in[8] + lane;
#pragma unroll
          for (int j = 0; j < 8; ++j) g[j] = gp[64 * j]; }
        int m = gw; f32x4 v[8];
        { const GAS f32x4* xr = (const GAS f32x4*)x_row(a, m) + lane;
#pragma unroll
          for (int j = 0; j < 8; ++j) v[j] = xr[64 * j]; }
        for (;;) {
            const int mn = m + NGW; const bool has = mn < MT; const int mp = has ? mn : m;
            f32x4 nv[8];
            { const GAS f32x4* xr = (const GAS f32x4*)x_row(a, mp) + lane;
#pragma unroll
              for (int j = 0; j < 8; ++j) nv[j] = xr[64 * j]; }
            float s = 0.f;
#pragma unroll
            for (int j = 0; j < 8; ++j) s += (v[j].x * v[j].x + v[j].y * v[j].y) + (v[j].z * v[j].z + v[j].w * v[j].w);
            const float rstd = 1.f / sqrtf(wave_sum(s) * (1.f / DM) + EPS);
            GAS u32x2* o = (GAS u32x2*)((GAS bf16_t*)(ws + WS_H) + (size_t)m * DM) + lane;
#pragma unroll
            for (int j = 0; j < 8; ++j) { u32x2 w; w.x = cvt_pk_bf16(v[j].x * rstd * g[j].x, v[j].y * rstd * g[j].y); w.y = cvt_pk_bf16(v[j].z * rstd * g[j].z, v[j].w * rstd * g[j].w); o[64 * j] = w; }
            if (!has) break;
#pragma unroll
            for (int j = 0; j < 8; ++j) v[j] = nv[j];
            m = mn;
        }
    }
    for (int i = gtid; i < MT * 32; i += GT) {
        const int row = i >> 5, c8 = (i & 31) * 8;
        const GAS float* src = row < MP ? (const GAS float*)a.in[6] + (size_t)row * PLE + c8 : (const GAS float*)a.in[7] + (size_t)(row - MP) * PLE + c8;
        const f32x4 lo = *(const GAS f32x4*)src, hi = *(const GAS f32x4*)(src + 4);
        *(GAS u32x4*)((GAS bf16_t*)(ws + WS_PB) + (size_t)row * PLE + c8) = pack8(lo, hi);
    }
    for (int i = gtid; i < 4097 * 32; i += GT) {
        const int pi = i >> 5, fi = i & 31; const int pos = pi < 4096 ? pi : 16384;
        double inv = 1.0; for (int k = 0; k < fi; ++k) inv *= 0.7498942093324559;
        const float ang = (float)pos * (float)inv;
        double f = (double)ang * 0.15915494309189535; f -= __builtin_rint(f);
        GAS float* o = (GAS float*)(ws + WS_ROPE) + (size_t)i * 2;
        o[0] = __builtin_amdgcn_cosf((float)f); o[1] = __builtin_amdgcn_sinf((float)f);
    }
    for (int i = gtid; i < MS * CW; i += GT) { const int b = i / CW, c = i % CW; ((GAS float*)a.out)[O_CS + (size_t)(b * 2) * CW + c] = ((const GAS float*)a.in[4])[(size_t)(b * 2 + 1) * CW + c]; }
    for (int i = gtid; i < MS * DFF; i += GT) { const int b = i / DFF, c = i % DFF; ((GAS float*)a.out)[O_FS + (size_t)(b * 2) * DFF + c] = ((const GAS float*)a.in[5])[(size_t)(b * 2 + 1) * DFF + c]; }
}

constexpr int QS = 72, VS = 280;
__device__ __forceinline__ void rope8r(const f32x4* t, const float* x1, const float* x2, float sc, float* o1, float* o2) {
    const float c[8] = {t[0].x, t[0].z, t[1].x, t[1].z, t[2].x, t[2].z, t[3].x, t[3].z}, s[8] = {t[0].y, t[0].w, t[1].y, t[1].w, t[2].y, t[2].w, t[3].y, t[3].w};
#pragma unroll
    for (int e = 0; e < 8; ++e) { o1[e] = (x1[e] * c[e] - x2[e] * s[e]) * sc; o2[e] = (x2[e] * c[e] + x1[e] * s[e]) * sc; }
}
struct AttnRegs { u32x4 q1[4], q2[4], kc1, kc2, kp1, kp2, vv[4]; f32x4 rq[4], rp[4]; };
__device__ __forceinline__ void attn_load(const Args& a, int u, int tid, AttnRegs& R) {
    const int hq = u & 1, kv = (u >> 1) & 1, j = (u >> 2) & 31, n = u >> 7, h0 = kv * 8 + hq * 4;
    const GAS bf16_t* P1 = (const GAS bf16_t*)(a.ws + WS_PROJ1);
    const GAS float* ROPE = (const GAS float*)(a.ws + WS_ROPE);
    const bool hasprev = j > 0;
    const int r = tid >> 2, g = tid & 3, posq = j * 128 + r, posp = hasprev ? posq - 128 : posq;
    const GAS bf16_t* rowq = P1 + (size_t)(n * SEQ + posq) * P1C;
    const GAS bf16_t* rowp = P1 + (size_t)(n * SEQ + posp) * P1C;
#pragma unroll
    for (int i = 0; i < 4; ++i) { R.q1[i] = *(const GAS u32x4*)(rowq + (h0 + i) * 64 + 8 * g); R.q2[i] = *(const GAS u32x4*)(rowq + (h0 + i) * 64 + 32 + 8 * g); }
    R.kc1 = *(const GAS u32x4*)(rowq + C_K + kv * 64 + 8 * g); R.kc2 = *(const GAS u32x4*)(rowq + C_K + kv * 64 + 32 + 8 * g);
    R.kp1 = *(const GAS u32x4*)(rowp + C_K + kv * 64 + 8 * g); R.kp2 = *(const GAS u32x4*)(rowp + C_K + kv * 64 + 32 + 8 * g);
    const GAS f32x4* rq = (const GAS f32x4*)(ROPE + (size_t)(posq * 32 + 8 * g) * 2);
    const GAS f32x4* rp = (const GAS f32x4*)(ROPE + (size_t)(posp * 32 + 8 * g) * 2);
#pragma unroll
    for (int i = 0; i < 4; ++i) { R.rq[i] = rq[i]; R.rp[i] = rp[i]; }
    const int vk = tid >> 3, dg = tid & 7;
#pragma unroll
    for (int ps = 0; ps < 4; ++ps) {
        const int c = ps * 64 + vk; const int pos = (ps < 2) ? (hasprev ? j * 128 - 128 + c : j * 128 + c) : j * 128 - 128 + c;
        R.vv[ps] = *(const GAS u32x4*)(P1 + (size_t)(n * SEQ + pos) * P1C + C_V + kv * 64 + 8 * dg);
    }
}
constexpr int QBUF = 128 * QS;
__device__ __forceinline__ void attn_write_q(LAS bf16_t* Qb, const AttnRegs& R, int i, int tid) {
    const int r = tid >> 2, g = tid & 3;
    float x1[8], x2[8], o1[8], o2[8];
    unpack8(R.q1[i], x1); unpack8(R.q2[i], x2); rope8r(R.rq, x1, x2, 0.125f, o1, o2);
    *(LAS u32x4*)(Qb + r * QS + 8 * g) = pack8a(o1); *(LAS u32x4*)(Qb + r * QS + 32 + 8 * g) = pack8a(o2);
}

__device__ __forceinline__ void attn_prompt_unit(const Args& a, LAS unsigned char* lds, int u, int wid_in) {
    const int wid = wid_in, lane = fresh_lane(), tid = wid * 64 + lane, fr = lane & 15, fq = lane >> 4;
    const int hq = u & 1, kv = (u >> 1) & 1, j = (u >> 2) & 31, n = u >> 7, h0 = kv * 8 + hq * 4;
    LAS bf16_t* Qs0 = (LAS bf16_t*)lds; LAS bf16_t* Ks = Qs0 + 2 * QBUF; LAS bf16_t* Vt = Ks + 256 * QS;
    const bool wr_state = (j == 31) && (hq == 0);
    const bool hasprev = j > 0;
    AttnRegs R; attn_load(a, u, tid, R);
    {
        const int r = tid >> 2, g = tid & 3, vk = tid >> 3, dg = tid & 7;
        float x1[8], x2[8], o1[8], o2[8];
        attn_write_q(Qs0, R, 0, tid);
        unpack8(R.kc1, x1); unpack8(R.kc2, x2); rope8r(R.rq, x1, x2, 1.f, o1, o2);
        if (wr_state) {
            GAS float* o = (GAS float*)a.out + O_KP + ((size_t)(n * 128 + r) * 2 + kv) * 64 + 8 * g;
            *(GAS f32x4*)o = (f32x4){o1[0], o1[1], o1[2], o1[3]}; *(GAS f32x4*)(o + 4) = (f32x4){o1[4], o1[5], o1[6], o1[7]};
            *(GAS f32x4*)(o + 32) = (f32x4){o2[0], o2[1], o2[2], o2[3]}; *(GAS f32x4*)(o + 36) = (f32x4){o2[4], o2[5], o2[6], o2[7]};
        }
        *(LAS u32x4*)(Ks + (128 + r) * QS + 8 * g) = pack8a(o1); *(LAS u32x4*)(Ks + (128 + r) * QS + 32 + 8 * g) = pack8a(o2);
        unpack8(R.kp1, x1); unpack8(R.kp2, x2); rope8r(R.rp, x1, x2, hasprev ? 1.f : 0.f, o1, o2);
        *(LAS u32x4*)(Ks + r * QS + 8 * g) = pack8a(o1); *(LAS u32x4*)(Ks + r * QS + 32 + 8 * g) = pack8a(o2);
#pragma unroll
        for (int ps = 0; ps < 4; ++ps) {
            const int c = ps * 64 + vk;
            u32x4 w = R.vv[ps];
            if (ps < 2 && !hasprev) w = (u32x4){0u, 0u, 0u, 0u};
            const unsigned ww[4] = {w.x, w.y, w.z, w.w};
#pragma unroll
            for (int e = 0; e < 4; ++e) { Vt[(8 * dg + 2 * e) * VS + c] = (bf16_t)(ww[e] & 0xffffu); Vt[(8 * dg + 2 * e + 1) * VS + c] = (bf16_t)(ww[e] >> 16); }
            if (ps >= 2 && wr_state) {
                float v[8]; unpack8(w, v);
                GAS float* o = (GAS float*)a.out + O_VP + ((size_t)(n * 128 + (c - 128)) * 2 + kv) * 64 + 8 * dg;
                *(GAS f32x4*)o = (f32x4){v[0], v[1], v[2], v[3]}; *(GAS f32x4*)(o + 4) = (f32x4){v[4], v[5], v[6], v[7]};
            }
        }
    }
    for (int i = tid; i < 64 * 24; i += 512) Vt[(i / 24) * VS + 256 + (i % 24)] = 0;
    __syncthreads();
#pragma unroll
    for (int hi = 0; hi < 4; ++hi) {
    const int h = h0 + hi;
    LAS bf16_t* Qs = Qs0 + (hi & 1) * QBUF;
    if (hi < 3) attn_write_q(Qs0 + ((hi + 1) & 1) * QBUF, R, hi + 1, tid);
    const bf16x8 bq0 = *(const LAS bf16x8*)(Qs + (16 * wid + fr) * QS + 8 * fq), bq1 = *(const LAS bf16x8*)(Qs + (16 * wid + fr) * QS + 32 + 8 * fq);
    f32x4 s[9], s2[9];
#pragma unroll
    for (int b = 0; b < 9; ++b) {
        const int kb = wid + b;
        const bf16x8 k0 = *(const LAS bf16x8*)(Ks + (16 * kb + fr) * QS + 8 * fq), k1 = *(const LAS bf16x8*)(Ks + (16 * kb + fr) * QS + 32 + 8 * fq);
        const f32x4 z = {0.f, 0.f, 0.f, 0.f};
        s[b] = __builtin_amdgcn_mfma_f32_16x16x32_bf16(k0, bq0, z, 0, 0, 0);
        s2[b] = __builtin_amdgcn_mfma_f32_16x16x32_bf16(k1, bq1, z, 0, 0, 0);
    }
    __builtin_amdgcn_sched_barrier(0);
    asm volatile("s_nop 7\n\ts_nop 7" ::: "memory");
#pragma unroll
    for (int b = 0; b < 9; ++b) { asm volatile("" : "+v"(s[b]), "+v"(s2[b])); s[b] = s[b] + s2[b]; }
    const float sink = ((const GAS float*)a.in[13])[h];
    const int qi = 16 * wid + fr;
    float mx = sink;
#pragma unroll
    for (int b = 0; b < 9; ++b)
#pragma unroll
        for (int e = 0; e < 4; ++e) {
            const int c = 16 * (wid + b) + 4 * fq + e;
            const bool ok = (c > qi) && (c <= qi + 128) && (j > 0 || c >= 128);
            s[b][e] = ok ? s[b][e] : -1e30f;
            mx = fmaxf(mx, s[b][e]);
        }
    mx = fmaxf(mx, __shfl_xor(mx, 16)); mx = fmaxf(mx, __shfl_xor(mx, 32));
    float sum = 0.f;
#pragma unroll
    for (int b = 0; b < 9; ++b)
#pragma unroll
        for (int e = 0; e < 4; ++e) { const float p = s[b][e] > -1e29f ? __expf(s[b][e] - mx) : 0.f; s[b][e] = p; sum += p; }
    sum += __shfl_xor(sum, 16); sum += __shfl_xor(sum, 32);
    const float inv = 1.f / (sum + __expf(sink - mx));
    f32x4 ot[5][4];
#pragma unroll
    for (int pi = 0; pi < 5; ++pi) {
        const int kb0 = wid + 2 * pi, kb1 = kb0 + 1;
        u32x4 pw; pw.x = cvt_pk_bf16(s[2 * pi][0], s[2 * pi][1]); pw.y = cvt_pk_bf16(s[2 * pi][2], s[2 * pi][3]);
        if (pi < 4) { pw.z = cvt_pk_bf16(s[2 * pi + 1 < 9 ? 2 * pi + 1 : 8][0], s[2 * pi + 1 < 9 ? 2 * pi + 1 : 8][1]); pw.w = cvt_pk_bf16(s[2 * pi + 1 < 9 ? 2 * pi + 1 : 8][2], s[2 * pi + 1 < 9 ? 2 * pi + 1 : 8][3]); }
        else { pw.z = 0u; pw.w = 0u; }
        const bf16x8 pb = __builtin_bit_cast(bf16x8, pw);
#pragma unroll
        for (int d = 0; d < 4; ++d) {
            const u32x2 lo = *(const LAS u32x2*)(Vt + (16 * d + fr) * VS + 16 * kb0 + 4 * fq), hi = *(const LAS u32x2*)(Vt + (16 * d + fr) * VS + 16 * kb1 + 4 * fq);
            const u32x4 vw = {lo.x, lo.y, hi.x, hi.y};
            const f32x4 zz = {0.f, 0.f, 0.f, 0.f};
            ot[pi][d] = __builtin_amdgcn_mfma_f32_16x16x32_bf16(__builtin_bit_cast(bf16x8, vw), pb, zz, 0, 0, 0);
        }
    }
    __builtin_amdgcn_sched_barrier(0);
    asm volatile("s_nop 7\n\ts_nop 7" ::: "memory");
    f32x4 o[4];
#pragma unroll
    for (int d = 0; d < 4; ++d) {
#pragma unroll
        for (int pi = 0; pi < 5; ++pi) asm volatile("" : "+v"(ot[pi][d]));
        o[d] = ((ot[0][d] + ot[1][d]) + (ot[2][d] + ot[3][d])) + ot[4][d];
    }
    GAS bf16_t* dst = (GAS bf16_t*)(a.ws + WS_AB) + (size_t)(n * SEQ + j * 128 + qi) * DM + h * 64 + 4 * fq;
#pragma unroll
    for (int d = 0; d < 4; ++d) { u32x2 w; w.x = cvt_pk_bf16(o[d][0] * inv, o[d][1] * inv); w.y = cvt_pk_bf16(o[d][2] * inv, o[d][3] * inv); *(GAS u32x2*)(dst + 16 * d) = w; }
    __syncthreads();
    }
}

__device__ __forceinline__ void attn_sample_unit(const Args& a, LAS unsigned char* lds, int b, int wid_in) {
    const int wid = wid_in, lane = fresh_lane(), tid = wid * 64 + lane;
    LAS float* qf = (LAS float*)lds;
    LAS float* kn = qf + 1024;
    LAS float* vn = kn + 128;
    LAS float* S = vn + 128;
    LAS float* KV = (LAS float*)(lds + 16384);
    constexpr int KS_ = 129;
    const GAS bf16_t* prow = (const GAS bf16_t*)(a.ws + WS_PROJ1) + (size_t)(MP + b) * P1C;
    const GAS float* rp = (const GAS float*)(a.ws + WS_ROPE) + (size_t)4096 * 64;
    const GAS float* sk = (const GAS float*)a.in[2] + (size_t)b * 128 * 128 + 128;
    const GAS float* sv = (const GAS float*)a.in[3] + (size_t)b * 128 * 128 + 128;
    GAS float* ok = (GAS float*)a.out + O_KS + (size_t)b * 16384;
    GAS float* ov = (GAS float*)a.out + O_VS + (size_t)b * 16384;
    f32x4 kreg[8], vreg[8];
#pragma unroll
    for (int q = 0; q < 8; ++q) { const int i4 = tid + 512 * q; const bool ok_ = i4 < 127 * 32; const int j4 = ok_ ? i4 : 0;
        kreg[q] = *(const GAS f32x4*)(sk + (size_t)j4 * 4); vreg[q] = *(const GAS f32x4*)(sv + (size_t)j4 * 4); }
    {
        const int h = tid >> 5, i = tid & 31; const float c = rp[2 * i], s = rp[2 * i + 1];
        const float x1 = bf1(prow[h * 64 + i]), x2 = bf1(prow[h * 64 + 32 + i]);
        qf[h * 64 + i] = (x1 * c - x2 * s) * 0.125f; qf[h * 64 + 32 + i] = (x2 * c + x1 * s) * 0.125f;
        if (tid < 64) { const float y1 = bf1(prow[C_K + h * 64 + i]), y2 = bf1(prow[C_K + h * 64 + 32 + i]); kn[h * 64 + i] = y1 * c - y2 * s; kn[h * 64 + 32 + i] = y2 * c + y1 * s; }
        if (tid < 128) vn[tid] = bf1(prow[C_V + tid]);
    }
#pragma unroll
    for (int q = 0; q < 8; ++q) { const int i4 = tid + 512 * q; if (i4 < 127 * 32) { const int i = i4 >> 5, c4 = (i4 & 31) * 4; LAS float* d = KV + i * KS_ + c4;
        d[0] = kreg[q].x; d[1] = kreg[q].y; d[2] = kreg[q].z; d[3] = kreg[q].w; *(GAS f32x4*)(ok + (size_t)i4 * 4) = kreg[q]; *(GAS f32x4*)(ov + (size_t)i4 * 4) = vreg[q]; } }
    __syncthreads();
    if (tid < 128) { KV[127 * KS_ + tid] = kn[tid]; ok[127 * 128 + tid] = kn[tid]; ov[127 * 128 + tid] = vn[tid]; }
    __syncthreads();
#pragma unroll
    for (int cc = 0; cc < 4; ++cc) {
        const int idx = tid + 512 * cc, h = idx >> 7, i = idx & 127, kv = h >> 3;
        float d = 0.f;
#pragma unroll 16
        for (int e = 0; e < 64; ++e) d += KV[i * KS_ + kv * 64 + e] * qf[h * 64 + e];
        S[h * 128 + i] = d;
    }
    __syncthreads();
#pragma unroll
    for (int hh = 0; hh < 2; ++hh) {
        const int h = wid * 2 + hh; const float sink = ((const GAS float*)a.in[13])[h];
        const float s0 = S[h * 128 + lane], s1 = S[h * 128 + 64 + lane];
        const float mx = fmaxf(wave_max(fmaxf(s0, s1)), sink);
        const float p0 = __expf(s0 - mx), p1 = __expf(s1 - mx);
        const float inv = 1.f / (wave_sum(p0 + p1) + __expf(sink - mx));
        S[h * 128 + lane] = p0 * inv; S[h * 128 + 64 + lane] = p1 * inv;
    }
#pragma unroll
    for (int q = 0; q < 8; ++q) { const int i4 = tid + 512 * q; if (i4 < 127 * 32) { const int i = i4 >> 5, c4 = (i4 & 31) * 4; LAS float* d = KV + i * KS_ + c4;
        d[0] = vreg[q].x; d[1] = vreg[q].y; d[2] = vreg[q].z; d[3] = vreg[q].w; } }
    if (tid < 128) KV[127 * KS_ + tid] = vn[tid];
    __syncthreads();
#pragma unroll
    for (int cc = 0; cc < 2; ++cc) {
        const int idx = tid + 512 * cc, h = idx >> 6, d = idx & 63, kv = h >> 3;
        float acc = 0.f;
#pragma unroll 16
        for (int i = 0; i < 128; ++i) acc += S[h * 128 + i] * KV[i * KS_ + kv * 64 + d];
        ((GAS bf16_t*)(a.ws + WS_AB))[(size_t)(MP + b) * DM + h * 64 + d] = (bf16_t)(cvt_pk_bf16(acc, 0.f) & 0xffffu);
    }
    __syncthreads();
}

__device__ __forceinline__ void convb_item(const Args& a, int item, int lane) {
    const int rb = item >> 1, c0 = (item & 1) * 512 + lane * 8, row0 = rb * 8;
    const GAS bf16_t* P1 = (const GAS bf16_t*)(a.ws + WS_PROJ1);
    const GAS float* cw = (const GAS float*)a.in[14] + c0;
    float w0[8], w1[8], w2[8];
    { const f32x4 a0 = *(const GAS f32x4*)cw, a1 = *(const GAS f32x4*)(cw + 4), b0 = *(const GAS f32x4*)(cw + CW), b1 = *(const GAS f32x4*)(cw + CW + 4), c0v = *(const GAS f32x4*)(cw + 2 * CW), c1v = *(const GAS f32x4*)(cw + 2 * CW + 4);
#pragma unroll
      for (int e = 0; e < 4; ++e) { w0[e] = a0[e]; w0[e + 4] = a1[e]; w1[e] = b0[e]; w1[e + 4] = b1[e]; w2[e] = c0v[e]; w2[e + 4] = c1v[e]; } }
    float p2[8], p1[8];
    const bool prompt = row0 < MP;
    const bool halo = prompt && (row0 & (SEQ - 1)) != 0;
    const int hr = halo ? row0 - 2 : row0;
    const u32x4 hx0 = *(const GAS u32x4*)(P1 + (size_t)hr * P1C + C_CC + c0), hy0 = *(const GAS u32x4*)(P1 + (size_t)hr * P1C + C_CU + c0);
    const u32x4 hx1 = *(const GAS u32x4*)(P1 + (size_t)(hr + 1) * P1C + C_CC + c0), hy1 = *(const GAS u32x4*)(P1 + (size_t)(hr + 1) * P1C + C_CU + c0);
    u32x4 vb[8], vc[8], vu[8];
#pragma unroll
    for (int r = 0; r < 8; ++r) { const GAS bf16_t* pr = P1 + (size_t)(row0 + r) * P1C + c0; vb[r] = *(const GAS u32x4*)(pr + C_CB); vc[r] = *(const GAS u32x4*)(pr + C_CC); vu[r] = *(const GAS u32x4*)(pr + C_CU); }
    { float x[8], y[8]; unpack8(hx0, x); unpack8(hy0, y);
#pragma unroll
      for (int e = 0; e < 8; ++e) p2[e] = halo ? x[e] * y[e] : 0.f;
      unpack8(hx1, x); unpack8(hy1, y);
#pragma unroll
      for (int e = 0; e < 8; ++e) p1[e] = halo ? x[e] * y[e] : 0.f; }
#pragma unroll
    for (int r = 0; r < 8; ++r) {
        const int row = row0 + r;
        if (!prompt) {
            const GAS float* st = (const GAS float*)a.in[4] + (size_t)(row - MP) * 2 * CW + c0;
            const f32x4 s0 = *(const GAS f32x4*)st, s1 = *(const GAS f32x4*)(st + 4), s2 = *(const GAS f32x4*)(st + CW), s3 = *(const GAS f32x4*)(st + CW + 4);
#pragma unroll
            for (int e = 0; e < 4; ++e) { p2[e] = s0[e]; p2[e + 4] = s1[e]; p1[e] = s2[e]; p1[e + 4] = s3[e]; }
        }
        float cb[8], x[8], y[8], cx[8], ov[8];
        unpack8(vb[r], cb); unpack8(vc[r], x); unpack8(vu[r], y);
#pragma unroll
        for (int e = 0; e < 8; ++e) { cx[e] = x[e] * y[e]; ov[e] = cb[e] * (w0[e] * p2[e] + w1[e] * p1[e] + w2[e] * cx[e]); }
        *(GAS u32x4*)((GAS bf16_t*)(a.ws + WS_AB) + (size_t)row * DM + 1024 + c0) = pack8a(ov);
        GAS float* so = nullptr;
        if (prompt) { const int t = row & (SEQ - 1); if (t >= SEQ - 2) so = (GAS float*)a.out + O_CP + (size_t)((row >> 12) * 2 + (t - (SEQ - 2))) * CW + c0; }
        else so = (GAS float*)a.out + O_CS + (size_t)((row - MP) * 2 + 1) * CW + c0;
        if (so) { *(GAS f32x4*)so = (f32x4){cx[0], cx[1], cx[2], cx[3]}; *(GAS f32x4*)(so + 4) = (f32x4){cx[4], cx[5], cx[6], cx[7]}; }
#pragma unroll
        for (int e = 0; e < 8; ++e) { p2[e] = p1[e]; p1[e] = cx[e]; }
    }
}

template <bool FIRST>
__device__ __forceinline__ void resnorm_rows(const Args& a, int gw, int NGW, int lane) {
    f32x4 g1[8], g2[8];
    { const GAS f32x4* p1 = (const GAS f32x4*)a.in[FIRST ? 9 : 11] + lane; const GAS f32x4* p2 = (const GAS f32x4*)a.in[10] + lane;
#pragma unroll
      for (int j = 0; j < 8; ++j) { g1[j] = p1[64 * j]; g2[j] = FIRST ? p2[64 * j] : (f32x4){0.f, 0.f, 0.f, 0.f}; } }
    int m = gw; if (m >= MT) return;
    const GAS bf16_t* SRC = (const GAS bf16_t*)(a.ws + (FIRST ? WS_MO : WS_F));
    const GAS bf16_t* X1B = (const GAS bf16_t*)(a.ws + WS_X1B);
    f32x4 v[8], x[8];
    { const GAS u32x2* sr = (const GAS u32x2*)(SRC + (size_t)m * DM) + lane;
#pragma unroll
      for (int j = 0; j < 8; ++j) { const u32x2 w = sr[64 * j]; v[j] = (f32x4){bflo(w.x), bfhi(w.x), bflo(w.y), bfhi(w.y)}; }
      if (FIRST) { const GAS f32x4* xr = (const GAS f32x4*)x_row(a, m) + lane;
#pragma unroll
        for (int j = 0; j < 8; ++j) x[j] = xr[64 * j]; }
      else { const GAS u32x2* xr = (const GAS u32x2*)(X1B + (size_t)m * DM) + lane;
#pragma unroll
        for (int j = 0; j < 8; ++j) { const u32x2 w = xr[64 * j]; x[j] = (f32x4){bflo(w.x), bfhi(w.x), bflo(w.y), bfhi(w.y)}; } } }
    for (;;) {
        const int mn = m + NGW; const bool has = mn < MT; const int mp = has ? mn : m;
        u32x2 nw[8]; f32x4 nx[8]; u32x2 nxb[8];
        { const GAS u32x2* sr = (const GAS u32x2*)(SRC + (size_t)mp * DM) + lane;
#pragma unroll
          for (int j = 0; j < 8; ++j) nw[j] = sr[64 * j];
          if (FIRST) { const GAS f32x4* xr = (const GAS f32x4*)x_row(a, mp) + lane;
#pragma unroll
            for (int j = 0; j < 8; ++j) nx[j] = xr[64 * j]; }
          else { const GAS u32x2* xr = (const GAS u32x2*)(X1B + (size_t)mp * DM) + lane;
#pragma unroll
            for (int j = 0; j < 8; ++j) nxb[j] = xr[64 * j]; } }
        float s = 0.f;
#pragma unroll
        for (int j = 0; j < 8; ++j) s += (v[j].x * v[j].x + v[j].y * v[j].y) + (v[j].z * v[j].z + v[j].w * v[j].w);
        const float rstd = 1.f / sqrtf(wave_sum(s) * (1.f / DM) + EPS);
        float s2 = 0.f;
        GAS u32x2* xo = (GAS u32x2*)((GAS bf16_t*)(a.ws + (FIRST ? WS_X1B : WS_H)) + (size_t)m * DM) + lane;
#pragma unroll
        for (int j = 0; j < 8; ++j) { v[j] = x[j] + v[j] * rstd * g1[j]; u32x2 w; w.x = cvt_pk_bf16(v[j].x, v[j].y); w.y = cvt_pk_bf16(v[j].z, v[j].w); xo[64 * j] = w;
            s2 += (v[j].x * v[j].x + v[j].y * v[j].y) + (v[j].z * v[j].z + v[j].w * v[j].w); }
        if (FIRST) {
            GAS u32x2* ho = (GAS u32x2*)((GAS bf16_t*)(a.ws + WS_H) + (size_t)m * DM) + lane;
            const float rstd2 = 1.f / sqrtf(wave_sum(s2) * (1.f / DM) + EPS);
#pragma unroll
            for (int j = 0; j < 8; ++j) { u32x2 w; w.x = cvt_pk_bf16(v[j].x * rstd2 * g2[j].x, v[j].y * rstd2 * g2[j].y); w.y = cvt_pk_bf16(v[j].z * rstd2 * g2[j].z, v[j].w * rstd2 * g2[j].w); ho[64 * j] = w; }
        }
        if (!has) break;
#pragma unroll
        for (int j = 0; j < 8; ++j) { v[j] = (f32x4){bflo(nw[j].x), bfhi(nw[j].x), bflo(nw[j].y), bfhi(nw[j].y)};
            x[j] = FIRST ? nx[j] : (f32x4){bflo(nxb[j].x), bfhi(nxb[j].x), bflo(nxb[j].y), bfhi(nxb[j].y)}; }
        m = mn;
    }
}

__device__ __forceinline__ void ffnfix_item(const Args& a, int item, int lane) {
    const int c0 = (item % 11) * 512 + lane * 8, q = item / 11;
    const GAS float* cw = (const GAS float*)a.in[20] + c0;
    const GAS float* cbp = (const GAS float*)a.in[21] + c0;
    float w0[8], w1[8], w2[8], bb[8];
    { const f32x4 a0 = *(const GAS f32x4*)cw, a1 = *(const GAS f32x4*)(cw + 4), b0 = *(const GAS f32x4*)(cw + DFF), b1 = *(const GAS f32x4*)(cw + DFF + 4), c0v = *(const GAS f32x4*)(cw + 2 * DFF), c1v = *(const GAS f32x4*)(cw + 2 * DFF + 4),
                  d0 = *(const GAS f32x4*)cbp, d1 = *(const GAS f32x4*)(cbp + 4);
#pragma unroll
      for (int e = 0; e < 4; ++e) { w0[e] = a0[e]; w0[e + 4] = a1[e]; w1[e] = b0[e]; w1[e + 4] = b1[e]; w2[e] = c0v[e]; w2[e + 4] = c1v[e]; bb[e] = d0[e]; bb[e + 4] = d1[e]; } }
    GAS bf16_t* FIN = (GAS bf16_t*)(a.ws + WS_FIN);
    float p2[8], p1[8], x0[8], x1[8], g0[8], g1[8], ov[8];
    if (q < 128) {
        const GAS bf16_t* SA = (const GAS bf16_t*)(a.ws + WS_SA); const GAS bf16_t* SG = (const GAS bf16_t*)(a.ws + WS_SG);
        const int r0 = q * 64; const bool halo = (r0 & (SEQ - 1)) != 0; const int qp = halo ? q - 1 : q;
        const u32x4 h0 = *(const GAS u32x4*)(SA + ((size_t)qp * 4 + 0) * DFF + c0), h1 = *(const GAS u32x4*)(SA + ((size_t)qp * 4 + 1) * DFF + c0);
        const u32x4 a0 = *(const GAS u32x4*)(SA + ((size_t)q * 4 + 2) * DFF + c0), a1 = *(const GAS u32x4*)(SA + ((size_t)q * 4 + 3) * DFF + c0);
        const u32x4 gg0 = *(const GAS u32x4*)(SG + ((size_t)q * 2 + 0) * DFF + c0), gg1 = *(const GAS u32x4*)(SG + ((size_t)q * 2 + 1) * DFF + c0);
        unpack8(h0, p2); unpack8(h1, p1); unpack8(a0, x0); unpack8(a1, x1); unpack8(gg0, g0); unpack8(gg1, g1);
#pragma unroll
        for (int e = 0; e < 8; ++e) { p2[e] = halo ? p2[e] : 0.f; p1[e] = halo ? p1[e] : 0.f; }
#pragma unroll
        for (int e = 0; e < 8; ++e) ov[e] = gelu_tanh(w0[e] * p2[e] + w1[e] * p1[e] + w2[e] * x0[e] + bb[e]) * g0[e];
        *(GAS u32x4*)(FIN + (size_t)r0 * DFF + c0) = pack8a(ov);
#pragma unroll
        for (int e = 0; e < 8; ++e) ov[e] = gelu_tanh(w0[e] * p1[e] + w1[e] * x0[e] + w2[e] * x1[e] + bb[e]) * g1[e];
        *(GAS u32x4*)(FIN + (size_t)(r0 + 1) * DFF + c0) = pack8a(ov);
    } else {
        const int b = q - 128;
        const GAS float* st = (const GAS float*)a.in[5] + (size_t)b * 2 * DFF + c0;
        const f32x4 s0 = *(const GAS f32x4*)st, s1 = *(const GAS f32x4*)(st + 4), s2 = *(const GAS f32x4*)(st + DFF), s3 = *(const GAS f32x4*)(st + DFF + 4);
        const u32x4 a0 = *(const GAS u32x4*)((const GAS bf16_t*)(a.ws + WS_UAS) + (size_t)b * DFF + c0), gg0 = *(const GAS u32x4*)((const GAS bf16_t*)(a.ws + WS_UGS) + (size_t)b * DFF + c0);
        unpack8(a0, x0); unpack8(gg0, g0);
#pragma unroll
        for (int e = 0; e < 4; ++e) { p2[e] = s0[e]; p2[e + 4] = s1[e]; p1[e] = s2[e]; p1[e + 4] = s3[e]; }
#pragma unroll
        for (int e = 0; e < 8; ++e) ov[e] = gelu_tanh(w0[e] * p2[e] + w1[e] * p1[e] + w2[e] * x0[e] + bb[e]) * g0[e];
        *(GAS u32x4*)(FIN + (size_t)(MP + b) * DFF + c0) = pack8a(ov);
    }
}

#define XB_TMO      128
#define XB_XCNT(j)  (256  + 64 * (j))
#define XB_XSUB(j)  (1280 + 64 * (j))
#define XB_XGEN(j)  (2304 + 64 * (j))
#define XB_TOP      3328
#define XB_TOPGEN   3392
#define XCD_BAR_WORDS 3456
#define XB_SPIN_CAP (1u << 18)
__device__ __forceinline__ unsigned xb_ld(unsigned* p)              { return __hip_atomic_load(p, __ATOMIC_RELAXED, __HIP_MEMORY_SCOPE_AGENT); }
__device__ __forceinline__ unsigned xb_add(unsigned* p, unsigned v) { return __hip_atomic_fetch_add(p, v, __ATOMIC_RELAXED, __HIP_MEMORY_SCOPE_AGENT); }
__device__ __forceinline__ unsigned xb_xcc_id() { return (unsigned)__builtin_amdgcn_s_getreg((3 << 11) | 20) & 0xFu; }
#define XB_SPIN(cond, bar) do { unsigned _sp = 0; while (cond) { __builtin_amdgcn_s_sleep(1); \
    if ((++_sp & 255u) == 0u) { if (xb_ld(&(bar)[XB_TMO])) break; if (_sp > XB_SPIN_CAP) { atomicAdd(&(bar)[XB_TMO], 1u); break; } } } } while (0)
__device__ __forceinline__ void xcd_barrier_complete(unsigned* bar, unsigned x, unsigned G, unsigned& nloc, unsigned& nx) {
    unsigned sum, cnt, mine, sp = 0u;
    for (;;) {
        sum = 0u; cnt = 0u; mine = 0u;
#pragma unroll
        for (unsigned j = 0; j < 16; ++j) { const unsigned c = xb_ld(&bar[XB_XCNT(j)]); sum += c; cnt += (c > 0u) ? 1u : 0u; mine = (j == x) ? c : mine; }
        if (sum == G) break;
        __builtin_amdgcn_s_sleep(1);
        if ((++sp & 255u) == 0u) { if (xb_ld(&bar[XB_TMO])) break; if (sp > XB_SPIN_CAP) { atomicAdd(&bar[XB_TMO], 1u); break; } }
    }
    nloc = mine > 0u ? mine : 1u; nx = cnt > 0u ? cnt : 1u;
}
__device__ __forceinline__ void grid_barrier(unsigned* bar, volatile LAS unsigned* st, unsigned G, int wid_in) {
    asm volatile("s_waitcnt vmcnt(0)" ::: "memory");
    __syncthreads();
    if (wid_in == 0 && fresh_lane() == 0) {
        __builtin_amdgcn_s_waitcnt(0);
        const unsigned x = xb_xcc_id();
        unsigned nloc = st[0], nx = st[1];
        if (nloc == 0u) { xcd_barrier_complete(bar, x, G, nloc, nx); st[0] = nloc; st[1] = nx; }
        const unsigned old = xb_add(&bar[XB_XSUB(x)], 1u);
        const unsigned gen = old / nloc;
        if (old + 1u == (gen + 1u) * nloc) {
            __builtin_amdgcn_fence(__ATOMIC_RELEASE, "agent");
            asm volatile("s_waitcnt vmcnt(0)" ::: "memory");
            const unsigned og = xb_add(&bar[XB_TOP], 1u);
            const unsigned tg = og / nx;
            if (og + 1u == (tg + 1u) * nx) xb_add(&bar[XB_TOPGEN], 1u);
            else XB_SPIN(xb_ld(&bar[XB_TOPGEN]) == tg, bar);
            __builtin_amdgcn_fence(__ATOMIC_ACQUIRE, "agent");
            xb_add(&bar[XB_XGEN(x)], 1u);
            asm volatile("s_waitcnt vmcnt(0)" ::: "memory");
        } else {
            XB_SPIN(xb_ld(&bar[XB_XGEN(x)]) == gen, bar);
            __builtin_amdgcn_fence(__ATOMIC_ACQUIRE, "agent");
            asm volatile("s_waitcnt vmcnt(0)" ::: "memory");
        }
    }
    __syncthreads();
}

template <int MODE, int N, int K>
__device__ __forceinline__ void gemm_job(LAS unsigned char* lds, const Args& a, size_t offA, size_t offB, int G, int bid, int wid) {
    const bf16_t* A = (const bf16_t*)(a.ws + offA); const bf16_t* Bt = (const bf16_t*)(a.ws + offB);
    pg8::gemm_phase<MODE, N, K>(lds, a, A, Bt, G, bid, wid);
    skinny_gemm<MODE, N, K>(lds, a, A + (size_t)MP * K, Bt, G, bid, wid);
}

__global__ void __launch_bounds__(512, 2) hybrid_fwd(Args a) {
    __shared__ __attribute__((aligned(16))) unsigned char lds_raw[LDS_BYTES];
    LAS unsigned char* lds = (LAS unsigned char*)lds_raw;
    const int wid = __builtin_amdgcn_readfirstlane((int)threadIdx.x >> 6);
    const int G = gridDim.x, bid = blockIdx.x, gw = bid * 8 + wid, NGW = G * 8;
    const int lo = a.ph_lo, hi = a.ph_hi;
    if (lo > 1000) { __threadfence(); cg::this_grid().sync(); }
    if (hi - lo > 1) {
        if (wid == 0) { const int l = fresh_lane(); if (l < 2) ((volatile LAS unsigned*)(lds + 131072))[l] = 0u; if (l == 0) (void)xb_add((unsigned*)a.ws + XB_XCNT(xb_xcc_id()), 1u); }
        __syncthreads();
    }
#define IN(k) (lo <= (k) && (k) < hi)
#define SEAM(k) do { if (IN(k) && IN((k) + 1)) grid_barrier((unsigned*)a.ws, (volatile LAS unsigned*)(lds + 131072), (unsigned)G, wid); } while (0)
#ifdef PROBE_PHASE
    if (IN(100)) {
        const int gtid = bid * 512 + wid * 64 + fresh_lane(), GT = G * 512;
        const GAS bf16_t* b16 = (const GAS bf16_t*)(a.ws + 4 * MiB); const size_t n = (size_t)(341 * MiB / 2), NOUT = 16842752;
        for (size_t i = gtid; i < NOUT; i += GT) { float acc = 0.f; for (size_t k = i; k < n; k += NOUT) acc += bf1(b16[k]); ((GAS float*)a.out)[i] = acc; }
    }
#endif
    if (IN(0)) p0_prologue(a, lds, bid, G, wid);
    SEAM(0);
    if (IN(1)) {
        gemm_job<1, INC, 2048>(lds, a, WS_H, WS_WIN, G, bid, wid);
        constexpr int NFULL = (MP / 256) * (INC / 256) % 256;
        const int first = (G == 256) ? NFULL : 0;
        if (bid >= first) late_weights<1>(a, lds, (bid - first) * 8 + wid, (G - first) * 8, wid);
    }
    SEAM(1);
    if (IN(2)) {
#ifndef SKIP_PA
        for (int u = bid; u < 256; u += G) attn_prompt_unit(a, lds, u, wid);
#endif
        if (bid >= G - MS) attn_sample_unit(a, lds, G - 1 - bid, wid);
        for (int it = gw; it < (MT / 8) * 2; it += NGW) convb_item(a, it, fresh_lane());
    }
    SEAM(2);
    if (IN(3)) gemm_job<3, 2048, 2048>(lds, a, WS_AB, WS_WM, G, bid, wid);
    SEAM(3);
    if (IN(4)) gemm_job<4, 2048, 2048>(lds, a, WS_MERGED, WS_WO, G, bid, wid);
    SEAM(4);
    if (IN(5)) resnorm_rows<true>(a, gw, NGW, fresh_lane());
    SEAM(5);
    if (IN(6)) {
        gemm_job<6, 2 * DFF, 2048>(lds, a, WS_H, WS_WUP, G, bid, wid);
        constexpr int NFULL = (MP / 256) * (2 * DFF / 256) % 256;
        const int first = (G == 256) ? NFULL : 0;
        if (bid >= first) {
            late_weights<2>(a, lds, (bid - first) * 8 + wid, (G - first) * 8, wid);
            __syncthreads();
            gemm_job<9, 2048, PLE>(lds, a, WS_PB, WS_WP, G - first, bid - first, wid);
        }
    }
    SEAM(6);
    if (IN(7)) { for (int it = gw; it < (128 + MS) * 11; it += NGW) ffnfix_item(a, it, fresh_lane()); }
    SEAM(7);
    if (IN(8)) gemm_job<8, 2048, DFF>(lds, a, WS_FIN, WS_WDN, G, bid, wid);
    SEAM(8);
    if (IN(9)) resnorm_rows<false>(a, gw, NGW, fresh_lane());
    SEAM(9);
    if (IN(10)) gemm_job<10, 2048, 2048>(lds, a, WS_H, WS_WG, G, bid, wid);
#undef IN
#undef SEAM
}

extern "C" void kernel_launch(void* const* d_in, const int* in_sizes, int n_in, void* d_out, int out_size, void* d_ws, size_t ws_size, hipStream_t stream) {
    static int grid = 0;
    if (grid == 0) {
        if (n_in != 25 || ws_size < WS_END) { fprintf(stderr, "kernel_launch: unexpected n_in %d / ws_size %zu\n", n_in, ws_size); grid = -1; return; }
        int dev = 0, cus = 0, per_cu = 0;
        if (hipGetDevice(&dev) != hipSuccess || hipDeviceGetAttribute(&cus, hipDeviceAttributeMultiprocessorCount, dev) != hipSuccess) { grid = -1; return; }
        if (hipOccupancyMaxActiveBlocksPerMultiprocessor(&per_cu, (const void*)hybrid_fwd, 512, 0) != hipSuccess || per_cu < 1) { fprintf(stderr, "kernel_launch: occupancy query says %d\n", per_cu); per_cu = 1; }
        (void)hipGetLastError();
        grid = cus;
    }
    if (grid < 0) return;
    if (hipMemsetAsync(d_ws, 0, 16384, stream) != hipSuccess) { fprintf(stderr, "kernel_launch: memset failed\n"); return; }
    Args a{};
    for (int i = 0; i < 25; ++i) a.in[i] = (const float*)d_in[i];
    a.out = (float*)d_out; a.ws = (unsigned char*)d_ws;
#if MK_N_LAUNCHES == 1
    a.ph_lo = 0; a.ph_hi = NPHASE;
    void* kargs[] = {&a};
    hipError_t e = hipLaunchCooperativeKernel((const void*)hybrid_fwd, dim3(grid), dim3(512), kargs, 0, stream);
    if (e != hipSuccess) fprintf(stderr, "cooperative launch failed: %s (grid %d)\n", hipGetErrorString(e), grid);
#else
#ifdef PROBE_PHASE
    for (int ph = 0; ph <= PROBE_PHASE; ++ph) { a.ph_lo = ph; a.ph_hi = ph + 1; hipLaunchKernelGGL(hybrid_fwd, dim3(grid), dim3(512), 0, stream, a); }
    a.ph_lo = 100; a.ph_hi = 101; hipLaunchKernelGGL(hybrid_fwd, dim3(grid), dim3(512), 0, stream, a);
#else
    for (int ph = 0; ph < NPHASE; ++ph) {
        a.ph_lo = ph; a.ph_hi = ph + 1;
        for (int rep = 0; rep < 1 + ((REPMASK >> ph) & 1); ++rep)
            hipLaunchKernelGGL(hybrid_fwd, dim3(grid), dim3(512), 0, stream, a);
    }
#endif
#endif
}
```

```cpp
#include <hip/hip_runtime.h>
#include <hip/hip_cooperative_groups.h>
#include <cstdio>
#include <cstdint>
namespace cg = cooperative_groups;


#ifndef MK_N_LAUNCHES
#define MK_N_LAUNCHES 1
#define REPMASK 0x00
#endif

#define LAS __attribute__((address_space(3)))
#define GAS __attribute__((address_space(1)))
typedef unsigned short bf16_t;
typedef short bf16x8 __attribute__((ext_vector_type(8)));
typedef float f32x4 __attribute__((ext_vector_type(4)));
typedef float f32x16 __attribute__((ext_vector_type(16)));
typedef unsigned u32x4 __attribute__((ext_vector_type(4)));
typedef unsigned u32x2 __attribute__((ext_vector_type(2)));

constexpr int DM = 2048, SEQ = 4096, MP = 8192, MS = 32, MT = MP + MS;
constexpr int DFF = 5632, INC = 8448, CW = 1024, PLE = 256;
constexpr int P1C = 4352;
constexpr int C_K = 1024, C_V = 1152, C_CB = 1280, C_CC = 2304, C_CU = 3328;
constexpr float EPS = 1e-6f;
constexpr size_t O_YP = 0, O_YS = 16777216, O_KP = 16842752, O_VP = 16875520, O_CP = 16908288, O_FP = 16912384,
                 O_KS = 16934912, O_VS = 17459200, O_CS = 17983488, O_FS = 18049024;
constexpr size_t MiB = 1u << 20;
constexpr size_t WS_ROPE = 1 * MiB;
constexpr size_t WS_WIN = 4 * MiB, WS_WM = 37 * MiB, WS_WO = 45 * MiB, WS_WUP = 53 * MiB, WS_WDN = 97 * MiB, WS_WG = 119 * MiB, WS_WP = 127 * MiB;
constexpr size_t WS_H = 128 * MiB;
constexpr size_t WS_R = 161 * MiB;
constexpr size_t WS_PROJ1 = WS_R, WS_PROJ2 = 230 * MiB, WS_AB = 295 * MiB;
constexpr size_t WS_MERGED = WS_R, WS_MO = 230 * MiB;
constexpr size_t WS_SA = 4 * MiB;
constexpr size_t WS_SG = 10 * MiB;
constexpr size_t WS_UAS = 13 * MiB, WS_UGS = 13 * MiB + 512 * 1024;
constexpr size_t WS_PP = 16 * MiB;
constexpr size_t WS_FIN = WS_R;
constexpr size_t WS_F = 250 * MiB;
constexpr size_t WS_X1B = 295 * MiB;
constexpr size_t WS_PB = 340 * MiB;
constexpr size_t WS_END = 345 * MiB;
constexpr int LDS_BYTES = 147456;
constexpr int NPHASE = 11;

struct Args { const float* in[25]; float* out; unsigned char* ws; int ph_lo, ph_hi; };

__device__ __forceinline__ unsigned cvt_pk_bf16(float lo, float hi) { unsigned r; asm("v_cvt_pk_bf16_f32 %0, %1, %2" : "=v"(r) : "v"(lo), "v"(hi)); return r; }
__device__ __forceinline__ float bflo(unsigned w) { return __uint_as_float(w << 16); }
__device__ __forceinline__ float bfhi(unsigned w) { return __uint_as_float(w & 0xffff0000u); }
__device__ __forceinline__ float bf1(bf16_t b) { return __uint_as_float(((unsigned)b) << 16); }
__device__ __forceinline__ void unpack8(u32x4 w, float* f) { f[0] = bflo(w.x); f[1] = bfhi(w.x); f[2] = bflo(w.y); f[3] = bfhi(w.y); f[4] = bflo(w.z); f[5] = bfhi(w.z); f[6] = bflo(w.w); f[7] = bfhi(w.w); }
__device__ __forceinline__ u32x4 pack8(f32x4 lo, f32x4 hi) { u32x4 w; w.x = cvt_pk_bf16(lo[0], lo[1]); w.y = cvt_pk_bf16(lo[2], lo[3]); w.z = cvt_pk_bf16(hi[0], hi[1]); w.w = cvt_pk_bf16(hi[2], hi[3]); return w; }
__device__ __forceinline__ u32x4 pack8a(const float* f) { u32x4 w; w.x = cvt_pk_bf16(f[0], f[1]); w.y = cvt_pk_bf16(f[2], f[3]); w.z = cvt_pk_bf16(f[4], f[5]); w.w = cvt_pk_bf16(f[6], f[7]); return w; }
__device__ __forceinline__ int fresh_lane() { int l; asm volatile("v_mbcnt_lo_u32_b32 %0, -1, 0\n\tv_mbcnt_hi_u32_b32 %0, -1, %0" : "=v"(l)); return l; }
#define NTL(p) __builtin_nontemporal_load(p)
__device__ __forceinline__ float wave_sum(float v) {
#pragma unroll
    for (int o = 1; o < 64; o <<= 1) v += __shfl_xor(v, o);
    return v;
}
__device__ __forceinline__ float wave_max(float v) {
#pragma unroll
    for (int o = 1; o < 64; o <<= 1) v = fmaxf(v, __shfl_xor(v, o));
    return v;
}
__device__ __forceinline__ float rcpf_(float x) { return __builtin_amdgcn_rcpf(x); }
__device__ __forceinline__ float sigm(float x) { return rcpf_(1.f + __expf(-x)); }
__device__ __forceinline__ float gelu_tanh(float x) { const float u = 0.7978845608028654f * (x + 0.044715f * x * x * x); return x * rcpf_(1.f + __expf(-2.f * u)); }
__device__ __forceinline__ const GAS float* x_row(const Args& a, int row) {
    return row < MP ? (const GAS float*)a.in[0] + (size_t)row * DM : (const GAS float*)a.in[1] + (size_t)(row - MP) * DM;
}

__device__ __forceinline__ void load_gates(const Args& a, int row, int col0, float* ea, float* eb) {
    const GAS bf16_t* p2 = (const GAS bf16_t*)(a.ws + WS_PROJ2) + (size_t)row * 4096 + col0;
    const u32x4 wa = *(const GAS u32x4*)p2, wb = *(const GAS u32x4*)(p2 + 2048);
    const GAS float* bg = (const GAS float*)a.in[17] + col0;
    const f32x4 b0l = *(const GAS f32x4*)bg, b0h = *(const GAS f32x4*)(bg + 4), b1l = *(const GAS f32x4*)(bg + 2048), b1h = *(const GAS f32x4*)(bg + 2052);
    float ga[8], gb[8]; unpack8(wa, ga); unpack8(wb, gb);
#pragma unroll
    for (int e = 0; e < 4; ++e) {
        ea[e] = fminf(__expf(-(ga[e] + b0l[e])), 1e30f); ea[e + 4] = fminf(__expf(-(ga[e + 4] + b0h[e])), 1e30f);
        eb[e] = fminf(__expf(-(gb[e] + b1l[e])), 1e30f); eb[e + 4] = fminf(__expf(-(gb[e + 4] + b1h[e])), 1e30f);
    }
}

template <int MODE>
__device__ __forceinline__ void epi8(const Args& a, int row, int col0, f32x4 lo, f32x4 hi) {
    unsigned char* ws = a.ws;
    if constexpr (MODE == 1) {
        GAS bf16_t* p = col0 < P1C ? (GAS bf16_t*)(ws + WS_PROJ1) + (size_t)row * P1C + col0 : (GAS bf16_t*)(ws + WS_PROJ2) + (size_t)row * 4096 + (col0 - P1C);
        *(GAS u32x4*)p = pack8(lo, hi);
    } else if constexpr (MODE == 3) {
        float ea[8], eb[8]; load_gates(a, row, col0, ea, eb);
#pragma unroll
        for (int e = 0; e < 4; ++e) { lo[e] = lo[e] * rcpf_(1.f + eb[e]); hi[e] = hi[e] * rcpf_(1.f + eb[e + 4]); }
        *(GAS u32x4*)((GAS bf16_t*)(ws + WS_MERGED) + (size_t)row * DM + col0) = pack8(lo, hi);
    } else if constexpr (MODE == 30) {
        *(GAS u32x4*)((GAS bf16_t*)(ws + WS_MERGED) + (size_t)row * DM + col0) = pack8(lo, hi);
    } else if constexpr (MODE == 4) {
        *(GAS u32x4*)((GAS bf16_t*)(ws + WS_MO) + (size_t)row * DM + col0) = pack8(lo, hi);
    } else if constexpr (MODE == 6) {
        const int ch = (col0 >> 8) * 128 + (col0 & 127);
        if (((col0 >> 7) & 1) == 0) {
            *(GAS u32x4*)((GAS bf16_t*)(ws + WS_UAS) + (size_t)(row - MP) * DFF + ch) = pack8(lo, hi);
            GAS float* o = (GAS float*)a.out + O_FS + (size_t)((row - MP) * 2 + 1) * DFF + ch; *(GAS f32x4*)o = lo; *(GAS f32x4*)(o + 4) = hi;
        } else {
            *(GAS u32x4*)((GAS bf16_t*)(ws + WS_UGS) + (size_t)(row - MP) * DFF + ch) = pack8(lo, hi);
        }
    } else if constexpr (MODE == 8) {
        *(GAS u32x4*)((GAS bf16_t*)(ws + WS_F) + (size_t)row * DM + col0) = pack8(lo, hi);
    } else if constexpr (MODE == 9) {
        *(GAS u32x4*)((GAS bf16_t*)(ws + WS_PP) + (size_t)row * DM + col0) = pack8(lo, hi);
    } else if constexpr (MODE == 10) {
        GAS float* o = (GAS float*)a.out + (size_t)row * DM + col0;
        const u32x4 xw = *(const GAS u32x4*)((const GAS bf16_t*)(ws + WS_H) + (size_t)row * DM + col0);
        const u32x4 pw = NTL((const GAS u32x4*)((const GAS bf16_t*)(ws + WS_PP) + (size_t)row * DM + col0));
        float pp[8], xx[8]; unpack8(pw, pp); unpack8(xw, xx); f32x4 y0, y1;
#pragma unroll
        for (int e = 0; e < 4; ++e) { y0[e] = xx[e] + sigm(lo[e]) * pp[e]; y1[e] = xx[e + 4] + sigm(hi[e]) * pp[e + 4]; }
        *(GAS f32x4*)o = y0; *(GAS f32x4*)(o + 4) = y1;
    }
}

__device__ __forceinline__ void glds_s(const char* sbase, unsigned voff, unsigned lds_dst) {
    unsigned keep;
    asm volatile("s_mov_b32 %0, m0\n\ts_mov_b32 m0, %3\n\ts_nop 0\n\tglobal_load_lds_dwordx4 %1, %2\n\ts_mov_b32 m0, %0" : "=&s"(keep) : "v"(voff), "s"(sbase), "s"(lds_dst) : "memory");
}
namespace pg8 {
constexpr int BM = 256, BK = 64, HALF = 128, HTB = HALF * BK * 2, STAGE_BYTES = 8 * HTB, NXCD = 8, WGM = 8;
__host__ __device__ __forceinline__ int lds_byte(int r, int c) { const int st = (r >> 4) * 2 + (c >> 5), rr = r & 15, cc = c & 31, ob = rr * 64 + cc * 2; return st * 1024 + (ob ^ (((ob >> 9) & 1) << 5)); }
__host__ __device__ __forceinline__ void stage_rc(int b, int& R, int& C) { const int st = b / 1024, sb = b % 1024, swz = sb ^ (((sb >> 9) & 1) << 5); R = (st >> 1) * 16 + swz / 64; C = (st & 1) * 32 + (swz % 64) / 2; }
__host__ __device__ __forceinline__ int perm32(int rho) { const int n = rho >> 4, i = rho & 15; return 8 * (i >> 2) + 4 * n + (i & 3); }
struct Unit { int pm, pn; };
struct StaticOrder {
    int nM, nN, nwg, G, c;
    __device__ void init(int M, int N, int G_, int c_) { nM = M / BM; nN = N / BM; nwg = nM * nN; G = G_; c = c_; }
    __device__ bool next(int i, Unit& u) const {
        const long L = (long)i * G + c; if (L >= nwg) return false;
        int wgid = (int)L; { const int q = nwg / NXCD, r = nwg % NXCD, xcd = wgid % NXCD, off = wgid / NXCD; wgid = (xcd < r ? xcd * (q + 1) : r * (q + 1) + (xcd - r) * q) + off; }
        const int nig = WGM * nN, gid = wgid / nig, fm = gid * WGM, gsz = (nM - fm) < WGM ? (nM - fm) : WGM;
        u.pm = fm + ((wgid % nig) % gsz); u.pn = (wgid % nig) / gsz; return true;
    }
};

template <int MODE>
__device__ __forceinline__ void tile_epi(const Args& a, const f32x4 (&acc)[2][2][4][2], const Unit& u, int wr, int wc, int fr, int fq) {
#pragma unroll
    for (int ai = 0; ai < 2; ++ai)
#pragma unroll
        for (int m = 0; m < 4; ++m)
#pragma unroll
            for (int bj = 0; bj < 2; ++bj)
                epi8<MODE>(a, u.pm * BM + ai * HALF + wr * 64 + m * 16 + fr, u.pn * BM + bj * HALF + wc * 32 + 8 * fq, acc[ai][bj][m][0], acc[ai][bj][m][1]);
}
template <int CTRL> __device__ __forceinline__ float dppf(float old, float src) {
    return __int_as_float(__builtin_amdgcn_update_dpp(__float_as_int(old), __float_as_int(src), CTRL, 0xf, 0xf, false));
}
__device__ __forceinline__ void tile_epi6(const Args& a, const f32x4 (&acc)[2][2][4][2], const Unit& u, int wr, int wc, int fr, int fq) {
    const int ch0 = u.pn * 128 + wc * 32 + 8 * fq;
    const GAS float* cw = (const GAS float*)a.in[20] + ch0; const GAS float* cbp = (const GAS float*)a.in[21] + ch0;
    float w0[8], w1[8], w2[8], bb[8];
    { const f32x4 a0 = *(const GAS f32x4*)cw, a1 = *(const GAS f32x4*)(cw + 4), b0 = *(const GAS f32x4*)(cw + DFF), b1 = *(const GAS f32x4*)(cw + DFF + 4), c0v = *(const GAS f32x4*)(cw + 2 * DFF), c1v = *(const GAS f32x4*)(cw + 2 * DFF + 4),
                  d0 = *(const GAS f32x4*)cbp, d1 = *(const GAS f32x4*)(cbp + 4);
#pragma unroll
      for (int e = 0; e < 4; ++e) { w0[e] = a0[e]; w0[e + 4] = a1[e]; w1[e] = b0[e]; w1[e + 4] = b1[e]; w2[e] = c0v[e]; w2[e + 4] = c1v[e]; bb[e] = d0[e]; bb[e + 4] = d1[e]; } }
    GAS bf16_t* FIN = (GAS bf16_t*)(a.ws + WS_FIN); GAS bf16_t* SA = (GAS bf16_t*)(a.ws + WS_SA); GAS bf16_t* SG = (GAS bf16_t*)(a.ws + WS_SG);
#pragma unroll
    for (int ai = 0; ai < 2; ++ai)
#pragma unroll
        for (int m = 0; m < 4; ++m) {
            const int row = u.pm * BM + ai * HALF + wr * 64 + m * 16 + fr, grp = row >> 6;
            float ov[8];
#pragma unroll
            for (int n = 0; n < 2; ++n)
#pragma unroll
                for (int e = 0; e < 4; ++e) {
                    const float cur = acc[ai][0][m][n][e];
                    float r1 = 0.f, r2 = 0.f;
                    if (m > 0) { const float pv = acc[ai][0][m > 0 ? m - 1 : 0][n][e]; r1 = dppf<0x121>(0.f, pv); r2 = dppf<0x122>(0.f, pv); }
                    const float p1 = dppf<0x111>(r1, cur), p2 = dppf<0x112>(r2, cur);
                    const int k = 4 * n + e;
                    ov[k] = gelu_tanh(w0[k] * p2 + w1[k] * p1 + w2[k] * cur + bb[k]) * acc[ai][1][m][n][e];
                }
            if (m == 0 && fr < 2) {
                *(GAS u32x4*)(SA + ((size_t)grp * 4 + 2 + fr) * DFF + ch0) = pack8(acc[ai][0][m][0], acc[ai][0][m][1]);
                *(GAS u32x4*)(SG + ((size_t)grp * 2 + fr) * DFF + ch0) = pack8(acc[ai][1][m][0], acc[ai][1][m][1]);
            } else {
                *(GAS u32x4*)(FIN + (size_t)row * DFF + ch0) = pack8a(ov);
            }
            if (m == 3 && fr >= 14) {
                *(GAS u32x4*)(SA + ((size_t)grp * 4 + (fr - 14)) * DFF + ch0) = pack8(acc[ai][0][m][0], acc[ai][0][m][1]);
                const int t = row & (SEQ - 1);
                if (t >= SEQ - 2) { GAS float* o = (GAS float*)a.out + O_FP + (size_t)((row >> 12) * 2 + (t - (SEQ - 2))) * DFF + ch0; *(GAS f32x4*)o = acc[ai][0][m][0]; *(GAS f32x4*)(o + 4) = acc[ai][0][m][1]; }
            }
        }
}
__device__ __forceinline__ void mid_scale(const Args& a, f32x4 (&acc)[2][2][4][2], const Unit& u, int wr, int wc, int fr, int fq) {
    int z = 0; asm volatile("" : "+v"(z));
    fr += z;
#pragma unroll
    for (int ai = 0; ai < 2; ++ai)
#pragma unroll
        for (int m = 0; m < 4; ++m)
#pragma unroll
            for (int bj = 0; bj < 2; ++bj) {
                float ea[8], eb[8]; load_gates(a, u.pm * BM + ai * HALF + wr * 64 + m * 16 + fr, u.pn * BM + bj * HALF + wc * 32 + 8 * fq, ea, eb);
#pragma unroll
                for (int e = 0; e < 4; ++e) { acc[ai][bj][m][0][e] *= (1.f + eb[e]) * rcpf_(1.f + ea[e]); acc[ai][bj][m][1][e] *= (1.f + eb[e + 4]) * rcpf_(1.f + ea[e + 4]); }
                __builtin_amdgcn_sched_barrier(0);
            }
}

template <int MODE, int N, int K>
__device__ __forceinline__ void gemm_phase(LAS unsigned char* lds, const Args& args, const bf16_t* gA, const bf16_t* gBt, int G, int bid, int wid_in) {
    const int wid = wid_in, lane = fresh_lane(), tid = wid * 64 + lane, wr = wid >> 2, wc = wid & 3, fr = lane & 15, fq = lane >> 4;
    const int nt = K / BK;
    StaticOrder S; S.init(MP, N, G, bid);
    unsigned voffA, voffB;
    { int R, C; stage_rc(tid * 16, R, C); const int Rb = (R & ~31) + perm32(R & 31); voffA = (unsigned)(R * K + C) * 2u; voffB = (unsigned)(Rb * K + C) * 2u; }
    const unsigned ldsbase = (unsigned)(size_t)lds;
    const size_t kstep = (size_t)(BK * 2);
    const size_t hstep = (size_t)HALF * K * 2;
    const size_t tstep = 2 * hstep;
    const unsigned ldsw = (unsigned)wid * 1024u;
    const int aoff = lds_byte(wr * 64 + fr, fq * 8), boff = lds_byte(wc * 32 + fr, fq * 8);
#define PG8_SA(b, h) (((b) * 2 + (h)) * HTB)
#define PG8_SB(b, h) ((4 + (b) * 2 + (h)) * HTB)
#define PG8_STAGE(bufoff, gbase, voff) do { glds_s((const char*)(gbase), (voff), ldsbase + (unsigned)(bufoff) + ldsw); \
        glds_s((const char*)(gbase) + (size_t)64 * K * 2, (voff), ldsbase + (unsigned)(bufoff) + ldsw + 8192u); } while (0)
#define PG8_LDA(dst, b, h) do { _Pragma("unroll") for (int m = 0; m < 4; ++m) _Pragma("unroll") for (int k = 0; k < 2; ++k) dst[m][k] = *(const LAS bf16x8*)(lds + PG8_SA(b, h) + aoff + m * 2048 + k * 1024); } while (0)
#define PG8_LDB(dst, b, h) do { _Pragma("unroll") for (int n = 0; n < 2; ++n) _Pragma("unroll") for (int k = 0; k < 2; ++k) dst[n][k] = *(const LAS bf16x8*)(lds + PG8_SB(b, h) + boff + n * 2048 + k * 1024); } while (0)
#define PG8_MMA(ai, bj, At, Bt) do { __builtin_amdgcn_s_setprio(1); _Pragma("unroll") for (int m = 0; m < 4; ++m) _Pragma("unroll") for (int n = 0; n < 2; ++n) _Pragma("unroll") for (int k = 0; k < 2; ++k) \
        acc[ai][bj][m][n] = __builtin_amdgcn_mfma_f32_16x16x32_bf16(Bt[n][k], At[m][k], acc[ai][bj][m][n], 0, 0, 0); __builtin_amdgcn_s_setprio(0); } while (0)
#define PG8_WAIT_V(n) asm volatile("s_waitcnt vmcnt(" #n ")" ::: "memory")
#define PG8_WAIT_L(n) asm volatile("s_waitcnt lgkmcnt(" #n ")" ::: "memory")
#define PG8_BAR __builtin_amdgcn_s_barrier()
#define PG8_SCHED __builtin_amdgcn_sched_barrier(0)
    Unit cur, nxt; int ui = 0;
    if (!S.next(0, cur)) return;
    f32x4 acc[2][2][4][2];
#pragma unroll
    for (int a = 0; a < 2; ++a)
#pragma unroll
        for (int b = 0; b < 2; ++b)
#pragma unroll
            for (int m = 0; m < 4; ++m)
#pragma unroll
                for (int n = 0; n < 2; ++n) acc[a][b][m][n] = (f32x4){0.f, 0.f, 0.f, 0.f};
    bf16x8 At[4][2], B0[2][2], B1[2][2];
    const char* cA = (const char*)gA + (size_t)cur.pm * tstep; const char* cB = (const char*)gBt + (size_t)cur.pn * tstep;
    PG8_STAGE(PG8_SB(0, 0), cB, voffB); PG8_STAGE(PG8_SB(0, 1), cB + hstep, voffB); PG8_STAGE(PG8_SA(0, 0), cA, voffA); PG8_STAGE(PG8_SA(0, 1), cA + hstep, voffA);
    if (wr == 1) PG8_BAR;
    PG8_WAIT_V(2); PG8_BAR;
    PG8_STAGE(PG8_SB(1, 0), cB + kstep, voffB); PG8_STAGE(PG8_SA(1, 0), cA + kstep, voffA); PG8_STAGE(PG8_SB(1, 1), cB + hstep + kstep, voffB);
    PG8_WAIT_V(6); PG8_BAR;
    for (;;) {
        const bool has_next = S.next(ui + 1, nxt);
        const char* nA = has_next ? (const char*)gA + (size_t)nxt.pm * tstep : cA; const char* nB = has_next ? (const char*)gBt + (size_t)nxt.pn * tstep : cB;
        for (int t = 0; t < nt; t += 2) {
            const bool last = (t == nt - 2);
            const char* a1 = cA + (size_t)(t + 1) * kstep;
            const char* a2 = last ? nA : cA + (size_t)(t + 2) * kstep; const char* b2 = last ? nB : cB + (size_t)(t + 2) * kstep;
            const char* a3 = a2 + kstep; const char* b3 = b2 + kstep;
            if constexpr (MODE == 3) { if (t == (nt >> 1)) { mid_scale(args, acc, cur, wr, wc, fr, fq); PG8_SCHED; } }
            PG8_LDB(B0, 0, 0); PG8_LDB(B1, 0, 1); PG8_SCHED; PG8_LDA(At, 0, 0); PG8_STAGE(PG8_SA(1, 1), a1 + hstep, voffA);
            PG8_WAIT_V(8); PG8_WAIT_L(0); PG8_BAR; PG8_MMA(0, 0, At, B0); PG8_MMA(0, 1, At, B1); PG8_BAR; PG8_SCHED;
            PG8_LDA(At, 0, 1); PG8_STAGE(PG8_SB(0, 0), b2, voffB); PG8_STAGE(PG8_SB(0, 1), b2 + hstep, voffB); PG8_STAGE(PG8_SA(0, 0), a2, voffA);
            PG8_WAIT_V(8); PG8_WAIT_L(0); PG8_BAR; PG8_MMA(1, 0, At, B0); PG8_MMA(1, 1, At, B1); PG8_BAR; PG8_SCHED;
            PG8_LDB(B0, 1, 0); PG8_LDB(B1, 1, 1); PG8_SCHED; PG8_LDA(At, 1, 0); PG8_STAGE(PG8_SA(0, 1), a2 + hstep, voffA);
            PG8_WAIT_V(8); PG8_WAIT_L(0); PG8_BAR; PG8_MMA(0, 0, At, B0); PG8_MMA(0, 1, At, B1); PG8_BAR; PG8_SCHED;
            PG8_LDA(At, 1, 1); PG8_STAGE(PG8_SB(1, 0), b3, voffB); PG8_STAGE(PG8_SB(1, 1), b3 + hstep, voffB); PG8_STAGE(PG8_SA(1, 0), a3, voffA);
            PG8_WAIT_V(8); PG8_WAIT_L(0); PG8_BAR; PG8_MMA(1, 0, At, B0); PG8_MMA(1, 1, At, B1); PG8_BAR; PG8_SCHED;
        }
        if (wr == 0) PG8_BAR;
        if constexpr (MODE == 6) tile_epi6(args, acc, cur, wr, wc, fr, fq); else tile_epi<MODE>(args, acc, cur, wr, wc, fr, fq);
        if (!has_next) break;
#pragma unroll
        for (int a = 0; a < 2; ++a)
#pragma unroll
            for (int b = 0; b < 2; ++b)
#pragma unroll
                for (int m = 0; m < 4; ++m)
#pragma unroll
                    for (int n = 0; n < 2; ++n) acc[a][b][m][n] = (f32x4){0.f, 0.f, 0.f, 0.f};
        cur = nxt; cA = nA; cB = nB; ++ui;
        if (wr == 1) PG8_BAR;
    }
    PG8_WAIT_V(0);
    PG8_BAR;
#undef PG8_SA
#undef PG8_SB
#undef PG8_STAGE
#undef PG8_LDA
#undef PG8_LDB
#undef PG8_MMA
#undef PG8_WAIT_V
#undef PG8_WAIT_L
#undef PG8_BAR
#undef PG8_SCHED
}
}

template <int MODE, int N, int K>
__device__ __forceinline__ void skinny_gemm(LAS unsigned char* lds, const Args& args, const bf16_t* A, const bf16_t* Bt, int G, int bid, int wid_in) {
    const int wid = wid_in, lane = fresh_lane(), tid = wid * 64 + lane, fr = lane & 15, fq = lane >> 4;
    LAS float* P = (LAS float*)lds;
    constexpr int nitems = N / 16, kw = K / 8, NS = kw / 32;
    constexpr int GRP = (NS % 11 == 0) ? 11 : ((NS % 8 == 0) ? 8 : NS);
    static_assert(kw % 32 == 0 && NS % GRP == 0, "skinny K split");
    for (int it = G - 1 - bid; it < nitems; it += G) {
        const int n0 = it * 16;
        const GAS bf16_t* ap = (const GAS bf16_t*)A + (size_t)fr * K + wid * kw + 8 * fq;
        const GAS bf16_t* bp = (const GAS bf16_t*)Bt + (size_t)(n0 + fr) * K + wid * kw + 8 * fq;
        f32x4 acc0 = {0.f, 0.f, 0.f, 0.f}, acc1 = acc0;
#pragma unroll 1
        for (int g = 0; g < NS; g += GRP) {
            bf16x8 a0[GRP], a1[GRP], bv[GRP];
#pragma unroll
            for (int i = 0; i < GRP; ++i) { const int k = (g + i) * 32; a0[i] = *(const GAS bf16x8*)(ap + k); a1[i] = *(const GAS bf16x8*)(ap + (size_t)16 * K + k); bv[i] = *(const GAS bf16x8*)(bp + k); }
#pragma unroll
            for (int i = 0; i < GRP; ++i) { acc0 = __builtin_amdgcn_mfma_f32_16x16x32_bf16(a0[i], bv[i], acc0, 0, 0, 0); acc1 = __builtin_amdgcn_mfma_f32_16x16x32_bf16(a1[i], bv[i], acc1, 0, 0, 0); }
        }
#pragma unroll
        for (int j = 0; j < 4; ++j) { P[(wid * 32 + 4 * fq + j) * 17 + fr] = acc0[j]; P[(wid * 32 + 16 + 4 * fq + j) * 17 + fr] = acc1[j]; }
        __syncthreads();
        if (tid < 64) {
            const int r = tid >> 1, c0 = (tid & 1) * 8;
            f32x4 l0 = {0.f, 0.f, 0.f, 0.f}, h0 = l0, l1 = l0, h1 = l0;
#pragma unroll
            for (int w = 0; w < 4; ++w)
#pragma unroll
                for (int e = 0; e < 4; ++e) {
                    l0[e] += P[(w * 32 + r) * 17 + c0 + e]; h0[e] += P[(w * 32 + r) * 17 + c0 + 4 + e];
                    l1[e] += P[((w + 4) * 32 + r) * 17 + c0 + e]; h1[e] += P[((w + 4) * 32 + r) * 17 + c0 + 4 + e];
                }
            const int row = MP + r, col0 = n0 + c0;
            if constexpr (MODE == 3) {
                float ea[8], eb[8]; load_gates(args, row, col0, ea, eb); f32x4 lo, hi;
#pragma unroll
                for (int e = 0; e < 4; ++e) { lo[e] = l0[e] * rcpf_(1.f + ea[e]) + l1[e] * rcpf_(1.f + eb[e]); hi[e] = h0[e] * rcpf_(1.f + ea[e + 4]) + h1[e] * rcpf_(1.f + eb[e + 4]); }
                epi8<30>(args, row, col0, lo, hi);
            } else {
                epi8<MODE>(args, row, col0, l0 + l1, h0 + h1);
            }
        }
        __syncthreads();
    }
}

__device__ __forceinline__ void p0_transpose_item(const GAS float* W, int K, int N, GAS bf16_t* WT, int ldt, int k_off, int up_mode, LAS float* scr, int item, int lane) {
    const int nblk = N / 32, kb = item / nblk, nb = item % nblk, k0 = 64 * kb, n0 = 32 * nb;
    int rowbase = n0;
    if (up_mode) rowbase = n0 < DFF ? (n0 >> 7) * 256 + (n0 & 127) : ((n0 - DFF) >> 7) * 256 + 128 + ((n0 - DFF) & 127);
    {
        const int r8 = lane >> 3, c4 = (lane & 7) * 4;
        f32x4 v[8];
#pragma unroll
        for (int i = 0; i < 8; ++i) v[i] = __builtin_nontemporal_load((const GAS f32x4*)(W + (size_t)(k0 + 8 * i + r8) * N + n0 + c4));
#pragma unroll
        for (int i = 0; i < 8; ++i) { LAS float* d = scr + (8 * i + r8) * 33 + c4; d[0] = v[i].x; d[1] = v[i].y; d[2] = v[i].z; d[3] = v[i].w; }
    }
    asm volatile("s_waitcnt lgkmcnt(0)" ::: "memory");
    const int c = lane & 7;
#pragma unroll
    for (int j = 0; j < 4; ++j) { const int n = (lane >> 3) + 8 * j; const LAS float* s = scr + (8 * c) * 33 + n;
        u32x4 o; o.x = cvt_pk_bf16(s[0 * 33], s[1 * 33]); o.y = cvt_pk_bf16(s[2 * 33], s[3 * 33]); o.z = cvt_pk_bf16(s[4 * 33], s[5 * 33]); o.w = cvt_pk_bf16(s[6 * 33], s[7 * 33]);
        *(GAS u32x4*)(WT + (size_t)(rowbase + n) * ldt + k_off + k0 + 8 * c) = o; }
    asm volatile("s_waitcnt lgkmcnt(0)" ::: "memory");
}

template <int SET>
__device__ __forceinline__ void late_weights(const Args& a, LAS unsigned char* lds, int w0, int nw, int wid_in) {
    const int lane = fresh_lane();
    unsigned char* ws = a.ws;
    LAS float* scr = (LAS float*)(lds + wid_in * 16384);
    constexpr int I_BR = 16 * 64, I_O = 32 * 64, I_UP = 32 * 352, I_DN = 88 * 64, I_G = 32 * 64, I_P = 4 * 64;
    if constexpr (SET == 1) {
        for (int it = w0; it < 2 * I_BR + I_O + I_P + I_UP; it += nw) {
            int r = it;
            if (r < I_BR) { p0_transpose_item((const GAS float*)a.in[15], 1024, 2048, (GAS bf16_t*)(ws + WS_WM), 2048, 0, 0, scr, r, lane); continue; } r -= I_BR;
            if (r < I_BR) { p0_transpose_item((const GAS float*)a.in[16], 1024, 2048, (GAS bf16_t*)(ws + WS_WM), 2048, 1024, 0, scr, r, lane); continue; } r -= I_BR;
            if (r < I_O) { p0_transpose_item((const GAS float*)a.in[18], 2048, 2048, (GAS bf16_t*)(ws + WS_WO), 2048, 0, 0, scr, r, lane); continue; } r -= I_O;
            if (r < I_P) { p0_transpose_item((const GAS float*)a.in[23], PLE, 2048, (GAS bf16_t*)(ws + WS_WP), PLE, 0, 0, scr, r, lane); continue; } r -= I_P;
            p0_transpose_item((const GAS float*)a.in[19], 2048, 2 * DFF, (GAS bf16_t*)(ws + WS_WUP), 2048, 0, 1, scr, r, lane);
        }
    } else {
        for (int it = w0; it < I_DN + I_G; it += nw) {
            int r = it;
            if (r < I_DN) { p0_transpose_item((const GAS float*)a.in[22], DFF, 2048, (GAS bf16_t*)(ws + WS_WDN), DFF, 0, 0, scr, r, lane); continue; } r -= I_DN;
            p0_transpose_item((const GAS float*)a.in[24], 2048, 2048, (GAS bf16_t*)(ws + WS_WG), 2048, 0, 0, scr, r, lane);
        }
    }
}
__device__ __forceinline__ void p0_prologue(const Args& a, LAS unsigned char* lds, int bid, int G, int wid_in) {
    const int wid = wid_in, lane = fresh_lane(), tid = wid * 64 + lane;
    const int gw = bid * 8 + wid, NGW = G * 8, gtid = bid * 512 + tid, GT = G * 512;
    unsigned char* ws = a.ws;
    LAS float* scr = (LAS float*)(lds + wid * 16384);
    constexpr int I_IN = 32 * 264;
    for (int it = gw; it < I_IN; it += NGW) p0_transpose_item((const GAS float*)a.in[12], 2048, INC, (GAS bf16_t*)(ws + WS_WIN), 2048, 0, 0, scr, it, lane);
    if (gw < MT) {
        f32x4 g[8];
        { const GAS f32x4* gp = (const GAS f32x4*)a.in[8] + lane;
#pragma unroll
          for (int j = 0; j < 8; ++j) g[j] = gp[64 * j]; }
        int m = gw; f32x4 v[8];
        { const GAS f32x4* xr = (const GAS f32x4*)x_row(a, m) + lane;
#pragma unroll
          for (int j = 0; j < 8; ++j) v[j] = xr[64 * j]; }
        for (;;) {
            const int mn = m + NGW; const bool has = mn < MT; const int mp = has ? mn : m;
            f32x4 nv[8];
            { const GAS f32x4* xr = (const GAS f32x4*)x_row(a, mp) + lane;
#pragma unroll
              for (int j = 0; j < 8; ++j) nv[j] = xr[64 * j]; }
            float s = 0.f;
#pragma unroll
            for (int j = 0; j < 8; ++j) s += (v[j].x * v[j].x + v[j].y * v[j].y) + (v[j].z * v[j].z + v[j].w * v[j].w);
            const float rstd = 1.f / sqrtf(wave_sum(s) * (1.f / DM) + EPS);
            GAS u32x2* o = (GAS u32x2*)((GAS bf16_t*)(ws + WS_H) + (size_t)m * DM) + lane;
#pragma unroll
            for (int j = 0; j < 8; ++j) { u32x2 w; w.x = cvt_pk_bf16(v[j].x * rstd * g[j].x, v[j].y * rstd * g[j].y); w.y = cvt_pk_bf16(v[j].z * rstd * g[j].z, v[j].w * rstd * g[j].w); o[64 * j] = w; }
            if (!has) break;
#pragma unroll
            for (int j = 0; j < 8; ++j) v[j] = nv[j];
            m = mn;
        }
    }
    for (int i = gtid; i < MT * 32; i += GT) {
        const int row = i >> 5, c8 = (i & 31) * 8;
        const GAS float* src = row < MP ? (const GAS float*)a.in[6] + (size_t)row * PLE + c8 : (const GAS float*)a.in[7] + (size_t)(row - MP) * PLE + c8;
        const f32x4 lo = NTL((const GAS f32x4*)src), hi = NTL((const GAS f32x4*)(src + 4));
        *(GAS u32x4*)((GAS bf16_t*)(ws + WS_PB) + (size_t)row * PLE + c8) = pack8(lo, hi);
    }
    for (int i = gtid; i < 4097 * 32; i += GT) {
        const int pi = i >> 5, fi = i & 31; const int pos = pi < 4096 ? pi : 16384;
        double inv = 1.0; for (int k = 0; k < fi; ++k) inv *= 0.7498942093324559;
        const float ang = (float)pos * (float)inv;
        double f = (double)ang * 0.15915494309189535; f -= __builtin_rint(f);
        GAS float* o = (GAS float*)(ws + WS_ROPE) + (size_t)i * 2;
        o[0] = __builtin_amdgcn_cosf((float)f); o[1] = __builtin_amdgcn_sinf((float)f);
    }
    for (int i = gtid; i < MS * CW; i += GT) { const int b = i / CW, c = i % CW; ((GAS float*)a.out)[O_CS + (size_t)(b * 2) * CW + c] = ((const GAS float*)a.in[4])[(size_t)(b * 2 + 1) * CW + c]; }
    for (int i = gtid; i < MS * DFF; i += GT) { const int b = i / DFF, c = i % DFF; ((GAS float*)a.out)[O_FS + (size_t)(b * 2) * DFF + c] = ((const GAS float*)a.in[5])[(size_t)(b * 2 + 1) * DFF + c]; }
}

constexpr int QS = 72, VS = 280;
__device__ __forceinline__ void rope8r(const f32x4* t, const float* x1, const float* x2, float sc, float* o1, float* o2) {
    const float c[8] = {t[0].x, t[0].z, t[1].x, t[1].z, t[2].x, t[2].z, t[3].x, t[3].z}, s[8] = {t[0].y, t[0].w, t[1].y, t[1].w, t[2].y, t[2].w, t[3].y, t[3].w};
#pragma unroll
    for (int e = 0; e < 8; ++e) { o1[e] = (x1[e] * c[e] - x2[e] * s[e]) * sc; o2[e] = (x2[e] * c[e] + x1[e] * s[e]) * sc; }
}
struct AttnRegs { u32x4 q1[4], q2[4], kc1, kc2, kp1, kp2, vv[4]; f32x4 rq[4], rp[4]; };
__device__ __forceinline__ void attn_load(const Args& a, int u, int tid, AttnRegs& R) {
    const int hq = u & 1, kv = (u >> 1) & 1, j = (u >> 2) & 31, n = u >> 7, h0 = kv * 8 + hq * 4;
    const GAS bf16_t* P1 = (const GAS bf16_t*)(a.ws + WS_PROJ1);
    const GAS float* ROPE = (const GAS float*)(a.ws + WS_ROPE);
    const bool hasprev = j > 0;
    const int r = tid >> 2, g = tid & 3, posq = j * 128 + r, posp = hasprev ? posq - 128 : posq;
    const GAS bf16_t* rowq = P1 + (size_t)(n * SEQ + posq) * P1C;
    const GAS bf16_t* rowp = P1 + (size_t)(n * SEQ + posp) * P1C;
#pragma unroll
    for (int i = 0; i < 4; ++i) { R.q1[i] = *(const GAS u32x4*)(rowq + (h0 + i) * 64 + 8 * g); R.q2[i] = *(const GAS u32x4*)(rowq + (h0 + i) * 64 + 32 + 8 * g); }
    R.kc1 = *(const GAS u32x4*)(rowq + C_K + kv * 64 + 8 * g); R.kc2 = *(const GAS u32x4*)(rowq + C_K + kv * 64 + 32 + 8 * g);
    R.kp1 = *(const GAS u32x4*)(rowp + C_K + kv * 64 + 8 * g); R.kp2 = *(const GAS u32x4*)(rowp + C_K + kv * 64 + 32 + 8 * g);
    const GAS f32x4* rq = (const GAS f32x4*)(ROPE + (size_t)(posq * 32 + 8 * g) * 2);
    const GAS f32x4* rp = (const GAS f32x4*)(ROPE + (size_t)(posp * 32 + 8 * g) * 2);
#pragma unroll
    for (int i = 0; i < 4; ++i) { R.rq[i] = rq[i]; R.rp[i] = rp[i]; }
    const int vk = tid >> 3, dg = tid & 7;
#pragma unroll
    for (int ps = 0; ps < 4; ++ps) {
        const int c = ps * 64 + vk; const int pos = (ps < 2) ? (hasprev ? j * 128 - 128 + c : j * 128 + c) : j * 128 - 128 + c;
        R.vv[ps] = *(const GAS u32x4*)(P1 + (size_t)(n * SEQ + pos) * P1C + C_V + kv * 64 + 8 * dg);
    }
}
constexpr int QBUF = 128 * QS;
__device__ __forceinline__ void attn_write_q(LAS bf16_t* Qb, const AttnRegs& R, int i, int tid) {
    const int r = tid >> 2, g = tid & 3;
    float x1[8], x2[8], o1[8], o2[8];
    unpack8(R.q1[i], x1); unpack8(R.q2[i], x2); rope8r(R.rq, x1, x2, 0.125f, o1, o2);
    *(LAS u32x4*)(Qb + r * QS + 8 * g) = pack8a(o1); *(LAS u32x4*)(Qb + r * QS + 32 + 8 * g) = pack8a(o2);
}

__device__ __forceinline__ void attn_prompt_unit(const Args& a, LAS unsigned char* lds, int u, int wid_in) {
    const int wid = wid_in, lane = fresh_lane(), tid = wid * 64 + lane, fr = lane & 15, fq = lane >> 4;
    const int hq = u & 1, kv = (u >> 1) & 1, j = (u >> 2) & 31, n = u >> 7, h0 = kv * 8 + hq * 4;
    LAS bf16_t* Qs0 = (LAS bf16_t*)lds; LAS bf16_t* Ks = Qs0 + 2 * QBUF; LAS bf16_t* Vt = Ks + 256 * QS;
    const bool wr_state = (j == 31) && (hq == 0);
    const bool hasprev = j > 0;
    AttnRegs R; attn_load(a, u, tid, R);
    {
        const int r = tid >> 2, g = tid & 3, vk = tid >> 3, dg = tid & 7;
        float x1[8], x2[8], o1[8], o2[8];
        attn_write_q(Qs0, R, 0, tid);
        unpack8(R.kc1, x1); unpack8(R.kc2, x2); rope8r(R.rq, x1, x2, 1.f, o1, o2);
        if (wr_state) {
            GAS float* o = (GAS float*)a.out + O_KP + ((size_t)(n * 128 + r) * 2 + kv) * 64 + 8 * g;
            *(GAS f32x4*)o = (f32x4){o1[0], o1[1], o1[2], o1[3]}; *(GAS f32x4*)(o + 4) = (f32x4){o1[4], o1[5], o1[6], o1[7]};
            *(GAS f32x4*)(o + 32) = (f32x4){o2[0], o2[1], o2[2], o2[3]}; *(GAS f32x4*)(o + 36) = (f32x4){o2[4], o2[5], o2[6], o2[7]};
        }
        *(LAS u32x4*)(Ks + (128 + r) * QS + 8 * g) = pack8a(o1); *(LAS u32x4*)(Ks + (128 + r) * QS + 32 + 8 * g) = pack8a(o2);
        unpack8(R.kp1, x1); unpack8(R.kp2, x2); rope8r(R.rp, x1, x2, hasprev ? 1.f : 0.f, o1, o2);
        *(LAS u32x4*)(Ks + r * QS + 8 * g) = pack8a(o1); *(LAS u32x4*)(Ks + r * QS + 32 + 8 * g) = pack8a(o2);
#pragma unroll
        for (int ps = 0; ps < 4; ++ps) {
            const int c = ps * 64 + vk;
            u32x4 w = R.vv[ps];
            if (ps < 2 && !hasprev) w = (u32x4){0u, 0u, 0u, 0u};
            const unsigned ww[4] = {w.x, w.y, w.z, w.w};
#pragma unroll
            for (int e = 0; e < 4; ++e) { Vt[(8 * dg + 2 * e) * VS + c] = (bf16_t)(ww[e] & 0xffffu); Vt[(8 * dg + 2 * e + 1) * VS + c] = (bf16_t)(ww[e] >> 16); }
            if (ps >= 2 && wr_state) {
                float v[8]; unpack8(w, v);
                GAS float* o = (GAS float*)a.out + O_VP + ((size_t)(n * 128 + (c - 128)) * 2 + kv) * 64 + 8 * dg;
                *(GAS f32x4*)o = (f32x4){v[0], v[1], v[2], v[3]}; *(GAS f32x4*)(o + 4) = (f32x4){v[4], v[5], v[6], v[7]};
            }
        }
    }
    for (int i = tid; i < 64 * 24; i += 512) Vt[(i / 24) * VS + 256 + (i % 24)] = 0;
    __syncthreads();
#pragma unroll
    for (int hi = 0; hi < 4; ++hi) {
    const int h = h0 + hi;
    LAS bf16_t* Qs = Qs0 + (hi & 1) * QBUF;
    if (hi < 3) attn_write_q(Qs0 + ((hi + 1) & 1) * QBUF, R, hi + 1, tid);
    const bf16x8 bq0 = *(const LAS bf16x8*)(Qs + (16 * wid + fr) * QS + 8 * fq), bq1 = *(const LAS bf16x8*)(Qs + (16 * wid + fr) * QS + 32 + 8 * fq);
    f32x4 s[9], s2[9];
#pragma unroll
    for (int b = 0; b < 9; ++b) {
        const int kb = wid + b;
        const bf16x8 k0 = *(const LAS bf16x8*)(Ks + (16 * kb + fr) * QS + 8 * fq), k1 = *(const LAS bf16x8*)(Ks + (16 * kb + fr) * QS + 32 + 8 * fq);
        const f32x4 z = {0.f, 0.f, 0.f, 0.f};
        s[b] = __builtin_amdgcn_mfma_f32_16x16x32_bf16(k0, bq0, z, 0, 0, 0);
        s2[b] = __builtin_amdgcn_mfma_f32_16x16x32_bf16(k1, bq1, z, 0, 0, 0);
    }
    __builtin_amdgcn_sched_barrier(0);
    asm volatile("s_nop 7\n\ts_nop 7" ::: "memory");
#pragma unroll
    for (int b = 0; b < 9; ++b) { asm volatile("" : "+v"(s[b]), "+v"(s2[b])); s[b] = s[b] + s2[b]; }
    const float sink = ((const GAS float*)a.in[13])[h];
    const int qi = 16 * wid + fr;
    float mx = sink;
#pragma unroll
    for (int b = 0; b < 9; ++b)
#pragma unroll
        for (int e = 0; e < 4; ++e) {
            const int c = 16 * (wid + b) + 4 * fq + e;
            const bool ok = (c > qi) && (c <= qi + 128) && (j > 0 || c >= 128);
            s[b][e] = ok ? s[b][e] : -1e30f;
            mx = fmaxf(mx, s[b][e]);
        }
    mx = fmaxf(mx, __shfl_xor(mx, 16)); mx = fmaxf(mx, __shfl_xor(mx, 32));
    float sum = 0.f;
#pragma unroll
    for (int b = 0; b < 9; ++b)
#pragma unroll
        for (int e = 0; e < 4; ++e) { const float p = s[b][e] > -1e29f ? __expf(s[b][e] - mx) : 0.f; s[b][e] = p; sum += p; }
    sum += __shfl_xor(sum, 16); sum += __shfl_xor(sum, 32);
    const float inv = 1.f / (sum + __expf(sink - mx));
    f32x4 ot[5][4];
#pragma unroll
    for (int pi = 0; pi < 5; ++pi) {
        const int kb0 = wid + 2 * pi, kb1 = kb0 + 1;
        u32x4 pw; pw.x = cvt_pk_bf16(s[2 * pi][0], s[2 * pi][1]); pw.y = cvt_pk_bf16(s[2 * pi][2], s[2 * pi][3]);
        if (pi < 4) { pw.z = cvt_pk_bf16(s[2 * pi + 1 < 9 ? 2 * pi + 1 : 8][0], s[2 * pi + 1 < 9 ? 2 * pi + 1 : 8][1]); pw.w = cvt_pk_bf16(s[2 * pi + 1 < 9 ? 2 * pi + 1 : 8][2], s[2 * pi + 1 < 9 ? 2 * pi + 1 : 8][3]); }
        else { pw.z = 0u; pw.w = 0u; }
        const bf16x8 pb = __builtin_bit_cast(bf16x8, pw);
#pragma unroll
        for (int d = 0; d < 4; ++d) {
            const u32x2 lo = *(const LAS u32x2*)(Vt + (16 * d + fr) * VS + 16 * kb0 + 4 * fq), hi = *(const LAS u32x2*)(Vt + (16 * d + fr) * VS + 16 * kb1 + 4 * fq);
            const u32x4 vw = {lo.x, lo.y, hi.x, hi.y};
            const f32x4 zz = {0.f, 0.f, 0.f, 0.f};
            ot[pi][d] = __builtin_amdgcn_mfma_f32_16x16x32_bf16(__builtin_bit_cast(bf16x8, vw), pb, zz, 0, 0, 0);
        }
    }
    __builtin_amdgcn_sched_barrier(0);
    asm volatile("s_nop 7\n\ts_nop 7" ::: "memory");
    f32x4 o[4];
#pragma unroll
    for (int d = 0; d < 4; ++d) {
#pragma unroll
        for (int pi = 0; pi < 5; ++pi) asm volatile("" : "+v"(ot[pi][d]));
        o[d] = ((ot[0][d] + ot[1][d]) + (ot[2][d] + ot[3][d])) + ot[4][d];
    }
    GAS bf16_t* dst = (GAS bf16_t*)(a.ws + WS_AB) + (size_t)(n * SEQ + j * 128 + qi) * DM + h * 64 + 4 * fq;
#pragma unroll
    for (int d = 0; d < 4; ++d) { u32x2 w; w.x = cvt_pk_bf16(o[d][0] * inv, o[d][1] * inv); w.y = cvt_pk_bf16(o[d][2] * inv, o[d][3] * inv); *(GAS u32x2*)(dst + 16 * d) = w; }
    __syncthreads();
    }
}

__device__ __forceinline__ void attn_sample_unit(const Args& a, LAS unsigned char* lds, int b, int wid_in) {
    const int wid = wid_in, lane = fresh_lane(), tid = wid * 64 + lane;
    LAS float* qf = (LAS float*)lds;
    LAS float* kn = qf + 1024;
    LAS float* vn = kn + 128;
    LAS float* S = vn + 128;
    LAS float* KV = (LAS float*)(lds + 16384);
    constexpr int KS_ = 129;
    const GAS bf16_t* prow = (const GAS bf16_t*)(a.ws + WS_PROJ1) + (size_t)(MP + b) * P1C;
    const GAS float* rp = (const GAS float*)(a.ws + WS_ROPE) + (size_t)4096 * 64;
    const GAS float* sk = (const GAS float*)a.in[2] + (size_t)b * 128 * 128 + 128;
    const GAS float* sv = (const GAS float*)a.in[3] + (size_t)b * 128 * 128 + 128;
    GAS float* ok = (GAS float*)a.out + O_KS + (size_t)b * 16384;
    GAS float* ov = (GAS float*)a.out + O_VS + (size_t)b * 16384;
    f32x4 kreg[8], vreg[8];
#pragma unroll
    for (int q = 0; q < 8; ++q) { const int i4 = tid + 512 * q; const bool ok_ = i4 < 127 * 32; const int j4 = ok_ ? i4 : 0;
        kreg[q] = *(const GAS f32x4*)(sk + (size_t)j4 * 4); vreg[q] = *(const GAS f32x4*)(sv + (size_t)j4 * 4); }
    {
        const int h = tid >> 5, i = tid & 31; const float c = rp[2 * i], s = rp[2 * i + 1];
        const float x1 = bf1(prow[h * 64 + i]), x2 = bf1(prow[h * 64 + 32 + i]);
        qf[h * 64 + i] = (x1 * c - x2 * s) * 0.125f; qf[h * 64 + 32 + i] = (x2 * c + x1 * s) * 0.125f;
        if (tid < 64) { const float y1 = bf1(prow[C_K + h * 64 + i]), y2 = bf1(prow[C_K + h * 64 + 32 + i]); kn[h * 64 + i] = y1 * c - y2 * s; kn[h * 64 + 32 + i] = y2 * c + y1 * s; }
        if (tid < 128) vn[tid] = bf1(prow[C_V + tid]);
    }
#pragma unroll
    for (int q = 0; q < 8; ++q) { const int i4 = tid + 512 * q; if (i4 < 127 * 32) { const int i = i4 >> 5, c4 = (i4 & 31) * 4; LAS float* d = KV + i * KS_ + c4;
        d[0] = kreg[q].x; d[1] = kreg[q].y; d[2] = kreg[q].z; d[3] = kreg[q].w; *(GAS f32x4*)(ok + (size_t)i4 * 4) = kreg[q]; *(GAS f32x4*)(ov + (size_t)i4 * 4) = vreg[q]; } }
    __syncthreads();
    if (tid < 128) { KV[127 * KS_ + tid] = kn[tid]; ok[127 * 128 + tid] = kn[tid]; ov[127 * 128 + tid] = vn[tid]; }
    __syncthreads();
#pragma unroll
    for (int cc = 0; cc < 4; ++cc) {
        const int idx = tid + 512 * cc, h = idx >> 7, i = idx & 127, kv = h >> 3;
        float d = 0.f;
#pragma unroll 16
        for (int e = 0; e < 64; ++e) d += KV[i * KS_ + kv * 64 + e] * qf[h * 64 + e];
        S[h * 128 + i] = d;
    }
    __syncthreads();
#pragma unroll
    for (int hh = 0; hh < 2; ++hh) {
        const int h = wid * 2 + hh; const float sink = ((const GAS float*)a.in[13])[h];
        const float s0 = S[h * 128 + lane], s1 = S[h * 128 + 64 + lane];
        const float mx = fmaxf(wave_max(fmaxf(s0, s1)), sink);
        const float p0 = __expf(s0 - mx), p1 = __expf(s1 - mx);
        const float inv = 1.f / (wave_sum(p0 + p1) + __expf(sink - mx));
        S[h * 128 + lane] = p0 * inv; S[h * 128 + 64 + lane] = p1 * inv;
    }
#pragma unroll
    for (int q = 0; q < 8; ++q) { const int i4 = tid + 512 * q; if (i4 < 127 * 32) { const int i = i4 >> 5, c4 = (i4 & 31) * 4; LAS float* d = KV + i * KS_ + c4;
        d[0] = vreg[q].x; d[1] = vreg[q].y; d[2] = vreg[q].z; d[3] = vreg[q].w; } }
    if (tid < 128) KV[127 * KS_ + tid] = vn[tid];
    __syncthreads();
#pragma unroll
    for (int cc = 0; cc < 2; ++cc) {
        const int idx = tid + 512 * cc, h = idx >> 6, d = idx & 63, kv = h >> 3;
        float acc = 0.f;
#pragma unroll 16
        for (int i = 0; i < 128; ++i) acc += S[h * 128 + i] * KV[i * KS_ + kv * 64 + d];
        ((GAS bf16_t*)(a.ws + WS_AB))[(size_t)(MP + b) * DM + h * 64 + d] = (bf16_t)(cvt_pk_bf16(acc, 0.f) & 0xffffu);
    }
    __syncthreads();
}

__device__ __forceinline__ void convb_item(const Args& a, int item, int lane) {
    const int rb = item >> 1, c0 = (item & 1) * 512 + lane * 8, row0 = rb * 8;
    const GAS bf16_t* P1 = (const GAS bf16_t*)(a.ws + WS_PROJ1);
    const GAS float* cw = (const GAS float*)a.in[14] + c0;
    float w0[8], w1[8], w2[8];
    { const f32x4 a0 = *(const GAS f32x4*)cw, a1 = *(const GAS f32x4*)(cw + 4), b0 = *(const GAS f32x4*)(cw + CW), b1 = *(const GAS f32x4*)(cw + CW + 4), c0v = *(const GAS f32x4*)(cw + 2 * CW), c1v = *(const GAS f32x4*)(cw + 2 * CW + 4);
#pragma unroll
      for (int e = 0; e < 4; ++e) { w0[e] = a0[e]; w0[e + 4] = a1[e]; w1[e] = b0[e]; w1[e + 4] = b1[e]; w2[e] = c0v[e]; w2[e + 4] = c1v[e]; } }
    float p2[8], p1[8];
    const bool prompt = row0 < MP;
    const bool halo = prompt && (row0 & (SEQ - 1)) != 0;
    const int hr = halo ? row0 - 2 : row0;
    const u32x4 hx0 = *(const GAS u32x4*)(P1 + (size_t)hr * P1C + C_CC + c0), hy0 = *(const GAS u32x4*)(P1 + (size_t)hr * P1C + C_CU + c0);
    const u32x4 hx1 = *(const GAS u32x4*)(P1 + (size_t)(hr + 1) * P1C + C_CC + c0), hy1 = *(const GAS u32x4*)(P1 + (size_t)(hr + 1) * P1C + C_CU + c0);
    u32x4 vb[8], vc[8], vu[8];
#pragma unroll
    for (int r = 0; r < 8; ++r) { const GAS bf16_t* pr = P1 + (size_t)(row0 + r) * P1C + c0; vb[r] = NTL((const GAS u32x4*)(pr + C_CB)); vc[r] = NTL((const GAS u32x4*)(pr + C_CC)); vu[r] = NTL((const GAS u32x4*)(pr + C_CU)); }
    { float x[8], y[8]; unpack8(hx0, x); unpack8(hy0, y);
#pragma unroll
      for (int e = 0; e < 8; ++e) p2[e] = halo ? x[e] * y[e] : 0.f;
      unpack8(hx1, x); unpack8(hy1, y);
#pragma unroll
      for (int e = 0; e < 8; ++e) p1[e] = halo ? x[e] * y[e] : 0.f; }
#pragma unroll
    for (int r = 0; r < 8; ++r) {
        const int row = row0 + r;
        if (!prompt) {
            const GAS float* st = (const GAS float*)a.in[4] + (size_t)(row - MP) * 2 * CW + c0;
            const f32x4 s0 = *(const GAS f32x4*)st, s1 = *(const GAS f32x4*)(st + 4), s2 = *(const GAS f32x4*)(st + CW), s3 = *(const GAS f32x4*)(st + CW + 4);
#pragma unroll
            for (int e = 0; e < 4; ++e) { p2[e] = s0[e]; p2[e + 4] = s1[e]; p1[e] = s2[e]; p1[e + 4] = s3[e]; }
        }
        float cb[8], x[8], y[8], cx[8], ov[8];
        unpack8(vb[r], cb); unpack8(vc[r], x); unpack8(vu[r], y);
#pragma unroll
        for (int e = 0; e < 8; ++e) { cx[e] = x[e] * y[e]; ov[e] = cb[e] * (w0[e] * p2[e] + w1[e] * p1[e] + w2[e] * cx[e]); }
        *(GAS u32x4*)((GAS bf16_t*)(a.ws + WS_AB) + (size_t)row * DM + 1024 + c0) = pack8a(ov);
        GAS float* so = nullptr;
        if (prompt) { const int t = row & (SEQ - 1); if (t >= SEQ - 2) so = (GAS float*)a.out + O_CP + (size_t)((row >> 12) * 2 + (t - (SEQ - 2))) * CW + c0; }
        else so = (GAS float*)a.out + O_CS + (size_t)((row - MP) * 2 + 1) * CW + c0;
        if (so) { *(GAS f32x4*)so = (f32x4){cx[0], cx[1], cx[2], cx[3]}; *(GAS f32x4*)(so + 4) = (f32x4){cx[4], cx[5], cx[6], cx[7]}; }
#pragma unroll
        for (int e = 0; e < 8; ++e) { p2[e] = p1[e]; p1[e] = cx[e]; }
    }
}

template <bool FIRST>
__device__ __forceinline__ void resnorm_rows(const Args& a, int gw, int NGW, int lane) {
    f32x4 g1[8], g2[8];
    { const GAS f32x4* p1 = (const GAS f32x4*)a.in[FIRST ? 9 : 11] + lane; const GAS f32x4* p2 = (const GAS f32x4*)a.in[10] + lane;
#pragma unroll
      for (int j = 0; j < 8; ++j) { g1[j] = p1[64 * j]; g2[j] = FIRST ? p2[64 * j] : (f32x4){0.f, 0.f, 0.f, 0.f}; } }
    int m = gw; if (m >= MT) return;
    const GAS bf16_t* SRC = (const GAS bf16_t*)(a.ws + (FIRST ? WS_MO : WS_F));
    const GAS bf16_t* X1B = (const GAS bf16_t*)(a.ws + WS_X1B);
    f32x4 v[8], x[8];
    { const GAS u32x2* sr = (const GAS u32x2*)(SRC + (size_t)m * DM) + lane;
#pragma unroll
      for (int j = 0; j < 8; ++j) { const u32x2 w = NTL(sr + 64 * j); v[j] = (f32x4){bflo(w.x), bfhi(w.x), bflo(w.y), bfhi(w.y)}; }
      if (FIRST) { const GAS f32x4* xr = (const GAS f32x4*)x_row(a, m) + lane;
#pragma unroll
        for (int j = 0; j < 8; ++j) x[j] = NTL(xr + 64 * j); }
      else { const GAS u32x2* xr = (const GAS u32x2*)(X1B + (size_t)m * DM) + lane;
#pragma unroll
        for (int j = 0; j < 8; ++j) { const u32x2 w = NTL(xr + 64 * j); x[j] = (f32x4){bflo(w.x), bfhi(w.x), bflo(w.y), bfhi(w.y)}; } } }
    for (;;) {
        const int mn = m + NGW; const bool has = mn < MT; const int mp = has ? mn : m;
        u32x2 nw[8]; f32x4 nx[8]; u32x2 nxb[8];
        { const GAS u32x2* sr = (const GAS u32x2*)(SRC + (size_t)mp * DM) + lane;
#pragma unroll
          for (int j = 0; j < 8; ++j) nw[j] = NTL(sr + 64 * j);
          if (FIRST) { const GAS f32x4* xr = (const GAS f32x4*)x_row(a, mp) + lane;
#pragma unroll
            for (int j = 0; j < 8; ++j) nx[j] = NTL(xr + 64 * j); }
          else { const GAS u32x2* xr = (const GAS u32x2*)(X1B + (size_t)mp * DM) + lane;
#pragma unroll
            for (int j = 0; j < 8; ++j) nxb[j] = NTL(xr + 64 * j); } }
        float s = 0.f;
#pragma unroll
        for (int j = 0; j < 8; ++j) s += (v[j].x * v[j].x + v[j].y * v[j].y) + (v[j].z * v[j].z + v[j].w * v[j].w);
        const float rstd = 1.f / sqrtf(wave_sum(s) * (1.f / DM) + EPS);
        float s2 = 0.f;
        GAS u32x2* xo = (GAS u32x2*)((GAS bf16_t*)(a.ws + (FIRST ? WS_X1B : WS_H)) + (size_t)m * DM) + lane;
#pragma unroll
        for (int j = 0; j < 8; ++j) { v[j] = x[j] + v[j] * rstd * g1[j]; u32x2 w; w.x = cvt_pk_bf16(v[j].x, v[j].y); w.y = cvt_pk_bf16(v[j].z, v[j].w); xo[64 * j] = w;
            s2 += (v[j].x * v[j].x + v[j].y * v[j].y) + (v[j].z * v[j].z + v[j].w * v[j].w); }
        if (FIRST) {
            GAS u32x2* ho = (GAS u32x2*)((GAS bf16_t*)(a.ws + WS_H) + (size_t)m * DM) + lane;
            const float rstd2 = 1.f / sqrtf(wave_sum(s2) * (1.f / DM) + EPS);
#pragma unroll
            for (int j = 0; j < 8; ++j) { u32x2 w; w.x = cvt_pk_bf16(v[j].x * rstd2 * g2[j].x, v[j].y * rstd2 * g2[j].y); w.y = cvt_pk_bf16(v[j].z * rstd2 * g2[j].z, v[j].w * rstd2 * g2[j].w); ho[64 * j] = w; }
        }
        if (!has) break;
#pragma unroll
        for (int j = 0; j < 8; ++j) { v[j] = (f32x4){bflo(nw[j].x), bfhi(nw[j].x), bflo(nw[j].y), bfhi(nw[j].y)};
            x[j] = FIRST ? nx[j] : (f32x4){bflo(nxb[j].x), bfhi(nxb[j].x), bflo(nxb[j].y), bfhi(nxb[j].y)}; }
        m = mn;
    }
}

__device__ __forceinline__ void ffnfix_item(const Args& a, int item, int lane) {
    const int c0 = (item % 11) * 512 + lane * 8, q = item / 11;
    const GAS float* cw = (const GAS float*)a.in[20] + c0;
    const GAS float* cbp = (const GAS float*)a.in[21] + c0;
    float w0[8], w1[8], w2[8], bb[8];
    { const f32x4 a0 = *(const GAS f32x4*)cw, a1 = *(const GAS f32x4*)(cw + 4), b0 = *(const GAS f32x4*)(cw + DFF), b1 = *(const GAS f32x4*)(cw + DFF + 4), c0v = *(const GAS f32x4*)(cw + 2 * DFF), c1v = *(const GAS f32x4*)(cw + 2 * DFF + 4),
                  d0 = *(const GAS f32x4*)cbp, d1 = *(const GAS f32x4*)(cbp + 4);
#pragma unroll
      for (int e = 0; e < 4; ++e) { w0[e] = a0[e]; w0[e + 4] = a1[e]; w1[e] = b0[e]; w1[e + 4] = b1[e]; w2[e] = c0v[e]; w2[e + 4] = c1v[e]; bb[e] = d0[e]; bb[e + 4] = d1[e]; } }
    GAS bf16_t* FIN = (GAS bf16_t*)(a.ws + WS_FIN);
    float p2[8], p1[8], x0[8], x1[8], g0[8], g1[8], ov[8];
    if (q < 128) {
        const GAS bf16_t* SA = (const GAS bf16_t*)(a.ws + WS_SA); const GAS bf16_t* SG = (const GAS bf16_t*)(a.ws + WS_SG);
        const int r0 = q * 64; const bool halo = (r0 & (SEQ - 1)) != 0; const int qp = halo ? q - 1 : q;
        const u32x4 h0 = *(const GAS u32x4*)(SA + ((size_t)qp * 4 + 0) * DFF + c0), h1 = *(const GAS u32x4*)(SA + ((size_t)qp * 4 + 1) * DFF + c0);
        const u32x4 a0 = *(const GAS u32x4*)(SA + ((size_t)q * 4 + 2) * DFF + c0), a1 = *(const GAS u32x4*)(SA + ((size_t)q * 4 + 3) * DFF + c0);
        const u32x4 gg0 = *(const GAS u32x4*)(SG + ((size_t)q * 2 + 0) * DFF + c0), gg1 = *(const GAS u32x4*)(SG + ((size_t)q * 2 + 1) * DFF + c0);
        unpack8(h0, p2); unpack8(h1, p1); unpack8(a0, x0); unpack8(a1, x1); unpack8(gg0, g0); unpack8(gg1, g1);
#pragma unroll
        for (int e = 0; e < 8; ++e) { p2[e] = halo ? p2[e] : 0.f; p1[e] = halo ? p1[e] : 0.f; }
#pragma unroll
        for (int e = 0; e < 8; ++e) ov[e] = gelu_tanh(w0[e] * p2[e] + w1[e] * p1[e] + w2[e] * x0[e] + bb[e]) * g0[e];
        *(GAS u32x4*)(FIN + (size_t)r0 * DFF + c0) = pack8a(ov);
#pragma unroll
        for (int e = 0; e < 8; ++e) ov[e] = gelu_tanh(w0[e] * p1[e] + w1[e] * x0[e] + w2[e] * x1[e] + bb[e]) * g1[e];
        *(GAS u32x4*)(FIN + (size_t)(r0 + 1) * DFF + c0) = pack8a(ov);
    } else {
        const int b = q - 128;
        const GAS float* st = (const GAS float*)a.in[5] + (size_t)b * 2 * DFF + c0;
        const f32x4 s0 = *(const GAS f32x4*)st, s1 = *(const GAS f32x4*)(st + 4), s2 = *(const GAS f32x4*)(st + DFF), s3 = *(const GAS f32x4*)(st + DFF + 4);
        const u32x4 a0 = *(const GAS u32x4*)((const GAS bf16_t*)(a.ws + WS_UAS) + (size_t)b * DFF + c0), gg0 = *(const GAS u32x4*)((const GAS bf16_t*)(a.ws + WS_UGS) + (size_t)b * DFF + c0);
        unpack8(a0, x0); unpack8(gg0, g0);
#pragma unroll
        for (int e = 0; e < 4; ++e) { p2[e] = s0[e]; p2[e + 4] = s1[e]; p1[e] = s2[e]; p1[e + 4] = s3[e]; }
#pragma unroll
        for (int e = 0; e < 8; ++e) ov[e] = gelu_tanh(w0[e] * p2[e] + w1[e] * p1[e] + w2[e] * x0[e] + bb[e]) * g0[e];
        *(GAS u32x4*)(FIN + (size_t)(MP + b) * DFF + c0) = pack8a(ov);
    }
}

#define XB_TMO      128
#define XB_XCNT(j)  (256  + 64 * (j))
#define XB_XSUB(j)  (1280 + 64 * (j))
#define XB_XGEN(j)  (2304 + 64 * (j))
#define XB_TOP      3328
#define XB_TOPGEN   3392
#define XCD_BAR_WORDS 3456
#define XB_SPIN_CAP (1u << 18)
__device__ __forceinline__ unsigned xb_ld(unsigned* p)              { return __hip_atomic_load(p, __ATOMIC_RELAXED, __HIP_MEMORY_SCOPE_AGENT); }
__device__ __forceinline__ unsigned xb_add(unsigned* p, unsigned v) { return __hip_atomic_fetch_add(p, v, __ATOMIC_RELAXED, __HIP_MEMORY_SCOPE_AGENT); }
__device__ __forceinline__ unsigned xb_xcc_id() { return (unsigned)__builtin_amdgcn_s_getreg((3 << 11) | 20) & 0xFu; }
#define XB_SPIN(cond, bar) do { unsigned _sp = 0; while (cond) { __builtin_amdgcn_s_sleep(1); \
    if ((++_sp & 255u) == 0u) { if (xb_ld(&(bar)[XB_TMO])) break; if (_sp > XB_SPIN_CAP) { atomicAdd(&(bar)[XB_TMO], 1u); break; } } } } while (0)
__device__ __forceinline__ void xcd_barrier_complete(unsigned* bar, unsigned x, unsigned G, unsigned& nloc, unsigned& nx) {
    unsigned sum, cnt, mine, sp = 0u;
    for (;;) {
        sum = 0u; cnt = 0u; mine = 0u;
#pragma unroll
        for (unsigned j = 0; j < 16; ++j) { const unsigned c = xb_ld(&bar[XB_XCNT(j)]); sum += c; cnt += (c > 0u) ? 1u : 0u; mine = (j == x) ? c : mine; }
        if (sum == G) break;
        __builtin_amdgcn_s_sleep(1);
        if ((++sp & 255u) == 0u) { if (xb_ld(&bar[XB_TMO])) break; if (sp > XB_SPIN_CAP) { atomicAdd(&bar[XB_TMO], 1u); break; } }
    }
    nloc = mine > 0u ? mine : 1u; nx = cnt > 0u ? cnt : 1u;
}
__device__ __forceinline__ void grid_barrier(unsigned* bar, volatile LAS unsigned* st, unsigned G, int wid_in) {
    asm volatile("s_waitcnt vmcnt(0)" ::: "memory");
    __syncthreads();
    if (wid_in == 0 && fresh_lane() == 0) {
        __builtin_amdgcn_s_waitcnt(0);
        const unsigned x = xb_xcc_id();
        unsigned nloc = st[0], nx = st[1];
        if (nloc == 0u) { xcd_barrier_complete(bar, x, G, nloc, nx); st[0] = nloc; st[1] = nx; }
        const unsigned old = xb_add(&bar[XB_XSUB(x)], 1u);
        const unsigned gen = old / nloc;
        if (old + 1u == (gen + 1u) * nloc) {
            __builtin_amdgcn_fence(__ATOMIC_RELEASE, "agent");
            asm volatile("s_waitcnt vmcnt(0)" ::: "memory");
            const unsigned og = xb_add(&bar[XB_TOP], 1u);
            const unsigned tg = og / nx;
            if (og + 1u == (tg + 1u) * nx) xb_add(&bar[XB_TOPGEN], 1u);
            else XB_SPIN(xb_ld(&bar[XB_TOPGEN]) == tg, bar);
            __builtin_amdgcn_fence(__ATOMIC_ACQUIRE, "agent");
            xb_add(&bar[XB_XGEN(x)], 1u);
            asm volatile("s_waitcnt vmcnt(0)" ::: "memory");
        } else {
            XB_SPIN(xb_ld(&bar[XB_XGEN(x)]) == gen, bar);
            __builtin_amdgcn_fence(__ATOMIC_ACQUIRE, "agent");
            asm volatile("s_waitcnt vmcnt(0)" ::: "memory");
        }
    }
    __syncthreads();
}

template <int MODE, int N, int K>
__device__ __forceinline__ void gemm_job(LAS unsigned char* lds, const Args& a, size_t offA, size_t offB, int G, int bid, int wid) {
    const bf16_t* A = (const bf16_t*)(a.ws + offA); const bf16_t* Bt = (const bf16_t*)(a.ws + offB);
    pg8::gemm_phase<MODE, N, K>(lds, a, A, Bt, G, bid, wid);
    skinny_gemm<MODE, N, K>(lds, a, A + (size_t)MP * K, Bt, G, bid, wid);
}

__global__ void __launch_bounds__(512, 2) hybrid_fwd(Args a) {
    __shared__ __attribute__((aligned(16))) unsigned char lds_raw[LDS_BYTES];
    LAS unsigned char* lds = (LAS unsigned char*)lds_raw;
    const int wid = __builtin_amdgcn_readfirstlane((int)threadIdx.x >> 6);
    const int G = gridDim.x, bid = blockIdx.x, gw = bid * 8 + wid, NGW = G * 8;
    const int lo = a.ph_lo, hi = a.ph_hi;
    if (lo > 1000) { __threadfence(); cg::this_grid().sync(); }
    if (hi - lo > 1) {
        if (wid == 0) { const int l = fresh_lane(); if (l < 2) ((volatile LAS unsigned*)(lds + 131072))[l] = 0u; if (l == 0) (void)xb_add((unsigned*)a.ws + XB_XCNT(xb_xcc_id()), 1u); }
        __syncthreads();
    }
#define IN(k) (lo <= (k) && (k) < hi)
#define SEAM(k) do { if (IN(k) && IN((k) + 1)) grid_barrier((unsigned*)a.ws, (volatile LAS unsigned*)(lds + 131072), (unsigned)G, wid); } while (0)
#ifdef PROBE_PHASE
    if (IN(100)) {
        const int gtid = bid * 512 + wid * 64 + fresh_lane(), GT = G * 512;
        const GAS bf16_t* b16 = (const GAS bf16_t*)(a.ws + 4 * MiB); const size_t n = (size_t)(341 * MiB / 2), NOUT = 16842752;
        for (size_t i = gtid; i < NOUT; i += GT) { float acc = 0.f; for (size_t k = i; k < n; k += NOUT) acc += bf1(b16[k]); ((GAS float*)a.out)[i] = acc; }
    }
#endif
    if (IN(0)) p0_prologue(a, lds, bid, G, wid);
    SEAM(0);
    if (IN(1)) {
        gemm_job<1, INC, 2048>(lds, a, WS_H, WS_WIN, G, bid, wid);
        constexpr int NFULL = (MP / 256) * (INC / 256) % 256;
        const int first = (G == 256) ? NFULL : 0;
        if (bid >= first) late_weights<1>(a, lds, (bid - first) * 8 + wid, (G - first) * 8, wid);
    }
    SEAM(1);
    if (IN(2)) {
#ifndef SKIP_PA
        for (int u = bid; u < 256; u += G) attn_prompt_unit(a, lds, u, wid);
#endif
        if (bid >= G - MS) attn_sample_unit(a, lds, G - 1 - bid, wid);
        for (int it = gw; it < (MT / 8) * 2; it += NGW) convb_item(a, it, fresh_lane());
    }
    SEAM(2);
    if (IN(3)) gemm_job<3, 2048, 2048>(lds, a, WS_AB, WS_WM, G, bid, wid);
    SEAM(3);
    if (IN(4)) gemm_job<4, 2048, 2048>(lds, a, WS_MERGED, WS_WO, G, bid, wid);
    SEAM(4);
    if (IN(5)) resnorm_rows<true>(a, gw, NGW, fresh_lane());
    SEAM(5);
    if (IN(6)) {
        gemm_job<6, 2 * DFF, 2048>(lds, a, WS_H, WS_WUP, G, bid, wid);
        constexpr int NFULL = (MP / 256) * (2 * DFF / 256) % 256;
        const int first = (G == 256) ? NFULL : 0;
        if (bid >= first) {
            late_weights<2>(a, lds, (bid - first) * 8 + wid, (G - first) * 8, wid);
            __syncthreads();
            gemm_job<9, 2048, PLE>(lds, a, WS_PB, WS_WP, G - first, bid - first, wid);
        }
    }
    SEAM(6);
    if (IN(7)) { for (int it = gw; it < (128 + MS) * 11; it += NGW) ffnfix_item(a, it, fresh_lane()); }
    SEAM(7);
    if (IN(8)) gemm_job<8, 2048, DFF>(lds, a, WS_FIN, WS_WDN, G, bid, wid);
    SEAM(8);
    if (IN(9)) resnorm_rows<false>(a, gw, NGW, fresh_lane());
    SEAM(9);
    if (IN(10)) gemm_job<10, 2048, 2048>(lds, a, WS_H, WS_WG, G, bid, wid);
#undef IN
#undef SEAM
}

extern "C" void kernel_launch(void* const* d_in, const int* in_sizes, int n_in, void* d_out, int out_size, void* d_ws, size_t ws_size, hipStream_t stream) {
    static int grid = 0;
    if (grid == 0) {
        if (n_in != 25 || ws_size < WS_END) { fprintf(stderr, "kernel_launch: unexpected n_in %d / ws_size %zu\n", n_in, ws_size); grid = -1; return; }
        int dev = 0, cus = 0, per_cu = 0;
        if (hipGetDevice(&dev) != hipSuccess || hipDeviceGetAttribute(&cus, hipDeviceAttributeMultiprocessorCount, dev) != hipSuccess) { grid = -1; return; }
        if (hipOccupancyMaxActiveBlocksPerMultiprocessor(&per_cu, (const void*)hybrid_fwd, 512, 0) != hipSuccess || per_cu < 1) { fprintf(stderr, "kernel_launch: occupancy query says %d\n", per_cu); per_cu = 1; }
        (void)hipGetLastError();
        grid = cus;
    }
    if (grid < 0) return;
    if (hipMemsetAsync(d_ws, 0, 16384, stream) != hipSuccess) { fprintf(stderr, "kernel_launch: memset failed\n"); return; }
    Args a{};
    for (int i = 0; i < 25; ++i) a.in[i] = (const float*)d_in[i];
    a.out = (float*)d_out; a.ws = (unsigned char*)d_ws;
#if MK_N_LAUNCHES == 1
    a.ph_lo = 0; a.ph_hi = NPHASE;
    void* kargs[] = {&a};
    hipError_t e = hipLaunchCooperativeKernel((const void*)hybrid_fwd, dim3(grid), dim3(512), kargs, 0, stream);
    if (e != hipSuccess) fprintf(stderr, "cooperative launch failed: %s (grid %d)\n", hipGetErrorString(e), grid);
#else
#ifdef PROBE_PHASE
    for (int ph = 0; ph <= PROBE_PHASE; ++ph) { a.ph_lo = ph; a.ph_hi = ph + 1; hipLaunchKernelGGL(hybrid_fwd, dim3(grid), dim3(512), 0, stream, a); }
    a.ph_lo = 100; a.ph_hi = 101; hipLaunchKernelGGL(hybrid_fwd, dim3(grid), dim3(512), 0, stream, a);
#else
    for (int ph = 0; ph < NPHASE; ++ph) {
        a.ph_lo = ph; a.ph_hi = ph + 1;
        for (int rep = 0; rep < 1 + ((REPMASK >> ph) & 1); ++rep)
            hipLaunchKernelGGL(hybrid_fwd, dim3(grid), dim3(512), 0, stream, a);
    }
#endif
#endif
}
```

```cpp
#include <hip/hip_runtime.h>
#include <hip/hip_cooperative_groups.h>
#include <cstdio>
#include <cstdint>
namespace cg = cooperative_groups;


#ifndef MK_N_LAUNCHES
#define MK_N_LAUNCHES 1
#define REPMASK 0x00
#endif

#define LAS __attribute__((address_space(3)))
#define GAS __attribute__((address_space(1)))
typedef unsigned short bf16_t;
typedef short bf16x8 __attribute__((ext_vector_type(8)));
typedef float f32x4 __attribute__((ext_vector_type(4)));
typedef float f32x16 __attribute__((ext_vector_type(16)));
typedef unsigned u32x4 __attribute__((ext_vector_type(4)));
typedef unsigned u32x2 __attribute__((ext_vector_type(2)));

constexpr int DM = 2048, SEQ = 4096, MP = 8192, MS = 32, MT = MP + MS;
constexpr int DFF = 5632, INC = 8448, CW = 1024, PLE = 256;
constexpr int P1C = 4352;
constexpr int C_K = 1024, C_V = 1152, C_CB = 1280, C_CC = 2304, C_CU = 3328;
constexpr float EPS = 1e-6f;
constexpr size_t O_YP = 0, O_YS = 16777216, O_KP = 16842752, O_VP = 16875520, O_CP = 16908288, O_FP = 16912384,
                 O_KS = 16934912, O_VS = 17459200, O_CS = 17983488, O_FS = 18049024;
constexpr size_t MiB = 1u << 20;
constexpr size_t WS_ROPE = 1 * MiB;
constexpr size_t WS_WIN = 4 * MiB, WS_WM = 37 * MiB, WS_WO = 45 * MiB, WS_WUP = 53 * MiB, WS_WDN = 97 * MiB, WS_WG = 119 * MiB, WS_WP = 127 * MiB;
constexpr size_t WS_H = 128 * MiB;
constexpr size_t WS_R = 161 * MiB;
constexpr size_t WS_PROJ1 = WS_R, WS_PROJ2 = 230 * MiB, WS_AB = 295 * MiB;
constexpr size_t WS_MERGED = WS_R, WS_MO = 230 * MiB;
constexpr size_t WS_SA = 4 * MiB;
constexpr size_t WS_SG = 10 * MiB;
constexpr size_t WS_UAS = 13 * MiB, WS_UGS = 13 * MiB + 512 * 1024;
constexpr size_t WS_PP = 16 * MiB;
constexpr size_t WS_FIN = WS_R;
constexpr size_t WS_F = 250 * MiB;
constexpr size_t WS_X1B = 295 * MiB;
constexpr size_t WS_PB = 340 * MiB;
constexpr size_t WS_END = 345 * MiB;
constexpr int LDS_BYTES = 147456;
constexpr int NPHASE = 11;

struct Args { const float* in[25]; float* out; unsigned char* ws; int ph_lo, ph_hi; };

__device__ __forceinline__ unsigned cvt_pk_bf16(float lo, float hi) { unsigned r; asm("v_cvt_pk_bf16_f32 %0, %1, %2" : "=v"(r) : "v"(lo), "v"(hi)); return r; }
__device__ __forceinline__ float bflo(unsigned w) { return __uint_as_float(w << 16); }
__device__ __forceinline__ float bfhi(unsigned w) { return __uint_as_float(w & 0xffff0000u); }
__device__ __forceinline__ float bf1(bf16_t b) { return __uint_as_float(((unsigned)b) << 16); }
__device__ __forceinline__ void unpack8(u32x4 w, float* f) { f[0] = bflo(w.x); f[1] = bfhi(w.x); f[2] = bflo(w.y); f[3] = bfhi(w.y); f[4] = bflo(w.z); f[5] = bfhi(w.z); f[6] = bflo(w.w); f[7] = bfhi(w.w); }
__device__ __forceinline__ u32x4 pack8(f32x4 lo, f32x4 hi) { u32x4 w; w.x = cvt_pk_bf16(lo[0], lo[1]); w.y = cvt_pk_bf16(lo[2], lo[3]); w.z = cvt_pk_bf16(hi[0], hi[1]); w.w = cvt_pk_bf16(hi[2], hi[3]); return w; }
__device__ __forceinline__ u32x4 pack8a(const float* f) { u32x4 w; w.x = cvt_pk_bf16(f[0], f[1]); w.y = cvt_pk_bf16(f[2], f[3]); w.z = cvt_pk_bf16(f[4], f[5]); w.w = cvt_pk_bf16(f[6], f[7]); return w; }
__device__ __forceinline__ int fresh_lane() { int l; asm volatile("v_mbcnt_lo_u32_b32 %0, -1, 0\n\tv_mbcnt_hi_u32_b32 %0, -1, %0" : "=v"(l)); return l; }
#define NTL(p) __builtin_nontemporal_load(p)
__device__ __forceinline__ float wave_sum(float v) {
#pragma unroll
    for (int o = 1; o < 64; o <<= 1) v += __shfl_xor(v, o);
    return v;
}
__device__ __forceinline__ float wave_max(float v) {
#pragma unroll
    for (int o = 1; o < 64; o <<= 1) v = fmaxf(v, __shfl_xor(v, o));
    return v;
}
__device__ __forceinline__ float rcpf_(float x) { return __builtin_amdgcn_rcpf(x); }
__device__ __forceinline__ float sigm(float x) { return rcpf_(1.f + __expf(-x)); }
__device__ __forceinline__ float gelu_tanh(float x) { const float u = 0.7978845608028654f * (x + 0.044715f * x * x * x); return x * rcpf_(1.f + __expf(-2.f * u)); }
__device__ __forceinline__ const GAS float* x_row(const Args& a, int row) {
    return row < MP ? (const GAS float*)a.in[0] + (size_t)row * DM : (const GAS float*)a.in[1] + (size_t)(row - MP) * DM;
}

__device__ __forceinline__ void load_gates(const Args& a, int row, int col0, float* ea, float* eb) {
    const GAS bf16_t* p2 = (const GAS bf16_t*)(a.ws + WS_PROJ2) + (size_t)row * 4096 + col0;
    const u32x4 wa = *(const GAS u32x4*)p2, wb = *(const GAS u32x4*)(p2 + 2048);
    const GAS float* bg = (const GAS float*)a.in[17] + col0;
    const f32x4 b0l = *(const GAS f32x4*)bg, b0h = *(const GAS f32x4*)(bg + 4), b1l = *(const GAS f32x4*)(bg + 2048), b1h = *(const GAS f32x4*)(bg + 2052);
    float ga[8], gb[8]; unpack8(wa, ga); unpack8(wb, gb);
#pragma unroll
    for (int e = 0; e < 4; ++e) {
        ea[e] = fminf(__expf(-(ga[e] + b0l[e])), 1e30f); ea[e + 4] = fminf(__expf(-(ga[e + 4] + b0h[e])), 1e30f);
        eb[e] = fminf(__expf(-(gb[e] + b1l[e])), 1e30f); eb[e + 4] = fminf(__expf(-(gb[e + 4] + b1h[e])), 1e30f);
    }
}

template <int MODE>
__device__ __forceinline__ void epi8(const Args& a, int row, int col0, f32x4 lo, f32x4 hi) {
    unsigned char* ws = a.ws;
    if constexpr (MODE == 1) {
        GAS bf16_t* p = col0 < P1C ? (GAS bf16_t*)(ws + WS_PROJ1) + (size_t)row * P1C + col0 : (GAS bf16_t*)(ws + WS_PROJ2) + (size_t)row * 4096 + (col0 - P1C);
        *(GAS u32x4*)p = pack8(lo, hi);
    } else if constexpr (MODE == 3) {
        float ea[8], eb[8]; load_gates(a, row, col0, ea, eb);
#pragma unroll
        for (int e = 0; e < 4; ++e) { lo[e] = lo[e] * rcpf_(1.f + eb[e]); hi[e] = hi[e] * rcpf_(1.f + eb[e + 4]); }
        *(GAS u32x4*)((GAS bf16_t*)(ws + WS_MERGED) + (size_t)row * DM + col0) = pack8(lo, hi);
    } else if constexpr (MODE == 30) {
        *(GAS u32x4*)((GAS bf16_t*)(ws + WS_MERGED) + (size_t)row * DM + col0) = pack8(lo, hi);
    } else if constexpr (MODE == 4) {
        *(GAS u32x4*)((GAS bf16_t*)(ws + WS_MO) + (size_t)row * DM + col0) = pack8(lo, hi);
    } else if constexpr (MODE == 6) {
        const int ch = (col0 >> 8) * 128 + (col0 & 127);
        if (((col0 >> 7) & 1) == 0) {
            *(GAS u32x4*)((GAS bf16_t*)(ws + WS_UAS) + (size_t)(row - MP) * DFF + ch) = pack8(lo, hi);
            GAS float* o = (GAS float*)a.out + O_FS + (size_t)((row - MP) * 2 + 1) * DFF + ch; *(GAS f32x4*)o = lo; *(GAS f32x4*)(o + 4) = hi;
        } else {
            *(GAS u32x4*)((GAS bf16_t*)(ws + WS_UGS) + (size_t)(row - MP) * DFF + ch) = pack8(lo, hi);
        }
    } else if constexpr (MODE == 8) {
        *(GAS u32x4*)((GAS bf16_t*)(ws + WS_F) + (size_t)row * DM + col0) = pack8(lo, hi);
    } else if constexpr (MODE == 9) {
        *(GAS u32x4*)((GAS bf16_t*)(ws + WS_PP) + (size_t)row * DM + col0) = pack8(lo, hi);
    } else if constexpr (MODE == 10) {
        GAS float* o = (GAS float*)a.out + (size_t)row * DM + col0;
        const u32x4 xw = *(const GAS u32x4*)((const GAS bf16_t*)(ws + WS_H) + (size_t)row * DM + col0);
        const u32x4 pw = NTL((const GAS u32x4*)((const GAS bf16_t*)(ws + WS_PP) + (size_t)row * DM + col0));
        float pp[8], xx[8]; unpack8(pw, pp); unpack8(xw, xx); f32x4 y0, y1;
#pragma unroll
        for (int e = 0; e < 4; ++e) { y0[e] = xx[e] + sigm(lo[e]) * pp[e]; y1[e] = xx[e + 4] + sigm(hi[e]) * pp[e + 4]; }
        *(GAS f32x4*)o = y0; *(GAS f32x4*)(o + 4) = y1;
    }
}

__device__ __forceinline__ void glds_s(const char* sbase, unsigned voff, unsigned lds_dst) {
    unsigned keep;
    asm volatile("s_mov_b32 %0, m0\n\ts_mov_b32 m0, %3\n\ts_nop 0\n\tglobal_load_lds_dwordx4 %1, %2\n\ts_mov_b32 m0, %0" : "=&s"(keep) : "v"(voff), "s"(sbase), "s"(lds_dst) : "memory");
}
namespace pg8 {
constexpr int BM = 256, BK = 64, HALF = 128, HTB = HALF * BK * 2, STAGE_BYTES = 8 * HTB, NXCD = 8, WGM = 8;
__host__ __device__ __forceinline__ int lds_byte(int r, int c) { const int st = (r >> 4) * 2 + (c >> 5), rr = r & 15, cc = c & 31, ob = rr * 64 + cc * 2; return st * 1024 + (ob ^ (((ob >> 9) & 1) << 5)); }
__host__ __device__ __forceinline__ void stage_rc(int b, int& R, int& C) { const int st = b / 1024, sb = b % 1024, swz = sb ^ (((sb >> 9) & 1) << 5); R = (st >> 1) * 16 + swz / 64; C = (st & 1) * 32 + (swz % 64) / 2; }
__host__ __device__ __forceinline__ int perm32(int rho) { const int n = rho >> 4, i = rho & 15; return 8 * (i >> 2) + 4 * n + (i & 3); }
struct Unit { int pm, pn; };
struct StaticOrder {
    int nM, nN, nwg, G, c;
    __device__ void init(int M, int N, int G_, int c_) { nM = M / BM; nN = N / BM; nwg = nM * nN; G = G_; c = c_; }
    __device__ bool next(int i, Unit& u) const {
        const long L = (long)i * G + c; if (L >= nwg) return false;
        int wgid = (int)L; { const int q = nwg / NXCD, r = nwg % NXCD, xcd = wgid % NXCD, off = wgid / NXCD; wgid = (xcd < r ? xcd * (q + 1) : r * (q + 1) + (xcd - r) * q) + off; }
        const int nig = WGM * nN, gid = wgid / nig, fm = gid * WGM, gsz = (nM - fm) < WGM ? (nM - fm) : WGM;
        u.pm = fm + ((wgid % nig) % gsz); u.pn = (wgid % nig) / gsz; return true;
    }
};

template <int MODE>
__device__ __forceinline__ void tile_epi(const Args& a, const f32x4 (&acc)[2][2][4][2], const Unit& u, int wr, int wc, int fr, int fq) {
#pragma unroll
    for (int ai = 0; ai < 2; ++ai)
#pragma unroll
        for (int m = 0; m < 4; ++m)
#pragma unroll
            for (int bj = 0; bj < 2; ++bj)
                epi8<MODE>(a, u.pm * BM + ai * HALF + wr * 64 + m * 16 + fr, u.pn * BM + bj * HALF + wc * 32 + 8 * fq, acc[ai][bj][m][0], acc[ai][bj][m][1]);
}
template <int CTRL> __device__ __forceinline__ float dppf(float old, float src) {
    return __int_as_float(__builtin_amdgcn_update_dpp(__float_as_int(old), __float_as_int(src), CTRL, 0xf, 0xf, false));
}
__device__ __forceinline__ void tile_epi6(const Args& a, const f32x4 (&acc)[2][2][4][2], const Unit& u, int wr, int wc, int fr, int fq) {
    const int ch0 = u.pn * 128 + wc * 32 + 8 * fq;
    const GAS float* cw = (const GAS float*)a.in[20] + ch0; const GAS float* cbp = (const GAS float*)a.in[21] + ch0;
    float w0[8], w1[8], w2[8], bb[8];
    { const f32x4 a0 = *(const GAS f32x4*)cw, a1 = *(const GAS f32x4*)(cw + 4), b0 = *(const GAS f32x4*)(cw + DFF), b1 = *(const GAS f32x4*)(cw + DFF + 4), c0v = *(const GAS f32x4*)(cw + 2 * DFF), c1v = *(const GAS f32x4*)(cw + 2 * DFF + 4),
                  d0 = *(const GAS f32x4*)cbp, d1 = *(const GAS f32x4*)(cbp + 4);
#pragma unroll
      for (int e = 0; e < 4; ++e) { w0[e] = a0[e]; w0[e + 4] = a1[e]; w1[e] = b0[e]; w1[e + 4] = b1[e]; w2[e] = c0v[e]; w2[e + 4] = c1v[e]; bb[e] = d0[e]; bb[e + 4] = d1[e]; } }
    GAS bf16_t* FIN = (GAS bf16_t*)(a.ws + WS_FIN); GAS bf16_t* SA = (GAS bf16_t*)(a.ws + WS_SA); GAS bf16_t* SG = (GAS bf16_t*)(a.ws + WS_SG);
#pragma unroll
    for (int ai = 0; ai < 2; ++ai)
#pragma unroll
        for (int m = 0; m < 4; ++m) {
            const int row = u.pm * BM + ai * HALF + wr * 64 + m * 16 + fr, grp = row >> 6;
            float ov[8];
#pragma unroll
            for (int n = 0; n < 2; ++n)
#pragma unroll
                for (int e = 0; e < 4; ++e) {
                    const float cur = acc[ai][0][m][n][e];
                    float r1 = 0.f, r2 = 0.f;
                    if (m > 0) { const float pv = acc[ai][0][m > 0 ? m - 1 : 0][n][e]; r1 = dppf<0x121>(0.f, pv); r2 = dppf<0x122>(0.f, pv); }
                    const float p1 = dppf<0x111>(r1, cur), p2 = dppf<0x112>(r2, cur);
                    const int k = 4 * n + e;
                    ov[k] = gelu_tanh(w0[k] * p2 + w1[k] * p1 + w2[k] * cur + bb[k]) * acc[ai][1][m][n][e];
                }
            if (m == 0 && fr < 2) {
                *(GAS u32x4*)(SA + ((size_t)grp * 4 + 2 + fr) * DFF + ch0) = pack8(acc[ai][0][m][0], acc[ai][0][m][1]);
                *(GAS u32x4*)(SG + ((size_t)grp * 2 + fr) * DFF + ch0) = pack8(acc[ai][1][m][0], acc[ai][1][m][1]);
            } else {
                *(GAS u32x4*)(FIN + (size_t)row * DFF + ch0) = pack8a(ov);
            }
            if (m == 3 && fr >= 14) {
                *(GAS u32x4*)(SA + ((size_t)grp * 4 + (fr - 14)) * DFF + ch0) = pack8(acc[ai][0][m][0], acc[ai][0][m][1]);
                const int t = row & (SEQ - 1);
                if (t >= SEQ - 2) { GAS float* o = (GAS float*)a.out + O_FP + (size_t)((row >> 12) * 2 + (t - (SEQ - 2))) * DFF + ch0; *(GAS f32x4*)o = acc[ai][0][m][0]; *(GAS f32x4*)(o + 4) = acc[ai][0][m][1]; }
            }
        }
}
__device__ __forceinline__ void mid_scale(const Args& a, f32x4 (&acc)[2][2][4][2], const Unit& u, int wr, int wc, int fr, int fq) {
    int z = 0; asm volatile("" : "+v"(z));
    fr += z;
#pragma unroll
    for (int ai = 0; ai < 2; ++ai)
#pragma unroll
        for (int m = 0; m < 4; ++m)
#pragma unroll
            for (int bj = 0; bj < 2; ++bj) {
                float ea[8], eb[8]; load_gates(a, u.pm * BM + ai * HALF + wr * 64 + m * 16 + fr, u.pn * BM + bj * HALF + wc * 32 + 8 * fq, ea, eb);
#pragma unroll
                for (int e = 0; e < 4; ++e) { acc[ai][bj][m][0][e] *= (1.f + eb[e]) * rcpf_(1.f + ea[e]); acc[ai][bj][m][1][e] *= (1.f + eb[e + 4]) * rcpf_(1.f + ea[e + 4]); }
                __builtin_amdgcn_sched_barrier(0);
            }
}

template <int MODE, int N, int K>
__device__ __forceinline__ void gemm_phase(LAS unsigned char* lds, const Args& args, const bf16_t* gA, const bf16_t* gBt, int G, int bid, int wid_in) {
    const int wid = wid_in, lane = fresh_lane(), tid = wid * 64 + lane, wr = wid >> 2, wc = wid & 3, fr = lane & 15, fq = lane >> 4;
    const int nt = K / BK;
    StaticOrder S; S.init(MP, N, G, bid);
    unsigned voffA, voffB;
    { int R, C; stage_rc(tid * 16, R, C); const int Rb = (R & ~31) + perm32(R & 31); voffA = (unsigned)(R * K + C) * 2u; voffB = (unsigned)(Rb * K + C) * 2u; }
    const unsigned ldsbase = (unsigned)(size_t)lds;
    const size_t kstep = (size_t)(BK * 2);
    const size_t hstep = (size_t)HALF * K * 2;
    const size_t tstep = 2 * hstep;
    const unsigned ldsw = (unsigned)wid * 1024u;
    const int aoff = lds_byte(wr * 64 + fr, fq * 8), boff = lds_byte(wc * 32 + fr, fq * 8);
#define PG8_SA(b, h) (((b) * 2 + (h)) * HTB)
#define PG8_SB(b, h) ((4 + (b) * 2 + (h)) * HTB)
#define PG8_STAGE(bufoff, gbase, voff) do { glds_s((const char*)(gbase), (voff), ldsbase + (unsigned)(bufoff) + ldsw); \
        glds_s((const char*)(gbase) + (size_t)64 * K * 2, (voff), ldsbase + (unsigned)(bufoff) + ldsw + 8192u); } while (0)
#define PG8_LDA(dst, b, h) do { _Pragma("unroll") for (int m = 0; m < 4; ++m) _Pragma("unroll") for (int k = 0; k < 2; ++k) dst[m][k] = *(const LAS bf16x8*)(lds + PG8_SA(b, h) + aoff + m * 2048 + k * 1024); } while (0)
#define PG8_LDB(dst, b, h) do { _Pragma("unroll") for (int n = 0; n < 2; ++n) _Pragma("unroll") for (int k = 0; k < 2; ++k) dst[n][k] = *(const LAS bf16x8*)(lds + PG8_SB(b, h) + boff + n * 2048 + k * 1024); } while (0)
#define PG8_MMA(ai, bj, At, Bt) do { __builtin_amdgcn_s_setprio(1); _Pragma("unroll") for (int m = 0; m < 4; ++m) _Pragma("unroll") for (int n = 0; n < 2; ++n) _Pragma("unroll") for (int k = 0; k < 2; ++k) \
        acc[ai][bj][m][n] = __builtin_amdgcn_mfma_f32_16x16x32_bf16(Bt[n][k], At[m][k], acc[ai][bj][m][n], 0, 0, 0); __builtin_amdgcn_s_setprio(0); } while (0)
#define PG8_WAIT_V(n) asm volatile("s_waitcnt vmcnt(" #n ")" ::: "memory")
#define PG8_WAIT_L(n) asm volatile("s_waitcnt lgkmcnt(" #n ")" ::: "memory")
#define PG8_BAR __builtin_amdgcn_s_barrier()
#define PG8_SCHED __builtin_amdgcn_sched_barrier(0)
    Unit cur, nxt; int ui = 0;
    if (!S.next(0, cur)) return;
    f32x4 acc[2][2][4][2];
#pragma unroll
    for (int a = 0; a < 2; ++a)
#pragma unroll
        for (int b = 0; b < 2; ++b)
#pragma unroll
            for (int m = 0; m < 4; ++m)
#pragma unroll
                for (int n = 0; n < 2; ++n) acc[a][b][m][n] = (f32x4){0.f, 0.f, 0.f, 0.f};
    bf16x8 At[4][2], B0[2][2], B1[2][2];
    const char* cA = (const char*)gA + (size_t)cur.pm * tstep; const char* cB = (const char*)gBt + (size_t)cur.pn * tstep;
    PG8_STAGE(PG8_SB(0, 0), cB, voffB); PG8_STAGE(PG8_SB(0, 1), cB + hstep, voffB); PG8_STAGE(PG8_SA(0, 0), cA, voffA); PG8_STAGE(PG8_SA(0, 1), cA + hstep, voffA);
    if (wr == 1) PG8_BAR;
    PG8_WAIT_V(2); PG8_BAR;
    PG8_STAGE(PG8_SB(1, 0), cB + kstep, voffB); PG8_STAGE(PG8_SA(1, 0), cA + kstep, voffA); PG8_STAGE(PG8_SB(1, 1), cB + hstep + kstep, voffB);
    PG8_WAIT_V(6); PG8_BAR;
    for (;;) {
        const bool has_next = S.next(ui + 1, nxt);
        const char* nA = has_next ? (const char*)gA + (size_t)nxt.pm * tstep : cA; const char* nB = has_next ? (const char*)gBt + (size_t)nxt.pn * tstep : cB;
        for (int t = 0; t < nt; t += 2) {
            const bool last = (t == nt - 2);
            const char* a1 = cA + (size_t)(t + 1) * kstep;
            const char* a2 = last ? nA : cA + (size_t)(t + 2) * kstep; const char* b2 = last ? nB : cB + (size_t)(t + 2) * kstep;
            const char* a3 = a2 + kstep; const char* b3 = b2 + kstep;
            if constexpr (MODE == 3) { if (t == (nt >> 1)) { mid_scale(args, acc, cur, wr, wc, fr, fq); PG8_SCHED; } }
            PG8_LDB(B0, 0, 0); PG8_LDB(B1, 0, 1); PG8_SCHED; PG8_LDA(At, 0, 0); PG8_STAGE(PG8_SA(1, 1), a1 + hstep, voffA);
            PG8_WAIT_V(8); PG8_WAIT_L(0); PG8_BAR; PG8_MMA(0, 0, At, B0); PG8_MMA(0, 1, At, B1); PG8_BAR; PG8_SCHED;
            PG8_LDA(At, 0, 1); PG8_STAGE(PG8_SB(0, 0), b2, voffB); PG8_STAGE(PG8_SB(0, 1), b2 + hstep, voffB); PG8_STAGE(PG8_SA(0, 0), a2, voffA);
            PG8_WAIT_V(8); PG8_WAIT_L(0); PG8_BAR; PG8_MMA(1, 0, At, B0); PG8_MMA(1, 1, At, B1); PG8_BAR; PG8_SCHED;
            PG8_LDB(B0, 1, 0); PG8_LDB(B1, 1, 1); PG8_SCHED; PG8_LDA(At, 1, 0); PG8_STAGE(PG8_SA(0, 1), a2 + hstep, voffA);
            PG8_WAIT_V(8); PG8_WAIT_L(0); PG8_BAR; PG8_MMA(0, 0, At, B0); PG8_MMA(0, 1, At, B1); PG8_BAR; PG8_SCHED;
            PG8_LDA(At, 1, 1); PG8_STAGE(PG8_SB(1, 0), b3, voffB); PG8_STAGE(PG8_SB(1, 1), b3 + hstep, voffB); PG8_STAGE(PG8_SA(1, 0), a3, voffA);
            PG8_WAIT_V(8); PG8_WAIT_L(0); PG8_BAR; PG8_MMA(1, 0, At, B0); PG8_MMA(1, 1, At, B1); PG8_BAR; PG8_SCHED;
        }
        if (wr == 0) PG8_BAR;
        if constexpr (MODE == 6) tile_epi6(args, acc, cur, wr, wc, fr, fq); else tile_epi<MODE>(args, acc, cur, wr, wc, fr, fq);
        if (!has_next) break;
#pragma unroll
        for (int a = 0; a < 2; ++a)
#pragma unroll
            for (int b = 0; b < 2; ++b)
#pragma unroll
                for (int m = 0; m < 4; ++m)
#pragma unroll
                    for (int n = 0; n < 2; ++n) acc[a][b][m][n] = (f32x4){0.f, 0.f, 0.f, 0.f};
        cur = nxt; cA = nA; cB = nB; ++ui;
        if (wr == 1) PG8_BAR;
    }
    PG8_WAIT_V(0);
    PG8_BAR;
#undef PG8_SA
#undef PG8_SB
#undef PG8_STAGE
#undef PG8_LDA
#undef PG8_LDB
#undef PG8_MMA
#undef PG8_WAIT_V
#undef PG8_WAIT_L
#undef PG8_BAR
#undef PG8_SCHED
}
}

template <int MODE, int N, int K>
__device__ __forceinline__ void skinny_gemm(LAS unsigned char* lds, const Args& args, const bf16_t* A, const bf16_t* Bt, int G, int bid, int wid_in) {
    const int wid = wid_in, lane = fresh_lane(), tid = wid * 64 + lane, fr = lane & 15, fq = lane >> 4;
    LAS float* P = (LAS float*)lds;
    constexpr int nitems = N / 16, kw = K / 8, NS = kw / 32;
    constexpr int GRP = (NS % 11 == 0) ? 11 : ((NS % 8 == 0) ? 8 : NS);
    static_assert(kw % 32 == 0 && NS % GRP == 0, "skinny K split");
    for (int it = G - 1 - bid; it < nitems; it += G) {
        const int n0 = it * 16;
        const GAS bf16_t* ap = (const GAS bf16_t*)A + (size_t)fr * K + wid * kw + 8 * fq;
        const GAS bf16_t* bp = (const GAS bf16_t*)Bt + (size_t)(n0 + fr) * K + wid * kw + 8 * fq;
        f32x4 acc0 = {0.f, 0.f, 0.f, 0.f}, acc1 = acc0;
#pragma unroll 1
        for (int g = 0; g < NS; g += GRP) {
            bf16x8 a0[GRP], a1[GRP], bv[GRP];
#pragma unroll
            for (int i = 0; i < GRP; ++i) { const int k = (g + i) * 32; a0[i] = *(const GAS bf16x8*)(ap + k); a1[i] = *(const GAS bf16x8*)(ap + (size_t)16 * K + k); bv[i] = *(const GAS bf16x8*)(bp + k); }
#pragma unroll
            for (int i = 0; i < GRP; ++i) { acc0 = __builtin_amdgcn_mfma_f32_16x16x32_bf16(a0[i], bv[i], acc0, 0, 0, 0); acc1 = __builtin_amdgcn_mfma_f32_16x16x32_bf16(a1[i], bv[i], acc1, 0, 0, 0); }
        }
#pragma unroll
        for (int j = 0; j < 4; ++j) { P[(wid * 32 + 4 * fq + j) * 17 + fr] = acc0[j]; P[(wid * 32 + 16 + 4 * fq + j) * 17 + fr] = acc1[j]; }
        __syncthreads();
        if (tid < 64) {
            const int r = tid >> 1, c0 = (tid & 1) * 8;
            f32x4 l0 = {0.f, 0.f, 0.f, 0.f}, h0 = l0, l1 = l0, h1 = l0;
#pragma unroll
            for (int w = 0; w < 4; ++w)
#pragma unroll
                for (int e = 0; e < 4; ++e) {
                    l0[e] += P[(w * 32 + r) * 17 + c0 + e]; h0[e] += P[(w * 32 + r) * 17 + c0 + 4 + e];
                    l1[e] += P[((w + 4) * 32 + r) * 17 + c0 + e]; h1[e] += P[((w + 4) * 32 + r) * 17 + c0 + 4 + e];
                }
            const int row = MP + r, col0 = n0 + c0;
            if constexpr (MODE == 3) {
                float ea[8], eb[8]; load_gates(args, row, col0, ea, eb); f32x4 lo, hi;
#pragma unroll
                for (int e = 0; e < 4; ++e) { lo[e] = l0[e] * rcpf_(1.f + ea[e]) + l1[e] * rcpf_(1.f + eb[e]); hi[e] = h0[e] * rcpf_(1.f + ea[e + 4]) + h1[e] * rcpf_(1.f + eb[e + 4]); }
                epi8<30>(args, row, col0, lo, hi);
            } else {
                epi8<MODE>(args, row, col0, l0 + l1, h0 + h1);
            }
        }
        __syncthreads();
    }
}

__device__ __forceinline__ void p0_transpose_item(const GAS float* W, int K, int N, GAS bf16_t* WT, int ldt, int k_off, int up_mode, LAS float* scr, int item, int lane) {
    const int nblk = N / 32, kb = item / nblk, nb = item % nblk, k0 = 64 * kb, n0 = 32 * nb;
    int rowbase = n0;
    if (up_mode) rowbase = n0 < DFF ? (n0 >> 7) * 256 + (n0 & 127) : ((n0 - DFF) >> 7) * 256 + 128 + ((n0 - DFF) & 127);
    {
        const int r8 = lane >> 3, c4 = (lane & 7) * 4;
        f32x4 v[8];
#pragma unroll
        for (int i = 0; i < 8; ++i) v[i] = __builtin_nontemporal_load((const GAS f32x4*)(W + (size_t)(k0 + 8 * i + r8) * N + n0 + c4));
#pragma unroll
        for (int i = 0; i < 8; ++i) { LAS float* d = scr + (8 * i + r8) * 33 + c4; d[0] = v[i].x; d[1] = v[i].y; d[2] = v[i].z; d[3] = v[i].w; }
    }
    asm volatile("s_waitcnt lgkmcnt(0)" ::: "memory");
    const int c = lane & 7;
#pragma unroll
    for (int j = 0; j < 4; ++j) { const int n = (lane >> 3) + 8 * j; const LAS float* s = scr + (8 * c) * 33 + n;
        u32x4 o; o.x = cvt_pk_bf16(s[0 * 33], s[1 * 33]); o.y = cvt_pk_bf16(s[2 * 33], s[3 * 33]); o.z = cvt_pk_bf16(s[4 * 33], s[5 * 33]); o.w = cvt_pk_bf16(s[6 * 33], s[7 * 33]);
        *(GAS u32x4*)(WT + (size_t)(rowbase + n) * ldt + k_off + k0 + 8 * c) = o; }
    asm volatile("s_waitcnt lgkmcnt(0)" ::: "memory");
}

template <int SET>
__device__ __forceinline__ void late_weights(const Args& a, LAS unsigned char* lds, int w0, int nw, int wid_in) {
    const int lane = fresh_lane();
    unsigned char* ws = a.ws;
    LAS float* scr = (LAS float*)(lds + wid_in * 16384);
    constexpr int I_BR = 16 * 64, I_O = 32 * 64, I_UP = 32 * 352, I_DN = 88 * 64, I_G = 32 * 64, I_P = 4 * 64;
    if constexpr (SET == 1) {
        for (int it = w0; it < 2 * I_BR + I_O + I_P + I_UP; it += nw) {
            int r = it;
            if (r < I_BR) { p0_transpose_item((const GAS float*)a.in[15], 1024, 2048, (GAS bf16_t*)(ws + WS_WM), 2048, 0, 0, scr, r, lane); continue; } r -= I_BR;
            if (r < I_BR) { p0_transpose_item((const GAS float*)a.in[16], 1024, 2048, (GAS bf16_t*)(ws + WS_WM), 2048, 1024, 0, scr, r, lane); continue; } r -= I_BR;
            if (r < I_O) { p0_transpose_item((const GAS float*)a.in[18], 2048, 2048, (GAS bf16_t*)(ws + WS_WO), 2048, 0, 0, scr, r, lane); continue; } r -= I_O;
            if (r < I_P) { p0_transpose_item((const GAS float*)a.in[23], PLE, 2048, (GAS bf16_t*)(ws + WS_WP), PLE, 0, 0, scr, r, lane); continue; } r -= I_P;
            p0_transpose_item((const GAS float*)a.in[19], 2048, 2 * DFF, (GAS bf16_t*)(ws + WS_WUP), 2048, 0, 1, scr, r, lane);
        }
    } else {
        for (int it = w0; it < I_DN + I_G; it += nw) {
            int r = it;
            if (r < I_DN) { p0_transpose_item((const GAS float*)a.in[22], DFF, 2048, (GAS bf16_t*)(ws + WS_WDN), DFF, 0, 0, scr, r, lane); continue; } r -= I_DN;
            p0_transpose_item((const GAS float*)a.in[24], 2048, 2048, (GAS bf16_t*)(ws + WS_WG), 2048, 0, 0, scr, r, lane);
        }
    }
}
__device__ __forceinline__ void p0_prologue(const Args& a, LAS unsigned char* lds, int bid, int G, int wid_in) {
    const int wid = wid_in, lane = fresh_lane(), tid = wid * 64 + lane;
    const int gw = bid * 8 + wid, NGW = G * 8, gtid = bid * 512 + tid, GT = G * 512;
    unsigned char* ws = a.ws;
    LAS float* scr = (LAS float*)(lds + wid * 16384);
    constexpr int I_IN = 32 * 264;
    for (int it = gw; it < I_IN; it += NGW) p0_transpose_item((const GAS float*)a.in[12], 2048, INC, (GAS bf16_t*)(ws + WS_WIN), 2048, 0, 0, scr, it, lane);
    if (gw < MT) {
        f32x4 g[8];
        { const GAS f32x4* gp = (const GAS f32x4*)a.in[8] + lane;
#pragma unroll
          for (int j = 0; j < 8; ++j) g[j] = gp[64 * j]; }
        int m = gw; f32x4 v[8];
        { const GAS f32x4* xr = (const GAS f32x4*)x_row(a, m) + lane;
#pragma unroll
          for (int j = 0; j < 8; ++j) v[j] = NTL(xr + 64 * j); }
        for (;;) {
            const int mn = m + NGW; const bool has = mn < MT; const int mp = has ? mn : m;
            f32x4 nv[8];
            { const GAS f32x4* xr = (const GAS f32x4*)x_row(a, mp) + lane;
#pragma unroll
              for (int j = 0; j < 8; ++j) nv[j] = NTL(xr + 64 * j); }
            float s = 0.f;
#pragma unroll
            for (int j = 0; j < 8; ++j) s += (v[j].x * v[j].x + v[j].y * v[j].y) + (v[j].z * v[j].z + v[j].w * v[j].w);
            const float rstd = 1.f / sqrtf(wave_sum(s) * (1.f / DM) + EPS);
            GAS u32x2* o = (GAS u32x2*)((GAS bf16_t*)(ws + WS_H) + (size_t)m * DM) + lane;
#pragma unroll
            for (int j = 0; j < 8; ++j) { u32x2 w; w.x = cvt_pk_bf16(v[j].x * rstd * g[j].x, v[j].y * rstd * g[j].y); w.y = cvt_pk_bf16(v[j].z * rstd * g[j].z, v[j].w * rstd * g[j].w); o[64 * j] = w; }
            if (!has) break;
#pragma unroll
            for (int j = 0; j < 8; ++j) v[j] = nv[j];
            m = mn;
        }
    }
    for (int i = gtid; i < MT * 32; i += GT) {
        const int row = i >> 5, c8 = (i & 31) * 8;
        const GAS float* src = row < MP ? (const GAS float*)a.in[6] + (size_t)row * PLE + c8 : (const GAS float*)a.in[7] + (size_t)(row - MP) * PLE + c8;
        const f32x4 lo = NTL((const GAS f32x4*)src), hi = NTL((const GAS f32x4*)(src + 4));
        *(GAS u32x4*)((GAS bf16_t*)(ws + WS_PB) + (size_t)row * PLE + c8) = pack8(lo, hi);
    }
    for (int i = gtid; i < 4097 * 32; i += GT) {
        const int pi = i >> 5, fi = i & 31; const int pos = pi < 4096 ? pi : 16384;
        double inv = 1.0; for (int k = 0; k < fi; ++k) inv *= 0.7498942093324559;
        const float ang = (float)pos * (float)inv;
        double f = (double)ang * 0.15915494309189535; f -= __builtin_rint(f);
        GAS float* o = (GAS float*)(ws + WS_ROPE) + (size_t)i * 2;
        o[0] = __builtin_amdgcn_cosf((float)f); o[1] = __builtin_amdgcn_sinf((float)f);
    }
    for (int i = gtid; i < MS * CW; i += GT) { const int b = i / CW, c = i % CW; ((GAS float*)a.out)[O_CS + (size_t)(b * 2) * CW + c] = ((const GAS float*)a.in[4])[(size_t)(b * 2 + 1) * CW + c]; }
    for (int i = gtid; i < MS * DFF; i += GT) { const int b = i / DFF, c = i % DFF; ((GAS float*)a.out)[O_FS + (size_t)(b * 2) * DFF + c] = ((const GAS float*)a.in[5])[(size_t)(b * 2 + 1) * DFF + c]; }
}

constexpr int QS = 72, VS = 280;
__device__ __forceinline__ void rope8r(const f32x4* t, const float* x1, const float* x2, float sc, float* o1, float* o2) {
    const float c[8] = {t[0].x, t[0].z, t[1].x, t[1].z, t[2].x, t[2].z, t[3].x, t[3].z}, s[8] = {t[0].y, t[0].w, t[1].y, t[1].w, t[2].y, t[2].w, t[3].y, t[3].w};
#pragma unroll
    for (int e = 0; e < 8; ++e) { o1[e] = (x1[e] * c[e] - x2[e] * s[e]) * sc; o2[e] = (x2[e] * c[e] + x1[e] * s[e]) * sc; }
}
struct AttnRegs { u32x4 q1[4], q2[4], kc1, kc2, kp1, kp2, vv[4]; f32x4 rq[4], rp[4]; };
__device__ __forceinline__ void attn_load(const Args& a, int u, int tid, AttnRegs& R) {
    const int hq = u & 1, kv = (u >> 1) & 1, j = (u >> 2) & 31, n = u >> 7, h0 = kv * 8 + hq * 4;
    const GAS bf16_t* P1 = (const GAS bf16_t*)(a.ws + WS_PROJ1);
    const GAS float* ROPE = (const GAS float*)(a.ws + WS_ROPE);
    const bool hasprev = j > 0;
    const int r = tid >> 2, g = tid & 3, posq = j * 128 + r, posp = hasprev ? posq - 128 : posq;
    const GAS bf16_t* rowq = P1 + (size_t)(n * SEQ + posq) * P1C;
    const GAS bf16_t* rowp = P1 + (size_t)(n * SEQ + posp) * P1C;
#pragma unroll
    for (int i = 0; i < 4; ++i) { R.q1[i] = NTL((const GAS u32x4*)(rowq + (h0 + i) * 64 + 8 * g)); R.q2[i] = NTL((const GAS u32x4*)(rowq + (h0 + i) * 64 + 32 + 8 * g)); }
    R.kc1 = *(const GAS u32x4*)(rowq + C_K + kv * 64 + 8 * g); R.kc2 = *(const GAS u32x4*)(rowq + C_K + kv * 64 + 32 + 8 * g);
    R.kp1 = *(const GAS u32x4*)(rowp + C_K + kv * 64 + 8 * g); R.kp2 = *(const GAS u32x4*)(rowp + C_K + kv * 64 + 32 + 8 * g);
    const GAS f32x4* rq = (const GAS f32x4*)(ROPE + (size_t)(posq * 32 + 8 * g) * 2);
    const GAS f32x4* rp = (const GAS f32x4*)(ROPE + (size_t)(posp * 32 + 8 * g) * 2);
#pragma unroll
    for (int i = 0; i < 4; ++i) { R.rq[i] = rq[i]; R.rp[i] = rp[i]; }
    const int vk = tid >> 3, dg = tid & 7;
#pragma unroll
    for (int ps = 0; ps < 4; ++ps) {
        const int c = ps * 64 + vk; const int pos = (ps < 2) ? (hasprev ? j * 128 - 128 + c : j * 128 + c) : j * 128 - 128 + c;
        R.vv[ps] = *(const GAS u32x4*)(P1 + (size_t)(n * SEQ + pos) * P1C + C_V + kv * 64 + 8 * dg);
    }
}
constexpr int QBUF = 128 * QS;
__device__ __forceinline__ void attn_write_q(LAS bf16_t* Qb, const AttnRegs& R, int i, int tid) {
    const int r = tid >> 2, g = tid & 3;
    float x1[8], x2[8], o1[8], o2[8];
    unpack8(R.q1[i], x1); unpack8(R.q2[i], x2); rope8r(R.rq, x1, x2, 0.125f, o1, o2);
    *(LAS u32x4*)(Qb + r * QS + 8 * g) = pack8a(o1); *(LAS u32x4*)(Qb + r * QS + 32 + 8 * g) = pack8a(o2);
}

__device__ __forceinline__ void attn_prompt_unit(const Args& a, LAS unsigned char* lds, int u, int wid_in) {
    const int wid = wid_in, lane = fresh_lane(), tid = wid * 64 + lane, fr = lane & 15, fq = lane >> 4;
    const int hq = u & 1, kv = (u >> 1) & 1, j = (u >> 2) & 31, n = u >> 7, h0 = kv * 8 + hq * 4;
    LAS bf16_t* Qs0 = (LAS bf16_t*)lds; LAS bf16_t* Ks = Qs0 + 2 * QBUF; LAS bf16_t* Vt = Ks + 256 * QS;
    const bool wr_state = (j == 31) && (hq == 0);
    const bool hasprev = j > 0;
    AttnRegs R; attn_load(a, u, tid, R);
    {
        const int r = tid >> 2, g = tid & 3, vk = tid >> 3, dg = tid & 7;
        float x1[8], x2[8], o1[8], o2[8];
        attn_write_q(Qs0, R, 0, tid);
        unpack8(R.kc1, x1); unpack8(R.kc2, x2); rope8r(R.rq, x1, x2, 1.f, o1, o2);
        if (wr_state) {
            GAS float* o = (GAS float*)a.out + O_KP + ((size_t)(n * 128 + r) * 2 + kv) * 64 + 8 * g;
            *(GAS f32x4*)o = (f32x4){o1[0], o1[1], o1[2], o1[3]}; *(GAS f32x4*)(o + 4) = (f32x4){o1[4], o1[5], o1[6], o1[7]};
            *(GAS f32x4*)(o + 32) = (f32x4){o2[0], o2[1], o2[2], o2[3]}; *(GAS f32x4*)(o + 36) = (f32x4){o2[4], o2[5], o2[6], o2[7]};
        }
        *(LAS u32x4*)(Ks + (128 + r) * QS + 8 * g) = pack8a(o1); *(LAS u32x4*)(Ks + (128 + r) * QS + 32 + 8 * g) = pack8a(o2);
        unpack8(R.kp1, x1); unpack8(R.kp2, x2); rope8r(R.rp, x1, x2, hasprev ? 1.f : 0.f, o1, o2);
        *(LAS u32x4*)(Ks + r * QS + 8 * g) = pack8a(o1); *(LAS u32x4*)(Ks + r * QS + 32 + 8 * g) = pack8a(o2);
#pragma unroll
        for (int ps = 0; ps < 4; ++ps) {
            const int c = ps * 64 + vk;
            u32x4 w = R.vv[ps];
            if (ps < 2 && !hasprev) w = (u32x4){0u, 0u, 0u, 0u};
            const unsigned ww[4] = {w.x, w.y, w.z, w.w};
#pragma unroll
            for (int e = 0; e < 4; ++e) { Vt[(8 * dg + 2 * e) * VS + c] = (bf16_t)(ww[e] & 0xffffu); Vt[(8 * dg + 2 * e + 1) * VS + c] = (bf16_t)(ww[e] >> 16); }
            if (ps >= 2 && wr_state) {
                float v[8]; unpack8(w, v);
                GAS float* o = (GAS float*)a.out + O_VP + ((size_t)(n * 128 + (c - 128)) * 2 + kv) * 64 + 8 * dg;
                *(GAS f32x4*)o = (f32x4){v[0], v[1], v[2], v[3]}; *(GAS f32x4*)(o + 4) = (f32x4){v[4], v[5], v[6], v[7]};
            }
        }
    }
    for (int i = tid; i < 64 * 24; i += 512) Vt[(i / 24) * VS + 256 + (i % 24)] = 0;
    __syncthreads();
#pragma unroll
    for (int hi = 0; hi < 4; ++hi) {
    const int h = h0 + hi;
    LAS bf16_t* Qs = Qs0 + (hi & 1) * QBUF;
    if (hi < 3) attn_write_q(Qs0 + ((hi + 1) & 1) * QBUF, R, hi + 1, tid);
    const bf16x8 bq0 = *(const LAS bf16x8*)(Qs + (16 * wid + fr) * QS + 8 * fq), bq1 = *(const LAS bf16x8*)(Qs + (16 * wid + fr) * QS + 32 + 8 * fq);
    f32x4 s[9], s2[9];
#pragma unroll
    for (int b = 0; b < 9; ++b) {
        const int kb = wid + b;
        const bf16x8 k0 = *(const LAS bf16x8*)(Ks + (16 * kb + fr) * QS + 8 * fq), k1 = *(const LAS bf16x8*)(Ks + (16 * kb + fr) * QS + 32 + 8 * fq);
        const f32x4 z = {0.f, 0.f, 0.f, 0.f};
        s[b] = __builtin_amdgcn_mfma_f32_16x16x32_bf16(k0, bq0, z, 0, 0, 0);
        s2[b] = __builtin_amdgcn_mfma_f32_16x16x32_bf16(k1, bq1, z, 0, 0, 0);
    }
    __builtin_amdgcn_sched_barrier(0);
    asm volatile("s_nop 7\n\ts_nop 7" ::: "memory");
#pragma unroll
    for (int b = 0; b < 9; ++b) { asm volatile("" : "+v"(s[b]), "+v"(s2[b])); s[b] = s[b] + s2[b]; }
    const float sink = ((const GAS float*)a.in[13])[h];
    const int qi = 16 * wid + fr;
    float mx = sink;
#pragma unroll
    for (int b = 0; b < 9; ++b)
#pragma unroll
        for (int e = 0; e < 4; ++e) {
            const int c = 16 * (wid + b) + 4 * fq + e;
            const bool ok = (c > qi) && (c <= qi + 128) && (j > 0 || c >= 128);
            s[b][e] = ok ? s[b][e] : -1e30f;
            mx = fmaxf(mx, s[b][e]);
        }
    mx = fmaxf(mx, __shfl_xor(mx, 16)); mx = fmaxf(mx, __shfl_xor(mx, 32));
    float sum = 0.f;
#pragma unroll
    for (int b = 0; b < 9; ++b)
#pragma unroll
        for (int e = 0; e < 4; ++e) { const float p = s[b][e] > -1e29f ? __expf(s[b][e] - mx) : 0.f; s[b][e] = p; sum += p; }
    sum += __shfl_xor(sum, 16); sum += __shfl_xor(sum, 32);
    const float inv = 1.f / (sum + __expf(sink - mx));
    f32x4 ot[5][4];
#pragma unroll
    for (int pi = 0; pi < 5; ++pi) {
        const int kb0 = wid + 2 * pi, kb1 = kb0 + 1;
        u32x4 pw; pw.x = cvt_pk_bf16(s[2 * pi][0], s[2 * pi][1]); pw.y = cvt_pk_bf16(s[2 * pi][2], s[2 * pi][3]);
        if (pi < 4) { pw.z = cvt_pk_bf16(s[2 * pi + 1 < 9 ? 2 * pi + 1 : 8][0], s[2 * pi + 1 < 9 ? 2 * pi + 1 : 8][1]); pw.w = cvt_pk_bf16(s[2 * pi + 1 < 9 ? 2 * pi + 1 : 8][2], s[2 * pi + 1 < 9 ? 2 * pi + 1 : 8][3]); }
        else { pw.z = 0u; pw.w = 0u; }
        const bf16x8 pb = __builtin_bit_cast(bf16x8, pw);
#pragma unroll
        for (int d = 0; d < 4; ++d) {
            const u32x2 lo = *(const LAS u32x2*)(Vt + (16 * d + fr) * VS + 16 * kb0 + 4 * fq), hi = *(const LAS u32x2*)(Vt + (16 * d + fr) * VS + 16 * kb1 + 4 * fq);
            const u32x4 vw = {lo.x, lo.y, hi.x, hi.y};
            const f32x4 zz = {0.f, 0.f, 0.f, 0.f};
            ot[pi][d] = __builtin_amdgcn_mfma_f32_16x16x32_bf16(__builtin_bit_cast(bf16x8, vw), pb, zz, 0, 0, 0);
        }
    }
    __builtin_amdgcn_sched_barrier(0);
    asm volatile("s_nop 7\n\ts_nop 7" ::: "memory");
    f32x4 o[4];
#pragma unroll
    for (int d = 0; d < 4; ++d) {
#pragma unroll
        for (int pi = 0; pi < 5; ++pi) asm volatile("" : "+v"(ot[pi][d]));
        o[d] = ((ot[0][d] + ot[1][d]) + (ot[2][d] + ot[3][d])) + ot[4][d];
    }
    GAS bf16_t* dst = (GAS bf16_t*)(a.ws + WS_AB) + (size_t)(n * SEQ + j * 128 + qi) * DM + h * 64 + 4 * fq;
#pragma unroll
    for (int d = 0; d < 4; ++d) { u32x2 w; w.x = cvt_pk_bf16(o[d][0] * inv, o[d][1] * inv); w.y = cvt_pk_bf16(o[d][2] * inv, o[d][3] * inv); *(GAS u32x2*)(dst + 16 * d) = w; }
    __syncthreads();
    }
}

__device__ __forceinline__ void attn_sample_unit(const Args& a, LAS unsigned char* lds, int b, int wid_in) {
    const int wid = wid_in, lane = fresh_lane(), tid = wid * 64 + lane;
    LAS float* qf = (LAS float*)lds;
    LAS float* kn = qf + 1024;
    LAS float* vn = kn + 128;
    LAS float* S = vn + 128;
    LAS float* KV = (LAS float*)(lds + 16384);
    constexpr int KS_ = 129;
    const GAS bf16_t* prow = (const GAS bf16_t*)(a.ws + WS_PROJ1) + (size_t)(MP + b) * P1C;
    const GAS float* rp = (const GAS float*)(a.ws + WS_ROPE) + (size_t)4096 * 64;
    const GAS float* sk = (const GAS float*)a.in[2] + (size_t)b * 128 * 128 + 128;
    const GAS float* sv = (const GAS float*)a.in[3] + (size_t)b * 128 * 128 + 128;
    GAS float* ok = (GAS float*)a.out + O_KS + (size_t)b * 16384;
    GAS float* ov = (GAS float*)a.out + O_VS + (size_t)b * 16384;
    f32x4 kreg[8], vreg[8];
#pragma unroll
    for (int q = 0; q < 8; ++q) { const int i4 = tid + 512 * q; const bool ok_ = i4 < 127 * 32; const int j4 = ok_ ? i4 : 0;
        kreg[q] = *(const GAS f32x4*)(sk + (size_t)j4 * 4); vreg[q] = *(const GAS f32x4*)(sv + (size_t)j4 * 4); }
    {
        const int h = tid >> 5, i = tid & 31; const float c = rp[2 * i], s = rp[2 * i + 1];
        const float x1 = bf1(prow[h * 64 + i]), x2 = bf1(prow[h * 64 + 32 + i]);
        qf[h * 64 + i] = (x1 * c - x2 * s) * 0.125f; qf[h * 64 + 32 + i] = (x2 * c + x1 * s) * 0.125f;
        if (tid < 64) { const float y1 = bf1(prow[C_K + h * 64 + i]), y2 = bf1(prow[C_K + h * 64 + 32 + i]); kn[h * 64 + i] = y1 * c - y2 * s; kn[h * 64 + 32 + i] = y2 * c + y1 * s; }
        if (tid < 128) vn[tid] = bf1(prow[C_V + tid]);
    }
#pragma unroll
    for (int q = 0; q < 8; ++q) { const int i4 = tid + 512 * q; if (i4 < 127 * 32) { const int i = i4 >> 5, c4 = (i4 & 31) * 4; LAS float* d = KV + i * KS_ + c4;
        d[0] = kreg[q].x; d[1] = kreg[q].y; d[2] = kreg[q].z; d[3] = kreg[q].w; *(GAS f32x4*)(ok + (size_t)i4 * 4) = kreg[q]; *(GAS f32x4*)(ov + (size_t)i4 * 4) = vreg[q]; } }
    __syncthreads();
    if (tid < 128) { KV[127 * KS_ + tid] = kn[tid]; ok[127 * 128 + tid] = kn[tid]; ov[127 * 128 + tid] = vn[tid]; }
    __syncthreads();
#pragma unroll
    for (int cc = 0; cc < 4; ++cc) {
        const int idx = tid + 512 * cc, h = idx >> 7, i = idx & 127, kv = h >> 3;
        float d = 0.f;
#pragma unroll 16
        for (int e = 0; e < 64; ++e) d += KV[i * KS_ + kv * 64 + e] * qf[h * 64 + e];
        S[h * 128 + i] = d;
    }
    __syncthreads();
#pragma unroll
    for (int hh = 0; hh < 2; ++hh) {
        const int h = wid * 2 + hh; const float sink = ((const GAS float*)a.in[13])[h];
        const float s0 = S[h * 128 + lane], s1 = S[h * 128 + 64 + lane];
        const float mx = fmaxf(wave_max(fmaxf(s0, s1)), sink);
        const float p0 = __expf(s0 - mx), p1 = __expf(s1 - mx);
        const float inv = 1.f / (wave_sum(p0 + p1) + __expf(sink - mx));
        S[h * 128 + lane] = p0 * inv; S[h * 128 + 64 + lane] = p1 * inv;
    }
#pragma unroll
    for (int q = 0; q < 8; ++q) { const int i4 = tid + 512 * q; if (i4 < 127 * 32) { const int i = i4 >> 5, c4 = (i4 & 31) * 4; LAS float* d = KV + i * KS_ + c4;
        d[0] = vreg[q].x; d[1] = vreg[q].y; d[2] = vreg[q].z; d[3] = vreg[q].w; } }
    if (tid < 128) KV[127 * KS_ + tid] = vn[tid];
    __syncthreads();
#pragma unroll
    for (int cc = 0; cc < 2; ++cc) {
        const int idx = tid + 512 * cc, h = idx >> 6, d = idx & 63, kv = h >> 3;
        float acc = 0.f;
#pragma unroll 16
        for (int i = 0; i < 128; ++i) acc += S[h * 128 + i] * KV[i * KS_ + kv * 64 + d];
        ((GAS bf16_t*)(a.ws + WS_AB))[(size_t)(MP + b) * DM + h * 64 + d] = (bf16_t)(cvt_pk_bf16(acc, 0.f) & 0xffffu);
    }
    __syncthreads();
}

__device__ __forceinline__ void convb_item(const Args& a, int item, int lane) {
    const int rb = item >> 1, c0 = (item & 1) * 512 + lane * 8, row0 = rb * 8;
    const GAS bf16_t* P1 = (const GAS bf16_t*)(a.ws + WS_PROJ1);
    const GAS float* cw = (const GAS float*)a.in[14] + c0;
    float w0[8], w1[8], w2[8];
    { const f32x4 a0 = *(const GAS f32x4*)cw, a1 = *(const GAS f32x4*)(cw + 4), b0 = *(const GAS f32x4*)(cw + CW), b1 = *(const GAS f32x4*)(cw + CW + 4), c0v = *(const GAS f32x4*)(cw + 2 * CW), c1v = *(const GAS f32x4*)(cw + 2 * CW + 4);
#pragma unroll
      for (int e = 0; e < 4; ++e) { w0[e] = a0[e]; w0[e + 4] = a1[e]; w1[e] = b0[e]; w1[e + 4] = b1[e]; w2[e] = c0v[e]; w2[e + 4] = c1v[e]; } }
    float p2[8], p1[8];
    const bool prompt = row0 < MP;
    const bool halo = prompt && (row0 & (SEQ - 1)) != 0;
    const int hr = halo ? row0 - 2 : row0;
    const u32x4 hx0 = *(const GAS u32x4*)(P1 + (size_t)hr * P1C + C_CC + c0), hy0 = *(const GAS u32x4*)(P1 + (size_t)hr * P1C + C_CU + c0);
    const u32x4 hx1 = *(const GAS u32x4*)(P1 + (size_t)(hr + 1) * P1C + C_CC + c0), hy1 = *(const GAS u32x4*)(P1 + (size_t)(hr + 1) * P1C + C_CU + c0);
    u32x4 vb[8], vc[8], vu[8];
#pragma unroll
    for (int r = 0; r < 8; ++r) { const GAS bf16_t* pr = P1 + (size_t)(row0 + r) * P1C + c0; vb[r] = NTL((const GAS u32x4*)(pr + C_CB)); vc[r] = NTL((const GAS u32x4*)(pr + C_CC)); vu[r] = NTL((const GAS u32x4*)(pr + C_CU)); }
    { float x[8], y[8]; unpack8(hx0, x); unpack8(hy0, y);
#pragma unroll
      for (int e = 0; e < 8; ++e) p2[e] = halo ? x[e] * y[e] : 0.f;
      unpack8(hx1, x); unpack8(hy1, y);
#pragma unroll
      for (int e = 0; e < 8; ++e) p1[e] = halo ? x[e] * y[e] : 0.f; }
#pragma unroll
    for (int r = 0; r < 8; ++r) {
        const int row = row0 + r;
        if (!prompt) {
            const GAS float* st = (const GAS float*)a.in[4] + (size_t)(row - MP) * 2 * CW + c0;
            const f32x4 s0 = *(const GAS f32x4*)st, s1 = *(const GAS f32x4*)(st + 4), s2 = *(const GAS f32x4*)(st + CW), s3 = *(const GAS f32x4*)(st + CW + 4);
#pragma unroll
            for (int e = 0; e < 4; ++e) { p2[e] = s0[e]; p2[e + 4] = s1[e]; p1[e] = s2[e]; p1[e + 4] = s3[e]; }
        }
        float cb[8], x[8], y[8], cx[8], ov[8];
        unpack8(vb[r], cb); unpack8(vc[r], x); unpack8(vu[r], y);
#pragma unroll
        for (int e = 0; e < 8; ++e) { cx[e] = x[e] * y[e]; ov[e] = cb[e] * (w0[e] * p2[e] + w1[e] * p1[e] + w2[e] * cx[e]); }
        *(GAS u32x4*)((GAS bf16_t*)(a.ws + WS_AB) + (size_t)row * DM + 1024 + c0) = pack8a(ov);
        GAS float* so = nullptr;
        if (prompt) { const int t = row & (SEQ - 1); if (t >= SEQ - 2) so = (GAS float*)a.out + O_CP + (size_t)((row >> 12) * 2 + (t - (SEQ - 2))) * CW + c0; }
        else so = (GAS float*)a.out + O_CS + (size_t)((row - MP) * 2 + 1) * CW + c0;
        if (so) { *(GAS f32x4*)so = (f32x4){cx[0], cx[1], cx[2], cx[3]}; *(GAS f32x4*)(so + 4) = (f32x4){cx[4], cx[5], cx[6], cx[7]}; }
#pragma unroll
        for (int e = 0; e < 8; ++e) { p2[e] = p1[e]; p1[e] = cx[e]; }
    }
}

template <bool FIRST>
__device__ __forceinline__ void resnorm_rows(const Args& a, int gw, int NGW, int lane) {
    f32x4 g1[8], g2[8];
    { const GAS f32x4* p1 = (const GAS f32x4*)a.in[FIRST ? 9 : 11] + lane; const GAS f32x4* p2 = (const GAS f32x4*)a.in[10] + lane;
#pragma unroll
      for (int j = 0; j < 8; ++j) { g1[j] = p1[64 * j]; g2[j] = FIRST ? p2[64 * j] : (f32x4){0.f, 0.f, 0.f, 0.f}; } }
    int m = gw; if (m >= MT) return;
    const GAS bf16_t* SRC = (const GAS bf16_t*)(a.ws + (FIRST ? WS_MO : WS_F));
    const GAS bf16_t* X1B = (const GAS bf16_t*)(a.ws + WS_X1B);
    f32x4 v[8], x[8];
    { const GAS u32x2* sr = (const GAS u32x2*)(SRC + (size_t)m * DM) + lane;
#pragma unroll
      for (int j = 0; j < 8; ++j) { const u32x2 w = NTL(sr + 64 * j); v[j] = (f32x4){bflo(w.x), bfhi(w.x), bflo(w.y), bfhi(w.y)}; }
      if (FIRST) { const GAS f32x4* xr = (const GAS f32x4*)x_row(a, m) + lane;
#pragma unroll
        for (int j = 0; j < 8; ++j) x[j] = NTL(xr + 64 * j); }
      else { const GAS u32x2* xr = (const GAS u32x2*)(X1B + (size_t)m * DM) + lane;
#pragma unroll
        for (int j = 0; j < 8; ++j) { const u32x2 w = NTL(xr + 64 * j); x[j] = (f32x4){bflo(w.x), bfhi(w.x), bflo(w.y), bfhi(w.y)}; } } }
    for (;;) {
        const int mn = m + NGW; const bool has = mn < MT; const int mp = has ? mn : m;
        u32x2 nw[8]; f32x4 nx[8]; u32x2 nxb[8];
        { const GAS u32x2* sr = (const GAS u32x2*)(SRC + (size_t)mp * DM) + lane;
#pragma unroll
          for (int j = 0; j < 8; ++j) nw[j] = NTL(sr + 64 * j);
          if (FIRST) { const GAS f32x4* xr = (const GAS f32x4*)x_row(a, mp) + lane;
#pragma unroll
            for (int j = 0; j < 8; ++j) nx[j] = NTL(xr + 64 * j); }
          else { const GAS u32x2* xr = (const GAS u32x2*)(X1B + (size_t)mp * DM) + lane;
#pragma unroll
            for (int j = 0; j < 8; ++j) nxb[j] = NTL(xr + 64 * j); } }
        float s = 0.f;
#pragma unroll
        for (int j = 0; j < 8; ++j) s += (v[j].x * v[j].x + v[j].y * v[j].y) + (v[j].z * v[j].z + v[j].w * v[j].w);
        const float rstd = 1.f / sqrtf(wave_sum(s) * (1.f / DM) + EPS);
        float s2 = 0.f;
        GAS u32x2* xo = (GAS u32x2*)((GAS bf16_t*)(a.ws + (FIRST ? WS_X1B : WS_H)) + (size_t)m * DM) + lane;
#pragma unroll
        for (int j = 0; j < 8; ++j) { v[j] = x[j] + v[j] * rstd * g1[j]; u32x2 w; w.x = cvt_pk_bf16(v[j].x, v[j].y); w.y = cvt_pk_bf16(v[j].z, v[j].w); xo[64 * j] = w;
            s2 += (v[j].x * v[j].x + v[j].y * v[j].y) + (v[j].z * v[j].z + v[j].w * v[j].w); }
        if (FIRST) {
            GAS u32x2* ho = (GAS u32x2*)((GAS bf16_t*)(a.ws + WS_H) + (size_t)m * DM) + lane;
            const float rstd2 = 1.f / sqrtf(wave_sum(s2) * (1.f / DM) + EPS);
#pragma unroll
            for (int j = 0; j < 8; ++j) { u32x2 w; w.x = cvt_pk_bf16(v[j].x * rstd2 * g2[j].x, v[j].y * rstd2 * g2[j].y); w.y = cvt_pk_bf16(v[j].z * rstd2 * g2[j].z, v[j].w * rstd2 * g2[j].w); ho[64 * j] = w; }
        }
        if (!has) break;
#pragma unroll
        for (int j = 0; j < 8; ++j) { v[j] = (f32x4){bflo(nw[j].x), bfhi(nw[j].x), bflo(nw[j].y), bfhi(nw[j].y)};
            x[j] = FIRST ? nx[j] : (f32x4){bflo(nxb[j].x), bfhi(nxb[j].x), bflo(nxb[j].y), bfhi(nxb[j].y)}; }
        m = mn;
    }
}

__device__ __forceinline__ void ffnfix_item(const Args& a, int item, int lane) {
    const int c0 = (item % 11) * 512 + lane * 8, q = item / 11;
    const GAS float* cw = (const GAS float*)a.in[20] + c0;
    const GAS float* cbp = (const GAS float*)a.in[21] + c0;
    float w0[8], w1[8], w2[8], bb[8];
    { const f32x4 a0 = *(const GAS f32x4*)cw, a1 = *(const GAS f32x4*)(cw + 4), b0 = *(const GAS f32x4*)(cw + DFF), b1 = *(const GAS f32x4*)(cw + DFF + 4), c0v = *(const GAS f32x4*)(cw + 2 * DFF), c1v = *(const GAS f32x4*)(cw + 2 * DFF + 4),
                  d0 = *(const GAS f32x4*)cbp, d1 = *(const GAS f32x4*)(cbp + 4);
#pragma unroll
      for (int e = 0; e < 4; ++e) { w0[e] = a0[e]; w0[e + 4] = a1[e]; w1[e] = b0[e]; w1[e + 4] = b1[e]; w2[e] = c0v[e]; w2[e + 4] = c1v[e]; bb[e] = d0[e]; bb[e + 4] = d1[e]; } }
    GAS bf16_t* FIN = (GAS bf16_t*)(a.ws + WS_FIN);
    float p2[8], p1[8], x0[8], x1[8], g0[8], g1[8], ov[8];
    if (q < 128) {
        const GAS bf16_t* SA = (const GAS bf16_t*)(a.ws + WS_SA); const GAS bf16_t* SG = (const GAS bf16_t*)(a.ws + WS_SG);
        const int r0 = q * 64; const bool halo = (r0 & (SEQ - 1)) != 0; const int qp = halo ? q - 1 : q;
        const u32x4 h0 = *(const GAS u32x4*)(SA + ((size_t)qp * 4 + 0) * DFF + c0), h1 = *(const GAS u32x4*)(SA + ((size_t)qp * 4 + 1) * DFF + c0);
        const u32x4 a0 = *(const GAS u32x4*)(SA + ((size_t)q * 4 + 2) * DFF + c0), a1 = *(const GAS u32x4*)(SA + ((size_t)q * 4 + 3) * DFF + c0);
        const u32x4 gg0 = *(const GAS u32x4*)(SG + ((size_t)q * 2 + 0) * DFF + c0), gg1 = *(const GAS u32x4*)(SG + ((size_t)q * 2 + 1) * DFF + c0);
        unpack8(h0, p2); unpack8(h1, p1); unpack8(a0, x0); unpack8(a1, x1); unpack8(gg0, g0); unpack8(gg1, g1);
#pragma unroll
        for (int e = 0; e < 8; ++e) { p2[e] = halo ? p2[e] : 0.f; p1[e] = halo ? p1[e] : 0.f; }
#pragma unroll
        for (int e = 0; e < 8; ++e) ov[e] = gelu_tanh(w0[e] * p2[e] + w1[e] * p1[e] + w2[e] * x0[e] + bb[e]) * g0[e];
        *(GAS u32x4*)(FIN + (size_t)r0 * DFF + c0) = pack8a(ov);
#pragma unroll
        for (int e = 0; e < 8; ++e) ov[e] = gelu_tanh(w0[e] * p1[e] + w1[e] * x0[e] + w2[e] * x1[e] + bb[e]) * g1[e];
        *(GAS u32x4*)(FIN + (size_t)(r0 + 1) * DFF + c0) = pack8a(ov);
    } else {
        const int b = q - 128;
        const GAS float* st = (const GAS float*)a.in[5] + (size_t)b * 2 * DFF + c0;
        const f32x4 s0 = *(const GAS f32x4*)st, s1 = *(const GAS f32x4*)(st + 4), s2 = *(const GAS f32x4*)(st + DFF), s3 = *(const GAS f32x4*)(st + DFF + 4);
        const u32x4 a0 = *(const GAS u32x4*)((const GAS bf16_t*)(a.ws + WS_UAS) + (size_t)b * DFF + c0), gg0 = *(const GAS u32x4*)((const GAS bf16_t*)(a.ws + WS_UGS) + (size_t)b * DFF + c0);
        unpack8(a0, x0); unpack8(gg0, g0);
#pragma unroll
        for (int e = 0; e < 4; ++e) { p2[e] = s0[e]; p2[e + 4] = s1[e]; p1[e] = s2[e]; p1[e + 4] = s3[e]; }
#pragma unroll
        for (int e = 0; e < 8; ++e) ov[e] = gelu_tanh(w0[e] * p2[e] + w1[e] * p1[e] + w2[e] * x0[e] + bb[e]) * g0[e];
        *(GAS u32x4*)(FIN + (size_t)(MP + b) * DFF + c0) = pack8a(ov);
    }
}

#define XB_TMO      128
#define XB_XCNT(j)  (256  + 64 * (j))
#define XB_XSUB(j)  (1280 + 64 * (j))
#define XB_XGEN(j)  (2304 + 64 * (j))
#define XB_TOP      3328
#define XB_TOPGEN   3392
#define XCD_BAR_WORDS 3456
#define XB_SPIN_CAP (1u << 18)
__device__ __forceinline__ unsigned xb_ld(unsigned* p)              { return __hip_atomic_load(p, __ATOMIC_RELAXED, __HIP_MEMORY_SCOPE_AGENT); }
__device__ __forceinline__ unsigned xb_add(unsigned* p, unsigned v) { return __hip_atomic_fetch_add(p, v, __ATOMIC_RELAXED, __HIP_MEMORY_SCOPE_AGENT); }
__device__ __forceinline__ unsigned xb_xcc_id() { return (unsigned)__builtin_amdgcn_s_getreg((3 << 11) | 20) & 0xFu; }
#define XB_SPIN(cond, bar) do { unsigned _sp = 0; while (cond) { __builtin_amdgcn_s_sleep(1); \
    if ((++_sp & 255u) == 0u) { if (xb_ld(&(bar)[XB_TMO])) break; if (_sp > XB_SPIN_CAP) { atomicAdd(&(bar)[XB_TMO], 1u); break; } } } } while (0)
__device__ __forceinline__ void xcd_barrier_complete(unsigned* bar, unsigned x, unsigned G, unsigned& nloc, unsigned& nx) {
    unsigned sum, cnt, mine, sp = 0u;
    for (;;) {
        sum = 0u; cnt = 0u; mine = 0u;
#pragma unroll
        for (unsigned j = 0; j < 16; ++j) { const unsigned c = xb_ld(&bar[XB_XCNT(j)]); sum += c; cnt += (c > 0u) ? 1u : 0u; mine = (j == x) ? c : mine; }
        if (sum == G) break;
        __builtin_amdgcn_s_sleep(1);
        if ((++sp & 255u) == 0u) { if (xb_ld(&bar[XB_TMO])) break; if (sp > XB_SPIN_CAP) { atomicAdd(&bar[XB_TMO], 1u); break; } }
    }
    nloc = mine > 0u ? mine : 1u; nx = cnt > 0u ? cnt : 1u;
}
__device__ __forceinline__ void grid_barrier(unsigned* bar, volatile LAS unsigned* st, unsigned G, int wid_in) {
    asm volatile("s_waitcnt vmcnt(0)" ::: "memory");
    __syncthreads();
    if (wid_in == 0 && fresh_lane() == 0) {
        __builtin_amdgcn_s_waitcnt(0);
        const unsigned x = xb_xcc_id();
        unsigned nloc = st[0], nx = st[1];
        if (nloc == 0u) { xcd_barrier_complete(bar, x, G, nloc, nx); st[0] = nloc; st[1] = nx; }
        const unsigned old = xb_add(&bar[XB_XSUB(x)], 1u);
        const unsigned gen = old / nloc;
        if (old + 1u == (gen + 1u) * nloc) {
            __builtin_amdgcn_fence(__ATOMIC_RELEASE, "agent");
            asm volatile("s_waitcnt vmcnt(0)" ::: "memory");
            const unsigned og = xb_add(&bar[XB_TOP], 1u);
            const unsigned tg = og / nx;
            if (og + 1u == (tg + 1u) * nx) xb_add(&bar[XB_TOPGEN], 1u);
            else XB_SPIN(xb_ld(&bar[XB_TOPGEN]) == tg, bar);
            __builtin_amdgcn_fence(__ATOMIC_ACQUIRE, "agent");
            xb_add(&bar[XB_XGEN(x)], 1u);
            asm volatile("s_waitcnt vmcnt(0)" ::: "memory");
        } else {
            XB_SPIN(xb_ld(&bar[XB_XGEN(x)]) == gen, bar);
            __builtin_amdgcn_fence(__ATOMIC_ACQUIRE, "agent");
            asm volatile("s_waitcnt vmcnt(0)" ::: "memory");
        }
    }
    __syncthreads();
}

template <int MODE, int N, int K>
__device__ __forceinline__ void gemm_job(LAS unsigned char* lds, const Args& a, size_t offA, size_t offB, int G, int bid, int wid) {
    const bf16_t* A = (const bf16_t*)(a.ws + offA); const bf16_t* Bt = (const bf16_t*)(a.ws + offB);
    pg8::gemm_phase<MODE, N, K>(lds, a, A, Bt, G, bid, wid);
    skinny_gemm<MODE, N, K>(lds, a, A + (size_t)MP * K, Bt, G, bid, wid);
}

__global__ void __launch_bounds__(512, 2) hybrid_fwd(Args a) {
    __shared__ __attribute__((aligned(16))) unsigned char lds_raw[LDS_BYTES];
    LAS unsigned char* lds = (LAS unsigned char*)lds_raw;
    const int wid = __builtin_amdgcn_readfirstlane((int)threadIdx.x >> 6);
    const int G = gridDim.x, bid = blockIdx.x, gw = bid * 8 + wid, NGW = G * 8;
    const int lo = a.ph_lo, hi = a.ph_hi;
    if (lo > 1000) { __threadfence(); cg::this_grid().sync(); }
    if (hi - lo > 1) {
        if (wid == 0) { const int l = fresh_lane(); if (l < 2) ((volatile LAS unsigned*)(lds + 131072))[l] = 0u; if (l == 0) (void)xb_add((unsigned*)a.ws + XB_XCNT(xb_xcc_id()), 1u); }
        __syncthreads();
    }
#define IN(k) (lo <= (k) && (k) < hi)
#define SEAM(k) do { if (IN(k) && IN((k) + 1)) grid_barrier((unsigned*)a.ws, (volatile LAS unsigned*)(lds + 131072), (unsigned)G, wid); } while (0)
#ifdef PROBE_PHASE
    if (IN(100)) {
        const int gtid = bid * 512 + wid * 64 + fresh_lane(), GT = G * 512;
        const GAS bf16_t* b16 = (const GAS bf16_t*)(a.ws + 4 * MiB); const size_t n = (size_t)(341 * MiB / 2), NOUT = 16842752;
        for (size_t i = gtid; i < NOUT; i += GT) { float acc = 0.f; for (size_t k = i; k < n; k += NOUT) acc += bf1(b16[k]); ((GAS float*)a.out)[i] = acc; }
    }
#endif
    if (IN(0)) p0_prologue(a, lds, bid, G, wid);
    SEAM(0);
    if (IN(1)) {
        gemm_job<1, INC, 2048>(lds, a, WS_H, WS_WIN, G, bid, wid);
        constexpr int NFULL = (MP / 256) * (INC / 256) % 256;
        const int first = (G == 256) ? NFULL : 0;
        if (bid >= first) late_weights<1>(a, lds, (bid - first) * 8 + wid, (G - first) * 8, wid);
    }
    SEAM(1);
    if (IN(2)) {
#ifndef SKIP_PA
        for (int u = bid; u < 256; u += G) attn_prompt_unit(a, lds, u, wid);
#endif
        if (bid >= G - MS) attn_sample_unit(a, lds, G - 1 - bid, wid);
        for (int it = gw; it < (MT / 8) * 2; it += NGW) convb_item(a, it, fresh_lane());
    }
    SEAM(2);
    if (IN(3)) gemm_job<3, 2048, 2048>(lds, a, WS_AB, WS_WM, G, bid, wid);
    SEAM(3);
    if (IN(4)) gemm_job<4, 2048, 2048>(lds, a, WS_MERGED, WS_WO, G, bid, wid);
    SEAM(4);
    if (IN(5)) resnorm_rows<true>(a, gw, NGW, fresh_lane());
    SEAM(5);
    if (IN(6)) {
        gemm_job<6, 2 * DFF, 2048>(lds, a, WS_H, WS_WUP, G, bid, wid);
        constexpr int NFULL = (MP / 256) * (2 * DFF / 256) % 256;
        const int first = (G == 256) ? NFULL : 0;
        if (bid >= first) {
            late_weights<2>(a, lds, (bid - first) * 8 + wid, (G - first) * 8, wid);
            __syncthreads();
            gemm_job<9, 2048, PLE>(lds, a, WS_PB, WS_WP, G - first, bid - first, wid);
        }
    }
    SEAM(6);
    if (IN(7)) { for (int it = gw; it < (128 + MS) * 11; it += NGW) ffnfix_item(a, it, fresh_lane()); }
    SEAM(7);
    if (IN(8)) gemm_job<8, 2048, DFF>(lds, a, WS_FIN, WS_WDN, G, bid, wid);
    SEAM(8);
    if (IN(9)) resnorm_rows<false>(a, gw, NGW, fresh_lane());
    SEAM(9);
    if (IN(10)) gemm_job<10, 2048, 2048>(lds, a, WS_H, WS_WG, G, bid, wid);
#undef IN
#undef SEAM
}

extern "C" void kernel_launch(void* const* d_in, const int* in_sizes, int n_in, void* d_out, int out_size, void* d_ws, size_t ws_size, hipStream_t stream) {
    static int grid = 0;
    if (grid == 0) {
        if (n_in != 25 || ws_size < WS_END) { fprintf(stderr, "kernel_launch: unexpected n_in %d / ws_size %zu\n", n_in, ws_size); grid = -1; return; }
        int dev = 0, cus = 0, per_cu = 0;
        if (hipGetDevice(&dev) != hipSuccess || hipDeviceGetAttribute(&cus, hipDeviceAttributeMultiprocessorCount, dev) != hipSuccess) { grid = -1; return; }
        if (hipOccupancyMaxActiveBlocksPerMultiprocessor(&per_cu, (const void*)hybrid_fwd, 512, 0) != hipSuccess || per_cu < 1) { fprintf(stderr, "kernel_launch: occupancy query says %d\n", per_cu); per_cu = 1; }
        (void)hipGetLastError();
        grid = cus;
    }
    if (grid < 0) return;
    if (hipMemsetAsync(d_ws, 0, 16384, stream) != hipSuccess) { fprintf(stderr, "kernel_launch: memset failed\n"); return; }
    Args a{};
    for (int i = 0; i < 25; ++i) a.in[i] = (const float*)d_in[i];
    a.out = (float*)d_out; a.ws = (unsigned char*)d_ws;
#if MK_N_LAUNCHES == 1
    a.ph_lo = 0; a.ph_hi = NPHASE;
    void* kargs[] = {&a};
    hipError_t e = hipLaunchCooperativeKernel((const void*)hybrid_fwd, dim3(grid), dim3(512), kargs, 0, stream);
    if (e != hipSuccess) fprintf(stderr, "cooperative launch failed: %s (grid %d)\n", hipGetErrorString(e), grid);
#else
#ifdef PROBE_PHASE
    for (int ph = 0; ph <= PROBE_PHASE; ++ph) { a.ph_lo = ph; a.ph_hi = ph + 1; hipLaunchKernelGGL(hybrid_fwd, dim3(grid), dim3(512), 0, stream, a); }
    a.ph_lo = 100; a.ph_hi = 101; hipLaunchKernelGGL(hybrid_fwd, dim3(grid), dim3(512), 0, stream, a);
#else
    for (int ph = 0; ph < NPHASE; ++ph) {
        a.ph_lo = ph; a.ph_hi = ph + 1;
        for (int rep = 0; rep < 1 + ((REPMASK >> ph) & 1); ++rep)
            hipLaunchKernelGGL(hybrid_fwd, dim3(grid), dim3(512), 0, stream, a);
    }
#endif
#endif
}
```

```cpp
#include <hip/hip_runtime.h>
#include <hip/hip_cooperative_groups.h>
#include <cstdio>
#include <cstdint>
namespace cg = cooperative_groups;


#ifndef MK_N_LAUNCHES
#define MK_N_LAUNCHES 1
#define REPMASK 0x00
#endif

#define LAS __attribute__((address_space(3)))
#define GAS __attribute__((address_space(1)))
typedef unsigned short bf16_t;
typedef short bf16x8 __attribute__((ext_vector_type(8)));
typedef float f32x4 __attribute__((ext_vector_type(4)));
typedef float f32x16 __attribute__((ext_vector_type(16)));
typedef unsigned u32x4 __attribute__((ext_vector_type(4)));
typedef unsigned u32x2 __attribute__((ext_vector_type(2)));

constexpr int DM = 2048, SEQ = 4096, MP = 8192, MS = 32, MT = MP + MS;
constexpr int DFF = 5632, INC = 8448, CW = 1024, PLE = 256;
constexpr int P1C = 4352;
constexpr int C_K = 1024, C_V = 1152, C_CB = 1280, C_CC = 2304, C_CU = 3328;
constexpr float EPS = 1e-6f;
constexpr size_t O_YP = 0, O_YS = 16777216, O_KP = 16842752, O_VP = 16875520, O_CP = 16908288, O_FP = 16912384,
                 O_KS = 16934912, O_VS = 17459200, O_CS = 17983488, O_FS = 18049024;
constexpr size_t MiB = 1u << 20;
constexpr size_t WS_ROPE = 1 * MiB;
constexpr size_t WS_WIN = 4 * MiB, WS_WM = 37 * MiB, WS_WO = 45 * MiB, WS_WUP = 53 * MiB, WS_WDN = 97 * MiB, WS_WG = 119 * MiB, WS_WP = 127 * MiB;
constexpr size_t WS_H = 128 * MiB;
constexpr size_t WS_R = 161 * MiB;
constexpr size_t WS_PROJ1 = WS_R, WS_PROJ2 = 230 * MiB, WS_AB = 295 * MiB;
constexpr size_t WS_MERGED = WS_R, WS_MO = 230 * MiB;
constexpr size_t WS_SA = 4 * MiB;
constexpr size_t WS_SG = 10 * MiB;
constexpr size_t WS_UAS = 13 * MiB, WS_UGS = 13 * MiB + 512 * 1024;
constexpr size_t WS_PP = 16 * MiB;
constexpr size_t WS_FIN = WS_R;
constexpr size_t WS_F = 250 * MiB;
constexpr size_t WS_X1B = 295 * MiB;
constexpr size_t WS_PB = 340 * MiB;
constexpr size_t WS_END = 345 * MiB;
constexpr int LDS_BYTES = 147456;
constexpr int NPHASE = 11;

struct Args { const float* in[25]; float* out; unsigned char* ws; int ph_lo, ph_hi; };

__device__ __forceinline__ unsigned cvt_pk_bf16(float lo, float hi) { unsigned r; asm("v_cvt_pk_bf16_f32 %0, %1, %2" : "=v"(r) : "v"(lo), "v"(hi)); return r; }
__device__ __forceinline__ float bflo(unsigned w) { return __uint_as_float(w << 16); }
__device__ __forceinline__ float bfhi(unsigned w) { return __uint_as_float(w & 0xffff0000u); }
__device__ __forceinline__ float bf1(bf16_t b) { return __uint_as_float(((unsigned)b) << 16); }
__device__ __forceinline__ void unpack8(u32x4 w, float* f) { f[0] = bflo(w.x); f[1] = bfhi(w.x); f[2] = bflo(w.y); f[3] = bfhi(w.y); f[4] = bflo(w.z); f[5] = bfhi(w.z); f[6] = bflo(w.w); f[7] = bfhi(w.w); }
__device__ __forceinline__ u32x4 pack8(f32x4 lo, f32x4 hi) { u32x4 w; w.x = cvt_pk_bf16(lo[0], lo[1]); w.y = cvt_pk_bf16(lo[2], lo[3]); w.z = cvt_pk_bf16(hi[0], hi[1]); w.w = cvt_pk_bf16(hi[2], hi[3]); return w; }
__device__ __forceinline__ u32x4 pack8a(const float* f) { u32x4 w; w.x = cvt_pk_bf16(f[0], f[1]); w.y = cvt_pk_bf16(f[2], f[3]); w.z = cvt_pk_bf16(f[4], f[5]); w.w = cvt_pk_bf16(f[6], f[7]); return w; }
__device__ __forceinline__ int fresh_lane() { int l; asm volatile("v_mbcnt_lo_u32_b32 %0, -1, 0\n\tv_mbcnt_hi_u32_b32 %0, -1, %0" : "=v"(l)); return l; }
#define NTL(p) __builtin_nontemporal_load(p)
__device__ __forceinline__ float wave_sum(float v) {
#pragma unroll
    for (int o = 1; o < 64; o <<= 1) v += __shfl_xor(v, o);
    return v;
}
__device__ __forceinline__ float wave_max(float v) {
#pragma unroll
    for (int o = 1; o < 64; o <<= 1) v = fmaxf(v, __shfl_xor(v, o));
    return v;
}
__device__ __forceinline__ float rcpf_(float x) { return __builtin_amdgcn_rcpf(x); }
__device__ __forceinline__ float sigm(float x) { return rcpf_(1.f + __expf(-x)); }
__device__ __forceinline__ float gelu_tanh(float x) { const float u = 0.7978845608028654f * (x + 0.044715f * x * x * x); return x * rcpf_(1.f + __expf(-2.f * u)); }
__device__ __forceinline__ const GAS float* x_row(const Args& a, int row) {
    return row < MP ? (const GAS float*)a.in[0] + (size_t)row * DM : (const GAS float*)a.in[1] + (size_t)(row - MP) * DM;
}

__device__ __forceinline__ void load_gates(const Args& a, int row, int col0, float* ea, float* eb) {
    const GAS bf16_t* p2 = (const GAS bf16_t*)(a.ws + WS_PROJ2) + (size_t)row * 4096 + col0;
    const u32x4 wa = *(const GAS u32x4*)p2, wb = *(const GAS u32x4*)(p2 + 2048);
    const GAS float* bg = (const GAS float*)a.in[17] + col0;
    const f32x4 b0l = *(const GAS f32x4*)bg, b0h = *(const GAS f32x4*)(bg + 4), b1l = *(const GAS f32x4*)(bg + 2048), b1h = *(const GAS f32x4*)(bg + 2052);
    float ga[8], gb[8]; unpack8(wa, ga); unpack8(wb, gb);
#pragma unroll
    for (int e = 0; e < 4; ++e) {
        ea[e] = fminf(__expf(-(ga[e] + b0l[e])), 1e30f); ea[e + 4] = fminf(__expf(-(ga[e + 4] + b0h[e])), 1e30f);
        eb[e] = fminf(__expf(-(gb[e] + b1l[e])), 1e30f); eb[e + 4] = fminf(__expf(-(gb[e + 4] + b1h[e])), 1e30f);
    }
}

template <int MODE>
__device__ __forceinline__ void epi8(const Args& a, int row, int col0, f32x4 lo, f32x4 hi) {
    unsigned char* ws = a.ws;
    if constexpr (MODE == 1) {
        GAS bf16_t* p = col0 < P1C ? (GAS bf16_t*)(ws + WS_PROJ1) + (size_t)row * P1C + col0 : (GAS bf16_t*)(ws + WS_PROJ2) + (size_t)row * 4096 + (col0 - P1C);
        *(GAS u32x4*)p = pack8(lo, hi);
    } else if constexpr (MODE == 3) {
        float ea[8], eb[8]; load_gates(a, row, col0, ea, eb);
#pragma unroll
        for (int e = 0; e < 4; ++e) { lo[e] = lo[e] * rcpf_(1.f + eb[e]); hi[e] = hi[e] * rcpf_(1.f + eb[e + 4]); }
        *(GAS u32x4*)((GAS bf16_t*)(ws + WS_MERGED) + (size_t)row * DM + col0) = pack8(lo, hi);
    } else if constexpr (MODE == 30) {
        *(GAS u32x4*)((GAS bf16_t*)(ws + WS_MERGED) + (size_t)row * DM + col0) = pack8(lo, hi);
    } else if constexpr (MODE == 4) {
        *(GAS u32x4*)((GAS bf16_t*)(ws + WS_MO) + (size_t)row * DM + col0) = pack8(lo, hi);
    } else if constexpr (MODE == 6) {
        const int ch = (col0 >> 8) * 128 + (col0 & 127);
        if (((col0 >> 7) & 1) == 0) {
            *(GAS u32x4*)((GAS bf16_t*)(ws + WS_UAS) + (size_t)(row - MP) * DFF + ch) = pack8(lo, hi);
            GAS float* o = (GAS float*)a.out + O_FS + (size_t)((row - MP) * 2 + 1) * DFF + ch; *(GAS f32x4*)o = lo; *(GAS f32x4*)(o + 4) = hi;
        } else {
            *(GAS u32x4*)((GAS bf16_t*)(ws + WS_UGS) + (size_t)(row - MP) * DFF + ch) = pack8(lo, hi);
        }
    } else if constexpr (MODE == 8) {
        *(GAS u32x4*)((GAS bf16_t*)(ws + WS_F) + (size_t)row * DM + col0) = pack8(lo, hi);
    } else if constexpr (MODE == 9) {
        *(GAS u32x4*)((GAS bf16_t*)(ws + WS_PP) + (size_t)row * DM + col0) = pack8(lo, hi);
    } else if constexpr (MODE == 10) {
        GAS float* o = (GAS float*)a.out + (size_t)row * DM + col0;
        const u32x4 xw = *(const GAS u32x4*)((const GAS bf16_t*)(ws + WS_H) + (size_t)row * DM + col0);
        const u32x4 pw = NTL((const GAS u32x4*)((const GAS bf16_t*)(ws + WS_PP) + (size_t)row * DM + col0));
        float pp[8], xx[8]; unpack8(pw, pp); unpack8(xw, xx); f32x4 y0, y1;
#pragma unroll
        for (int e = 0; e < 4; ++e) { y0[e] = xx[e] + sigm(lo[e]) * pp[e]; y1[e] = xx[e + 4] + sigm(hi[e]) * pp[e + 4]; }
        *(GAS f32x4*)o = y0; *(GAS f32x4*)(o + 4) = y1;
    }
}

__device__ __forceinline__ void glds_s(const char* sbase, unsigned voff, unsigned lds_dst) {
    unsigned keep;
    asm volatile("s_mov_b32 %0, m0\n\ts_mov_b32 m0, %3\n\ts_nop 0\n\tglobal_load_lds_dwordx4 %1, %2\n\ts_mov_b32 m0, %0" : "=&s"(keep) : "v"(voff), "s"(sbase), "s"(lds_dst) : "memory");
}
namespace pg8 {
constexpr int BM = 256, BK = 64, HALF = 128, HTB = HALF * BK * 2, STAGE_BYTES = 8 * HTB, NXCD = 8, WGM = 8;
__host__ __device__ __forceinline__ int lds_byte(int r, int c) { const int st = (r >> 4) * 2 + (c >> 5), rr = r & 15, cc = c & 31, ob = rr * 64 + cc * 2; return st * 1024 + (ob ^ (((ob >> 9) & 1) << 5)); }
__host__ __device__ __forceinline__ void stage_rc(int b, int& R, int& C) { const int st = b / 1024, sb = b % 1024, swz = sb ^ (((sb >> 9) & 1) << 5); R = (st >> 1) * 16 + swz / 64; C = (st & 1) * 32 + (swz % 64) / 2; }
__host__ __device__ __forceinline__ int perm32(int rho) { const int n = rho >> 4, i = rho & 15; return 8 * (i >> 2) + 4 * n + (i & 3); }
struct Unit { int pm, pn; };
struct StaticOrder {
    int nM, nN, nwg, G, c;
    __device__ void init(int M, int N, int G_, int c_) { nM = M / BM; nN = N / BM; nwg = nM * nN; G = G_; c = c_; }
    __device__ bool next(int i, Unit& u) const {
        const long L = (long)i * G + c; if (L >= nwg) return false;
        int wgid = (int)L; { const int q = nwg / NXCD, r = nwg % NXCD, xcd = wgid % NXCD, off = wgid / NXCD; wgid = (xcd < r ? xcd * (q + 1) : r * (q + 1) + (xcd - r) * q) + off; }
        const int nig = WGM * nN, gid = wgid / nig, fm = gid * WGM, gsz = (nM - fm) < WGM ? (nM - fm) : WGM;
        u.pm = fm + ((wgid % nig) % gsz); u.pn = (wgid % nig) / gsz; return true;
    }
};

template <int MODE>
__device__ __forceinline__ void tile_epi(const Args& a, const f32x4 (&acc)[2][2][4][2], const Unit& u, int wr, int wc, int fr, int fq) {
#pragma unroll
    for (int ai = 0; ai < 2; ++ai)
#pragma unroll
        for (int m = 0; m < 4; ++m)
#pragma unroll
            for (int bj = 0; bj < 2; ++bj)
                epi8<MODE>(a, u.pm * BM + ai * HALF + wr * 64 + m * 16 + fr, u.pn * BM + bj * HALF + wc * 32 + 8 * fq, acc[ai][bj][m][0], acc[ai][bj][m][1]);
}
template <int CTRL> __device__ __forceinline__ float dppf(float old, float src) {
    return __int_as_float(__builtin_amdgcn_update_dpp(__float_as_int(old), __float_as_int(src), CTRL, 0xf, 0xf, false));
}
__device__ __forceinline__ void tile_epi6(const Args& a, const f32x4 (&acc)[2][2][4][2], const Unit& u, int wr, int wc, int fr, int fq) {
    const int ch0 = u.pn * 128 + wc * 32 + 8 * fq;
    const GAS float* cw = (const GAS float*)a.in[20] + ch0; const GAS float* cbp = (const GAS float*)a.in[21] + ch0;
    float w0[8], w1[8], w2[8], bb[8];
    { const f32x4 a0 = *(const GAS f32x4*)cw, a1 = *(const GAS f32x4*)(cw + 4), b0 = *(const GAS f32x4*)(cw + DFF), b1 = *(const GAS f32x4*)(cw + DFF + 4), c0v = *(const GAS f32x4*)(cw + 2 * DFF), c1v = *(const GAS f32x4*)(cw + 2 * DFF + 4),
                  d0 = *(const GAS f32x4*)cbp, d1 = *(const GAS f32x4*)(cbp + 4);
#pragma unroll
      for (int e = 0; e < 4; ++e) { w0[e] = a0[e]; w0[e + 4] = a1[e]; w1[e] = b0[e]; w1[e + 4] = b1[e]; w2[e] = c0v[e]; w2[e + 4] = c1v[e]; bb[e] = d0[e]; bb[e + 4] = d1[e]; } }
    GAS bf16_t* FIN = (GAS bf16_t*)(a.ws + WS_FIN); GAS bf16_t* SA = (GAS bf16_t*)(a.ws + WS_SA); GAS bf16_t* SG = (GAS bf16_t*)(a.ws + WS_SG);
#pragma unroll
    for (int ai = 0; ai < 2; ++ai)
#pragma unroll
        for (int m = 0; m < 4; ++m) {
            const int row = u.pm * BM + ai * HALF + wr * 64 + m * 16 + fr, grp = row >> 6;
            float ov[8];
#pragma unroll
            for (int n = 0; n < 2; ++n)
#pragma unroll
                for (int e = 0; e < 4; ++e) {
                    const float cur = acc[ai][0][m][n][e];
                    float r1 = 0.f, r2 = 0.f;
                    if (m > 0) { const float pv = acc[ai][0][m > 0 ? m - 1 : 0][n][e]; r1 = dppf<0x121>(0.f, pv); r2 = dppf<0x122>(0.f, pv); }
                    const float p1 = dppf<0x111>(r1, cur), p2 = dppf<0x112>(r2, cur);
                    const int k = 4 * n + e;
                    ov[k] = gelu_tanh(w0[k] * p2 + w1[k] * p1 + w2[k] * cur + bb[k]) * acc[ai][1][m][n][e];
                }
            if (m == 0 && fr < 2) {
                *(GAS u32x4*)(SA + ((size_t)grp * 4 + 2 + fr) * DFF + ch0) = pack8(acc[ai][0][m][0], acc[ai][0][m][1]);
                *(GAS u32x4*)(SG + ((size_t)grp * 2 + fr) * DFF + ch0) = pack8(acc[ai][1][m][0], acc[ai][1][m][1]);
            } else {
                *(GAS u32x4*)(FIN + (size_t)row * DFF + ch0) = pack8a(ov);
            }
            if (m == 3 && fr >= 14) {
                *(GAS u32x4*)(SA + ((size_t)grp * 4 + (fr - 14)) * DFF + ch0) = pack8(acc[ai][0][m][0], acc[ai][0][m][1]);
                const int t = row & (SEQ - 1);
                if (t >= SEQ - 2) { GAS float* o = (GAS float*)a.out + O_FP + (size_t)((row >> 12) * 2 + (t - (SEQ - 2))) * DFF + ch0; *(GAS f32x4*)o = acc[ai][0][m][0]; *(GAS f32x4*)(o + 4) = acc[ai][0][m][1]; }
            }
        }
}
__device__ __forceinline__ void mid_scale(const Args& a, f32x4 (&acc)[2][2][4][2], const Unit& u, int wr, int wc, int fr, int fq) {
    int z = 0; asm volatile("" : "+v"(z));
    fr += z;
#pragma unroll
    for (int ai = 0; ai < 2; ++ai)
#pragma unroll
        for (int m = 0; m < 4; ++m)
#pragma unroll
            for (int bj = 0; bj < 2; ++bj) {
                float ea[8], eb[8]; load_gates(a, u.pm * BM + ai * HALF + wr * 64 + m * 16 + fr, u.pn * BM + bj * HALF + wc * 32 + 8 * fq, ea, eb);
#pragma unroll
                for (int e = 0; e < 4; ++e) { acc[ai][bj][m][0][e] *= (1.f + eb[e]) * rcpf_(1.f + ea[e]); acc[ai][bj][m][1][e] *= (1.f + eb[e + 4]) * rcpf_(1.f + ea[e + 4]); }
                __builtin_amdgcn_sched_barrier(0);
            }
}

template <int MODE, int N, int K>
__device__ __forceinline__ void gemm_phase(LAS unsigned char* lds, const Args& args, const bf16_t* gA, const bf16_t* gBt, int G, int bid, int wid_in) {
    const int wid = wid_in, lane = fresh_lane(), tid = wid * 64 + lane, wr = wid >> 2, wc = wid & 3, fr = lane & 15, fq = lane >> 4;
    const int nt = K / BK;
    StaticOrder S; S.init(MP, N, G, bid);
    unsigned voffA, voffB;
    { int R, C; stage_rc(tid * 16, R, C); const int Rb = (R & ~31) + perm32(R & 31); voffA = (unsigned)(R * K + C) * 2u; voffB = (unsigned)(Rb * K + C) * 2u; }
    const unsigned ldsbase = (unsigned)(size_t)lds;
    const size_t kstep = (size_t)(BK * 2);
    const size_t hstep = (size_t)HALF * K * 2;
    const size_t tstep = 2 * hstep;
    const unsigned ldsw = (unsigned)wid * 1024u;
    const int aoff = lds_byte(wr * 64 + fr, fq * 8), boff = lds_byte(wc * 32 + fr, fq * 8);
#define PG8_SA(b, h) (((b) * 2 + (h)) * HTB)
#define PG8_SB(b, h) ((4 + (b) * 2 + (h)) * HTB)
#define PG8_STAGE(bufoff, gbase, voff) do { glds_s((const char*)(gbase), (voff), ldsbase + (unsigned)(bufoff) + ldsw); \
        glds_s((const char*)(gbase) + (size_t)64 * K * 2, (voff), ldsbase + (unsigned)(bufoff) + ldsw + 8192u); } while (0)
#define PG8_LDA(dst, b, h) do { _Pragma("unroll") for (int m = 0; m < 4; ++m) _Pragma("unroll") for (int k = 0; k < 2; ++k) dst[m][k] = *(const LAS bf16x8*)(lds + PG8_SA(b, h) + aoff + m * 2048 + k * 1024); } while (0)
#define PG8_LDB(dst, b, h) do { _Pragma("unroll") for (int n = 0; n < 2; ++n) _Pragma("unroll") for (int k = 0; k < 2; ++k) dst[n][k] = *(const LAS bf16x8*)(lds + PG8_SB(b, h) + boff + n * 2048 + k * 1024); } while (0)
#define PG8_MMA(ai, bj, At, Bt) do { __builtin_amdgcn_s_setprio(1); _Pragma("unroll") for (int m = 0; m < 4; ++m) _Pragma("unroll") for (int n = 0; n < 2; ++n) _Pragma("unroll") for (int k = 0; k < 2; ++k) \
        acc[ai][bj][m][n] = __builtin_amdgcn_mfma_f32_16x16x32_bf16(Bt[n][k], At[m][k], acc[ai][bj][m][n], 0, 0, 0); __builtin_amdgcn_s_setprio(0); } while (0)
#define PG8_WAIT_V(n) asm volatile("s_waitcnt vmcnt(" #n ")" ::: "memory")
#define PG8_WAIT_L(n) asm volatile("s_waitcnt lgkmcnt(" #n ")" ::: "memory")
#define PG8_BAR __builtin_amdgcn_s_barrier()
#define PG8_SCHED __builtin_amdgcn_sched_barrier(0)
    Unit cur, nxt; int ui = 0;
    if (!S.next(0, cur)) return;
    f32x4 acc[2][2][4][2];
#pragma unroll
    for (int a = 0; a < 2; ++a)
#pragma unroll
        for (int b = 0; b < 2; ++b)
#pragma unroll
            for (int m = 0; m < 4; ++m)
#pragma unroll
                for (int n = 0; n < 2; ++n) acc[a][b][m][n] = (f32x4){0.f, 0.f, 0.f, 0.f};
    bf16x8 At[4][2], B0[2][2], B1[2][2];
    const char* cA = (const char*)gA + (size_t)cur.pm * tstep; const char* cB = (const char*)gBt + (size_t)cur.pn * tstep;
    PG8_STAGE(PG8_SB(0, 0), cB, voffB); PG8_STAGE(PG8_SB(0, 1), cB + hstep, voffB); PG8_STAGE(PG8_SA(0, 0), cA, voffA); PG8_STAGE(PG8_SA(0, 1), cA + hstep, voffA);
    if (wr == 1) PG8_BAR;
    PG8_WAIT_V(2); PG8_BAR;
    PG8_STAGE(PG8_SB(1, 0), cB + kstep, voffB); PG8_STAGE(PG8_SA(1, 0), cA + kstep, voffA); PG8_STAGE(PG8_SB(1, 1), cB + hstep + kstep, voffB);
    PG8_WAIT_V(6); PG8_BAR;
    for (;;) {
        const bool has_next = S.next(ui + 1, nxt);
        const char* nA = has_next ? (const char*)gA + (size_t)nxt.pm * tstep : cA; const char* nB = has_next ? (const char*)gBt + (size_t)nxt.pn * tstep : cB;
        for (int t = 0; t < nt; t += 2) {
            const bool last = (t == nt - 2);
            const char* a1 = cA + (size_t)(t + 1) * kstep;
            const char* a2 = last ? nA : cA + (size_t)(t + 2) * kstep; const char* b2 = last ? nB : cB + (size_t)(t + 2) * kstep;
            const char* a3 = a2 + kstep; const char* b3 = b2 + kstep;
            if constexpr (MODE == 3) { if (t == (nt >> 1)) { mid_scale(args, acc, cur, wr, wc, fr, fq); PG8_SCHED; } }
            PG8_LDB(B0, 0, 0); PG8_LDB(B1, 0, 1); PG8_SCHED; PG8_LDA(At, 0, 0); PG8_STAGE(PG8_SA(1, 1), a1 + hstep, voffA);
            PG8_WAIT_V(8); PG8_WAIT_L(0); PG8_BAR; PG8_MMA(0, 0, At, B0); PG8_MMA(0, 1, At, B1); PG8_BAR; PG8_SCHED;
            PG8_LDA(At, 0, 1); PG8_STAGE(PG8_SB(0, 0), b2, voffB); PG8_STAGE(PG8_SB(0, 1), b2 + hstep, voffB); PG8_STAGE(PG8_SA(0, 0), a2, voffA);
            PG8_WAIT_V(8); PG8_WAIT_L(0); PG8_BAR; PG8_MMA(1, 0, At, B0); PG8_MMA(1, 1, At, B1); PG8_BAR; PG8_SCHED;
            PG8_LDB(B0, 1, 0); PG8_LDB(B1, 1, 1); PG8_SCHED; PG8_LDA(At, 1, 0); PG8_STAGE(PG8_SA(0, 1), a2 + hstep, voffA);
            PG8_WAIT_V(8); PG8_WAIT_L(0); PG8_BAR; PG8_MMA(0, 0, At, B0); PG8_MMA(0, 1, At, B1); PG8_BAR; PG8_SCHED;
            PG8_LDA(At, 1, 1); PG8_STAGE(PG8_SB(1, 0), b3, voffB); PG8_STAGE(PG8_SB(1, 1), b3 + hstep, voffB); PG8_STAGE(PG8_SA(1, 0), a3, voffA);
            PG8_WAIT_V(8); PG8_WAIT_L(0); PG8_BAR; PG8_MMA(1, 0, At, B0); PG8_MMA(1, 1, At, B1); PG8_BAR; PG8_SCHED;
        }
        if (wr == 0) PG8_BAR;
        if constexpr (MODE == 6) tile_epi6(args, acc, cur, wr, wc, fr, fq); else tile_epi<MODE>(args, acc, cur, wr, wc, fr, fq);
        if (!has_next) break;
#pragma unroll
        for (int a = 0; a < 2; ++a)
#pragma unroll
            for (int b = 0; b < 2; ++b)
#pragma unroll
                for (int m = 0; m < 4; ++m)
#pragma unroll
                    for (int n = 0; n < 2; ++n) acc[a][b][m][n] = (f32x4){0.f, 0.f, 0.f, 0.f};
        cur = nxt; cA = nA; cB = nB; ++ui;
        if (wr == 1) PG8_BAR;
    }
    PG8_WAIT_V(0);
    PG8_BAR;
#undef PG8_SA
#undef PG8_SB
#undef PG8_STAGE
#undef PG8_LDA
#undef PG8_LDB
#undef PG8_MMA
#undef PG8_WAIT_V
#undef PG8_WAIT_L
#undef PG8_BAR
#undef PG8_SCHED
}
}

template <int MODE, int N, int K>
__device__ __forceinline__ void skinny_gemm(LAS unsigned char* lds, const Args& args, const bf16_t* A, const bf16_t* Bt, int G, int bid, int wid_in) {
    const int wid = wid_in, lane = fresh_lane(), tid = wid * 64 + lane, fr = lane & 15, fq = lane >> 4;
    LAS float* P = (LAS float*)lds;
    constexpr int nitems = N / 16, kw = K / 8, NS = kw / 32;
    constexpr int GRP = (NS % 11 == 0) ? 11 : ((NS % 8 == 0) ? 8 : NS);
    static_assert(kw % 32 == 0 && NS % GRP == 0, "skinny K split");
    for (int it = G - 1 - bid; it < nitems; it += G) {
        const int n0 = it * 16;
        const GAS bf16_t* ap = (const GAS bf16_t*)A + (size_t)fr * K + wid * kw + 8 * fq;
        const GAS bf16_t* bp = (const GAS bf16_t*)Bt + (size_t)(n0 + fr) * K + wid * kw + 8 * fq;
        f32x4 acc0 = {0.f, 0.f, 0.f, 0.f}, acc1 = acc0;
#pragma unroll 1
        for (int g = 0; g < NS; g += GRP) {
            bf16x8 a0[GRP], a1[GRP], bv[GRP];
#pragma unroll
            for (int i = 0; i < GRP; ++i) { const int k = (g + i) * 32; a0[i] = *(const GAS bf16x8*)(ap + k); a1[i] = *(const GAS bf16x8*)(ap + (size_t)16 * K + k); bv[i] = *(const GAS bf16x8*)(bp + k); }
#pragma unroll
            for (int i = 0; i < GRP; ++i) { acc0 = __builtin_amdgcn_mfma_f32_16x16x32_bf16(a0[i], bv[i], acc0, 0, 0, 0); acc1 = __builtin_amdgcn_mfma_f32_16x16x32_bf16(a1[i], bv[i], acc1, 0, 0, 0); }
        }
#pragma unroll
        for (int j = 0; j < 4; ++j) { P[(wid * 32 + 4 * fq + j) * 17 + fr] = acc0[j]; P[(wid * 32 + 16 + 4 * fq + j) * 17 + fr] = acc1[j]; }
        __syncthreads();
        if (tid < 64) {
            const int r = tid >> 1, c0 = (tid & 1) * 8;
            f32x4 l0 = {0.f, 0.f, 0.f, 0.f}, h0 = l0, l1 = l0, h1 = l0;
#pragma unroll
            for (int w = 0; w < 4; ++w)
#pragma unroll
                for (int e = 0; e < 4; ++e) {
                    l0[e] += P[(w * 32 + r) * 17 + c0 + e]; h0[e] += P[(w * 32 + r) * 17 + c0 + 4 + e];
                    l1[e] += P[((w + 4) * 32 + r) * 17 + c0 + e]; h1[e] += P[((w + 4) * 32 + r) * 17 + c0 + 4 + e];
                }
            const int row = MP + r, col0 = n0 + c0;
            if constexpr (MODE == 3) {
                float ea[8], eb[8]; load_gates(args, row, col0, ea, eb); f32x4 lo, hi;
#pragma unroll
                for (int e = 0; e < 4; ++e) { lo[e] = l0[e] * rcpf_(1.f + ea[e]) + l1[e] * rcpf_(1.f + eb[e]); hi[e] = h0[e] * rcpf_(1.f + ea[e + 4]) + h1[e] * rcpf_(1.f + eb[e + 4]); }
                epi8<30>(args, row, col0, lo, hi);
            } else {
                epi8<MODE>(args, row, col0, l0 + l1, h0 + h1);
            }
        }
        __syncthreads();
    }
}

__device__ __forceinline__ void p0_transpose_item(const GAS float* W, int K, int N, GAS bf16_t* WT, int ldt, int k_off, int up_mode, LAS float* scr, int item, int lane) {
    const int nblk = N / 32, kb = item / nblk, nb = item % nblk, k0 = 64 * kb, n0 = 32 * nb;
    int rowbase = n0;
    if (up_mode) rowbase = n0 < DFF ? (n0 >> 7) * 256 + (n0 & 127) : ((n0 - DFF) >> 7) * 256 + 128 + ((n0 - DFF) & 127);
    {
        const int r8 = lane >> 3, c4 = (lane & 7) * 4;
        f32x4 v[8];
#pragma unroll
        for (int i = 0; i < 8; ++i) v[i] = __builtin_nontemporal_load((const GAS f32x4*)(W + (size_t)(k0 + 8 * i + r8) * N + n0 + c4));
#pragma unroll
        for (int i = 0; i < 8; ++i) { LAS float* d = scr + (8 * i + r8) * 33 + c4; d[0] = v[i].x; d[1] = v[i].y; d[2] = v[i].z; d[3] = v[i].w; }
    }
    asm volatile("s_waitcnt lgkmcnt(0)" ::: "memory");
    const int c = lane & 7;
#pragma unroll
    for (int j = 0; j < 4; ++j) { const int n = (lane >> 3) + 8 * j; const LAS float* s = scr + (8 * c) * 33 + n;
        u32x4 o; o.x = cvt_pk_bf16(s[0 * 33], s[1 * 33]); o.y = cvt_pk_bf16(s[2 * 33], s[3 * 33]); o.z = cvt_pk_bf16(s[4 * 33], s[5 * 33]); o.w = cvt_pk_bf16(s[6 * 33], s[7 * 33]);
        *(GAS u32x4*)(WT + (size_t)(rowbase + n) * ldt + k_off + k0 + 8 * c) = o; }
    asm volatile("s_waitcnt lgkmcnt(0)" ::: "memory");
}

template <int SET>
__device__ __forceinline__ void late_weights(const Args& a, LAS unsigned char* lds, int w0, int nw, int wid_in) {
    const int lane = fresh_lane();
    unsigned char* ws = a.ws;
    LAS float* scr = (LAS float*)(lds + wid_in * 16384);
    constexpr int I_BR = 16 * 64, I_O = 32 * 64, I_UP = 32 * 352, I_DN = 88 * 64, I_G = 32 * 64, I_P = 4 * 64;
    if constexpr (SET == 1) {
        for (int it = w0; it < 2 * I_BR + I_O + I_P + I_UP; it += nw) {
            int r = it;
            if (r < I_BR) { p0_transpose_item((const GAS float*)a.in[15], 1024, 2048, (GAS bf16_t*)(ws + WS_WM), 2048, 0, 0, scr, r, lane); continue; } r -= I_BR;
            if (r < I_BR) { p0_transpose_item((const GAS float*)a.in[16], 1024, 2048, (GAS bf16_t*)(ws + WS_WM), 2048, 1024, 0, scr, r, lane); continue; } r -= I_BR;
            if (r < I_O) { p0_transpose_item((const GAS float*)a.in[18], 2048, 2048, (GAS bf16_t*)(ws + WS_WO), 2048, 0, 0, scr, r, lane); continue; } r -= I_O;
            if (r < I_P) { p0_transpose_item((const GAS float*)a.in[23], PLE, 2048, (GAS bf16_t*)(ws + WS_WP), PLE, 0, 0, scr, r, lane); continue; } r -= I_P;
            p0_transpose_item((const GAS float*)a.in[19], 2048, 2 * DFF, (GAS bf16_t*)(ws + WS_WUP), 2048, 0, 1, scr, r, lane);
        }
    } else {
        for (int it = w0; it < I_DN + I_G; it += nw) {
            int r = it;
            if (r < I_DN) { p0_transpose_item((const GAS float*)a.in[22], DFF, 2048, (GAS bf16_t*)(ws + WS_WDN), DFF, 0, 0, scr, r, lane); continue; } r -= I_DN;
            p0_transpose_item((const GAS float*)a.in[24], 2048, 2048, (GAS bf16_t*)(ws + WS_WG), 2048, 0, 0, scr, r, lane);
        }
    }
}
__device__ __forceinline__ void p0_prologue(const Args& a, LAS unsigned char* lds, int bid, int G, int wid_in) {
    const int wid = wid_in, lane = fresh_lane(), tid = wid * 64 + lane;
    const int gw = bid * 8 + wid, NGW = G * 8, gtid = bid * 512 + tid, GT = G * 512;
    unsigned char* ws = a.ws;
    LAS float* scr = (LAS float*)(lds + wid * 16384);
    if (gw < MT) {
        f32x4 g[8];
        { const GAS f32x4* gp = (const GAS f32x4*)a.in[8] + lane;
#pragma unroll
          for (int j = 0; j < 8; ++j) g[j] = gp[64 * j]; }
        int m = gw; f32x4 v[8];
        { const GAS f32x4* xr = (const GAS f32x4*)x_row(a, m) + lane;
#pragma unroll
          for (int j = 0; j < 8; ++j) v[j] = NTL(xr + 64 * j); }
        for (;;) {
            const int mn = m + NGW; const bool has = mn < MT; const int mp = has ? mn : m;
            f32x4 nv[8];
            { const GAS f32x4* xr = (const GAS f32x4*)x_row(a, mp) + lane;
#pragma unroll
              for (int j = 0; j < 8; ++j) nv[j] = NTL(xr + 64 * j); }
            float s = 0.f;
#pragma unroll
            for (int j = 0; j < 8; ++j) s += (v[j].x * v[j].x + v[j].y * v[j].y) + (v[j].z * v[j].z + v[j].w * v[j].w);
            const float rstd = 1.f / sqrtf(wave_sum(s) * (1.f / DM) + EPS);
            GAS u32x2* o = (GAS u32x2*)((GAS bf16_t*)(ws + WS_H) + (size_t)m * DM) + lane;
#pragma unroll
            for (int j = 0; j < 8; ++j) { u32x2 w; w.x = cvt_pk_bf16(v[j].x * rstd * g[j].x, v[j].y * rstd * g[j].y); w.y = cvt_pk_bf16(v[j].z * rstd * g[j].z, v[j].w * rstd * g[j].w); o[64 * j] = w; }
            if (!has) break;
#pragma unroll
            for (int j = 0; j < 8; ++j) v[j] = nv[j];
            m = mn;
        }
    }
    constexpr int I_IN = 32 * 264;
    for (int it = gw; it < I_IN; it += NGW) p0_transpose_item((const GAS float*)a.in[12], 2048, INC, (GAS bf16_t*)(ws + WS_WIN), 2048, 0, 0, scr, it, lane);
    for (int i = gtid; i < MT * 32; i += GT) {
        const int row = i >> 5, c8 = (i & 31) * 8;
        const GAS float* src = row < MP ? (const GAS float*)a.in[6] + (size_t)row * PLE + c8 : (const GAS float*)a.in[7] + (size_t)(row - MP) * PLE + c8;
        const f32x4 lo = NTL((const GAS f32x4*)src), hi = NTL((const GAS f32x4*)(src + 4));
        *(GAS u32x4*)((GAS bf16_t*)(ws + WS_PB) + (size_t)row * PLE + c8) = pack8(lo, hi);
    }
    for (int i = gtid; i < 4097 * 32; i += GT) {
        const int pi = i >> 5, fi = i & 31; const int pos = pi < 4096 ? pi : 16384;
        double inv = 1.0; for (int k = 0; k < fi; ++k) inv *= 0.7498942093324559;
        const float ang = (float)pos * (float)inv;
        double f = (double)ang * 0.15915494309189535; f -= __builtin_rint(f);
        GAS float* o = (GAS float*)(ws + WS_ROPE) + (size_t)i * 2;
        o[0] = __builtin_amdgcn_cosf((float)f); o[1] = __builtin_amdgcn_sinf((float)f);
    }
    for (int i = gtid; i < MS * CW; i += GT) { const int b = i / CW, c = i % CW; ((GAS float*)a.out)[O_CS + (size_t)(b * 2) * CW + c] = ((const GAS float*)a.in[4])[(size_t)(b * 2 + 1) * CW + c]; }
    for (int i = gtid; i < MS * DFF; i += GT) { const int b = i / DFF, c = i % DFF; ((GAS float*)a.out)[O_FS + (size_t)(b * 2) * DFF + c] = ((const GAS float*)a.in[5])[(size_t)(b * 2 + 1) * DFF + c]; }
}

constexpr int QS = 72, VS = 280;
__device__ __forceinline__ void rope8r(const f32x4* t, const float* x1, const float* x2, float sc, float* o1, float* o2) {
    const float c[8] = {t[0].x, t[0].z, t[1].x, t[1].z, t[2].x, t[2].z, t[3].x, t[3].z}, s[8] = {t[0].y, t[0].w, t[1].y, t[1].w, t[2].y, t[2].w, t[3].y, t[3].w};
#pragma unroll
    for (int e = 0; e < 8; ++e) { o1[e] = (x1[e] * c[e] - x2[e] * s[e]) * sc; o2[e] = (x2[e] * c[e] + x1[e] * s[e]) * sc; }
}
struct AttnRegs { u32x4 q1[4], q2[4], kc1, kc2, kp1, kp2, vv[4]; f32x4 rq[4], rp[4]; };
__device__ __forceinline__ void attn_load(const Args& a, int u, int tid, AttnRegs& R) {
    const int hq = u & 1, kv = (u >> 1) & 1, j = (u >> 2) & 31, n = u >> 7, h0 = kv * 8 + hq * 4;
    const GAS bf16_t* P1 = (const GAS bf16_t*)(a.ws + WS_PROJ1);
    const GAS float* ROPE = (const GAS float*)(a.ws + WS_ROPE);
    const bool hasprev = j > 0;
    const int r = tid >> 2, g = tid & 3, posq = j * 128 + r, posp = hasprev ? posq - 128 : posq;
    const GAS bf16_t* rowq = P1 + (size_t)(n * SEQ + posq) * P1C;
    const GAS bf16_t* rowp = P1 + (size_t)(n * SEQ + posp) * P1C;
#pragma unroll
    for (int i = 0; i < 4; ++i) { R.q1[i] = NTL((const GAS u32x4*)(rowq + (h0 + i) * 64 + 8 * g)); R.q2[i] = NTL((const GAS u32x4*)(rowq + (h0 + i) * 64 + 32 + 8 * g)); }
    R.kc1 = *(const GAS u32x4*)(rowq + C_K + kv * 64 + 8 * g); R.kc2 = *(const GAS u32x4*)(rowq + C_K + kv * 64 + 32 + 8 * g);
    R.kp1 = *(const GAS u32x4*)(rowp + C_K + kv * 64 + 8 * g); R.kp2 = *(const GAS u32x4*)(rowp + C_K + kv * 64 + 32 + 8 * g);
    const GAS f32x4* rq = (const GAS f32x4*)(ROPE + (size_t)(posq * 32 + 8 * g) * 2);
    const GAS f32x4* rp = (const GAS f32x4*)(ROPE + (size_t)(posp * 32 + 8 * g) * 2);
#pragma unroll
    for (int i = 0; i < 4; ++i) { R.rq[i] = rq[i]; R.rp[i] = rp[i]; }
    const int vk = tid >> 3, dg = tid & 7;
#pragma unroll
    for (int ps = 0; ps < 4; ++ps) {
        const int c = ps * 64 + vk; const int pos = (ps < 2) ? (hasprev ? j * 128 - 128 + c : j * 128 + c) : j * 128 - 128 + c;
        R.vv[ps] = *(const GAS u32x4*)(P1 + (size_t)(n * SEQ + pos) * P1C + C_V + kv * 64 + 8 * dg);
    }
}
constexpr int QBUF = 128 * QS;
__device__ __forceinline__ void attn_write_q(LAS bf16_t* Qb, const AttnRegs& R, int i, int tid) {
    const int r = tid >> 2, g = tid & 3;
    float x1[8], x2[8], o1[8], o2[8];
    unpack8(R.q1[i], x1); unpack8(R.q2[i], x2); rope8r(R.rq, x1, x2, 0.125f, o1, o2);
    *(LAS u32x4*)(Qb + r * QS + 8 * g) = pack8a(o1); *(LAS u32x4*)(Qb + r * QS + 32 + 8 * g) = pack8a(o2);
}

__device__ __forceinline__ void attn_prompt_unit(const Args& a, LAS unsigned char* lds, int u, int wid_in) {
    const int wid = wid_in, lane = fresh_lane(), tid = wid * 64 + lane, fr = lane & 15, fq = lane >> 4;
    const int hq = u & 1, kv = (u >> 1) & 1, j = (u >> 2) & 31, n = u >> 7, h0 = kv * 8 + hq * 4;
    LAS bf16_t* Qs0 = (LAS bf16_t*)lds; LAS bf16_t* Ks = Qs0 + 2 * QBUF; LAS bf16_t* Vt = Ks + 256 * QS;
    const bool wr_state = (j == 31) && (hq == 0);
    const bool hasprev = j > 0;
    AttnRegs R; attn_load(a, u, tid, R);
    {
        const int r = tid >> 2, g = tid & 3, vk = tid >> 3, dg = tid & 7;
        float x1[8], x2[8], o1[8], o2[8];
        attn_write_q(Qs0, R, 0, tid);
        unpack8(R.kc1, x1); unpack8(R.kc2, x2); rope8r(R.rq, x1, x2, 1.f, o1, o2);
        if (wr_state) {
            GAS float* o = (GAS float*)a.out + O_KP + ((size_t)(n * 128 + r) * 2 + kv) * 64 + 8 * g;
            *(GAS f32x4*)o = (f32x4){o1[0], o1[1], o1[2], o1[3]}; *(GAS f32x4*)(o + 4) = (f32x4){o1[4], o1[5], o1[6], o1[7]};
            *(GAS f32x4*)(o + 32) = (f32x4){o2[0], o2[1], o2[2], o2[3]}; *(GAS f32x4*)(o + 36) = (f32x4){o2[4], o2[5], o2[6], o2[7]};
        }
        *(LAS u32x4*)(Ks + (128 + r) * QS + 8 * g) = pack8a(o1); *(LAS u32x4*)(Ks + (128 + r) * QS + 32 + 8 * g) = pack8a(o2);
        unpack8(R.kp1, x1); unpack8(R.kp2, x2); rope8r(R.rp, x1, x2, hasprev ? 1.f : 0.f, o1, o2);
        *(LAS u32x4*)(Ks + r * QS + 8 * g) = pack8a(o1); *(LAS u32x4*)(Ks + r * QS + 32 + 8 * g) = pack8a(o2);
#pragma unroll
        for (int ps = 0; ps < 4; ++ps) {
            const int c = ps * 64 + vk;
            u32x4 w = R.vv[ps];
            if (ps < 2 && !hasprev) w = (u32x4){0u, 0u, 0u, 0u};
            const unsigned ww[4] = {w.x, w.y, w.z, w.w};
#pragma unroll
            for (int e = 0; e < 4; ++e) { Vt[(8 * dg + 2 * e) * VS + c] = (bf16_t)(ww[e] & 0xffffu); Vt[(8 * dg + 2 * e + 1) * VS + c] = (bf16_t)(ww[e] >> 16); }
            if (ps >= 2 && wr_state) {
                float v[8]; unpack8(w, v);
                GAS float* o = (GAS float*)a.out + O_VP + ((size_t)(n * 128 + (c - 128)) * 2 + kv) * 64 + 8 * dg;
                *(GAS f32x4*)o = (f32x4){v[0], v[1], v[2], v[3]}; *(GAS f32x4*)(o + 4) = (f32x4){v[4], v[5], v[6], v[7]};
            }
        }
    }
    for (int i = tid; i < 64 * 24; i += 512) Vt[(i / 24) * VS + 256 + (i % 24)] = 0;
    __syncthreads();
#pragma unroll
    for (int hi = 0; hi < 4; ++hi) {
    const int h = h0 + hi;
    LAS bf16_t* Qs = Qs0 + (hi & 1) * QBUF;
    if (hi < 3) attn_write_q(Qs0 + ((hi + 1) & 1) * QBUF, R, hi + 1, tid);
    const bf16x8 bq0 = *(const LAS bf16x8*)(Qs + (16 * wid + fr) * QS + 8 * fq), bq1 = *(const LAS bf16x8*)(Qs + (16 * wid + fr) * QS + 32 + 8 * fq);
    f32x4 s[9], s2[9];
#pragma unroll
    for (int b = 0; b < 9; ++b) {
        const int kb = wid + b;
        const bf16x8 k0 = *(const LAS bf16x8*)(Ks + (16 * kb + fr) * QS + 8 * fq), k1 = *(const LAS bf16x8*)(Ks + (16 * kb + fr) * QS + 32 + 8 * fq);
        const f32x4 z = {0.f, 0.f, 0.f, 0.f};
        s[b] = __builtin_amdgcn_mfma_f32_16x16x32_bf16(k0, bq0, z, 0, 0, 0);
        s2[b] = __builtin_amdgcn_mfma_f32_16x16x32_bf16(k1, bq1, z, 0, 0, 0);
    }
    __builtin_amdgcn_sched_barrier(0);
    asm volatile("s_nop 7\n\ts_nop 7" ::: "memory");
#pragma unroll
    for (int b = 0; b < 9; ++b) { asm volatile("" : "+v"(s[b]), "+v"(s2[b])); s[b] = s[b] + s2[b]; }
    const float sink = ((const GAS float*)a.in[13])[h];
    const int qi = 16 * wid + fr;
    float mx = sink;
#pragma unroll
    for (int b = 0; b < 9; ++b)
#pragma unroll
        for (int e = 0; e < 4; ++e) {
            const int c = 16 * (wid + b) + 4 * fq + e;
            const bool ok = (c > qi) && (c <= qi + 128) && (j > 0 || c >= 128);
            s[b][e] = ok ? s[b][e] : -1e30f;
            mx = fmaxf(mx, s[b][e]);
        }
    mx = fmaxf(mx, __shfl_xor(mx, 16)); mx = fmaxf(mx, __shfl_xor(mx, 32));
    float sum = 0.f;
#pragma unroll
    for (int b = 0; b < 9; ++b)
#pragma unroll
        for (int e = 0; e < 4; ++e) { const float p = s[b][e] > -1e29f ? __expf(s[b][e] - mx) : 0.f; s[b][e] = p; sum += p; }
    sum += __shfl_xor(sum, 16); sum += __shfl_xor(sum, 32);
    const float inv = 1.f / (sum + __expf(sink - mx));
    f32x4 ot[5][4];
#pragma unroll
    for (int pi = 0; pi < 5; ++pi) {
        const int kb0 = wid + 2 * pi, kb1 = kb0 + 1;
        u32x4 pw; pw.x = cvt_pk_bf16(s[2 * pi][0], s[2 * pi][1]); pw.y = cvt_pk_bf16(s[2 * pi][2], s[2 * pi][3]);
        if (pi < 4) { pw.z = cvt_pk_bf16(s[2 * pi + 1 < 9 ? 2 * pi + 1 : 8][0], s[2 * pi + 1 < 9 ? 2 * pi + 1 : 8][1]); pw.w = cvt_pk_bf16(s[2 * pi + 1 < 9 ? 2 * pi + 1 : 8][2], s[2 * pi + 1 < 9 ? 2 * pi + 1 : 8][3]); }
        else { pw.z = 0u; pw.w = 0u; }
        const bf16x8 pb = __builtin_bit_cast(bf16x8, pw);
#pragma unroll
        for (int d = 0; d < 4; ++d) {
            const u32x2 lo = *(const LAS u32x2*)(Vt + (16 * d + fr) * VS + 16 * kb0 + 4 * fq), hi = *(const LAS u32x2*)(Vt + (16 * d + fr) * VS + 16 * kb1 + 4 * fq);
            const u32x4 vw = {lo.x, lo.y, hi.x, hi.y};
            const f32x4 zz = {0.f, 0.f, 0.f, 0.f};
            ot[pi][d] = __builtin_amdgcn_mfma_f32_16x16x32_bf16(__builtin_bit_cast(bf16x8, vw), pb, zz, 0, 0, 0);
        }
    }
    __builtin_amdgcn_sched_barrier(0);
    asm volatile("s_nop 7\n\ts_nop 7" ::: "memory");
    f32x4 o[4];
#pragma unroll
    for (int d = 0; d < 4; ++d) {
#pragma unroll
        for (int pi = 0; pi < 5; ++pi) asm volatile("" : "+v"(ot[pi][d]));
        o[d] = ((ot[0][d] + ot[1][d]) + (ot[2][d] + ot[3][d])) + ot[4][d];
    }
    GAS bf16_t* dst = (GAS bf16_t*)(a.ws + WS_AB) + (size_t)(n * SEQ + j * 128 + qi) * DM + h * 64 + 4 * fq;
#pragma unroll
    for (int d = 0; d < 4; ++d) { u32x2 w; w.x = cvt_pk_bf16(o[d][0] * inv, o[d][1] * inv); w.y = cvt_pk_bf16(o[d][2] * inv, o[d][3] * inv); *(GAS u32x2*)(dst + 16 * d) = w; }
    __syncthreads();
    }
}

__device__ __forceinline__ void attn_sample_unit(const Args& a, LAS unsigned char* lds, int b, int wid_in) {
    const int wid = wid_in, lane = fresh_lane(), tid = wid * 64 + lane;
    LAS float* qf = (LAS float*)lds;
    LAS float* kn = qf + 1024;
    LAS float* vn = kn + 128;
    LAS float* S = vn + 128;
    LAS float* KV = (LAS float*)(lds + 16384);
    constexpr int KS_ = 129;
    const GAS bf16_t* prow = (const GAS bf16_t*)(a.ws + WS_PROJ1) + (size_t)(MP + b) * P1C;
    const GAS float* rp = (const GAS float*)(a.ws + WS_ROPE) + (size_t)4096 * 64;
    const GAS float* sk = (const GAS float*)a.in[2] + (size_t)b * 128 * 128 + 128;
    const GAS float* sv = (const GAS float*)a.in[3] + (size_t)b * 128 * 128 + 128;
    GAS float* ok = (GAS float*)a.out + O_KS + (size_t)b * 16384;
    GAS float* ov = (GAS float*)a.out + O_VS + (size_t)b * 16384;
    f32x4 kreg[8], vreg[8];
#pragma unroll
    for (int q = 0; q < 8; ++q) { const int i4 = tid + 512 * q; const bool ok_ = i4 < 127 * 32; const int j4 = ok_ ? i4 : 0;
        kreg[q] = *(const GAS f32x4*)(sk + (size_t)j4 * 4); vreg[q] = *(const GAS f32x4*)(sv + (size_t)j4 * 4); }
    {
        const int h = tid >> 5, i = tid & 31; const float c = rp[2 * i], s = rp[2 * i + 1];
        const float x1 = bf1(prow[h * 64 + i]), x2 = bf1(prow[h * 64 + 32 + i]);
        qf[h * 64 + i] = (x1 * c - x2 * s) * 0.125f; qf[h * 64 + 32 + i] = (x2 * c + x1 * s) * 0.125f;
        if (tid < 64) { const float y1 = bf1(prow[C_K + h * 64 + i]), y2 = bf1(prow[C_K + h * 64 + 32 + i]); kn[h * 64 + i] = y1 * c - y2 * s; kn[h * 64 + 32 + i] = y2 * c + y1 * s; }
        if (tid < 128) vn[tid] = bf1(prow[C_V + tid]);
    }
#pragma unroll
    for (int q = 0; q < 8; ++q) { const int i4 = tid + 512 * q; if (i4 < 127 * 32) { const int i = i4 >> 5, c4 = (i4 & 31) * 4; LAS float* d = KV + i * KS_ + c4;
        d[0] = kreg[q].x; d[1] = kreg[q].y; d[2] = kreg[q].z; d[3] = kreg[q].w; *(GAS f32x4*)(ok + (size_t)i4 * 4) = kreg[q]; *(GAS f32x4*)(ov + (size_t)i4 * 4) = vreg[q]; } }
    __syncthreads();
    if (tid < 128) { KV[127 * KS_ + tid] = kn[tid]; ok[127 * 128 + tid] = kn[tid]; ov[127 * 128 + tid] = vn[tid]; }
    __syncthreads();
#pragma unroll
    for (int cc = 0; cc < 4; ++cc) {
        const int idx = tid + 512 * cc, h = idx >> 7, i = idx & 127, kv = h >> 3;
        float d = 0.f;
#pragma unroll 16
        for (int e = 0; e < 64; ++e) d += KV[i * KS_ + kv * 64 + e] * qf[h * 64 + e];
        S[h * 128 + i] = d;
    }
    __syncthreads();
#pragma unroll
    for (int hh = 0; hh < 2; ++hh) {
        const int h = wid * 2 + hh; const float sink = ((const GAS float*)a.in[13])[h];
        const float s0 = S[h * 128 + lane], s1 = S[h * 128 + 64 + lane];
        const float mx = fmaxf(wave_max(fmaxf(s0, s1)), sink);
        const float p0 = __expf(s0 - mx), p1 = __expf(s1 - mx);
        const float inv = 1.f / (wave_sum(p0 + p1) + __expf(sink - mx));
        S[h * 128 + lane] = p0 * inv; S[h * 128 + 64 + lane] = p1 * inv;
    }
#pragma unroll
    for (int q = 0; q < 8; ++q) { const int i4 = tid + 512 * q; if (i4 < 127 * 32) { const int i = i4 >> 5, c4 = (i4 & 31) * 4; LAS float* d = KV + i * KS_ + c4;
        d[0] = vreg[q].x; d[1] = vreg[q].y; d[2] = vreg[q].z; d[3] = vreg[q].w; } }
    if (tid < 128) KV[127 * KS_ + tid] = vn[tid];
    __syncthreads();
#pragma unroll
    for (int cc = 0; cc < 2; ++cc) {
        const int idx = tid + 512 * cc, h = idx >> 6, d = idx & 63, kv = h >> 3;
        float acc = 0.f;
#pragma unroll 16
        for (int i = 0; i < 128; ++i) acc += S[h * 128 + i] * KV[i * KS_ + kv * 64 + d];
        ((GAS bf16_t*)(a.ws + WS_AB))[(size_t)(MP + b) * DM + h * 64 + d] = (bf16_t)(cvt_pk_bf16(acc, 0.f) & 0xffffu);
    }
    __syncthreads();
}

__device__ __forceinline__ void convb_item(const Args& a, int item, int lane) {
    const int rb = item >> 1, c0 = (item & 1) * 512 + lane * 8, row0 = rb * 8;
    const GAS bf16_t* P1 = (const GAS bf16_t*)(a.ws + WS_PROJ1);
    const GAS float* cw = (const GAS float*)a.in[14] + c0;
    float w0[8], w1[8], w2[8];
    { const f32x4 a0 = *(const GAS f32x4*)cw, a1 = *(const GAS f32x4*)(cw + 4), b0 = *(const GAS f32x4*)(cw + CW), b1 = *(const GAS f32x4*)(cw + CW + 4), c0v = *(const GAS f32x4*)(cw + 2 * CW), c1v = *(const GAS f32x4*)(cw + 2 * CW + 4);
#pragma unroll
      for (int e = 0; e < 4; ++e) { w0[e] = a0[e]; w0[e + 4] = a1[e]; w1[e] = b0[e]; w1[e + 4] = b1[e]; w2[e] = c0v[e]; w2[e + 4] = c1v[e]; } }
    float p2[8], p1[8];
    const bool prompt = row0 < MP;
    const bool halo = prompt && (row0 & (SEQ - 1)) != 0;
    const int hr = halo ? row0 - 2 : row0;
    const u32x4 hx0 = *(const GAS u32x4*)(P1 + (size_t)hr * P1C + C_CC + c0), hy0 = *(const GAS u32x4*)(P1 + (size_t)hr * P1C + C_CU + c0);
    const u32x4 hx1 = *(const GAS u32x4*)(P1 + (size_t)(hr + 1) * P1C + C_CC + c0), hy1 = *(const GAS u32x4*)(P1 + (size_t)(hr + 1) * P1C + C_CU + c0);
    u32x4 vb[8], vc[8], vu[8];
#pragma unroll
    for (int r = 0; r < 8; ++r) { const GAS bf16_t* pr = P1 + (size_t)(row0 + r) * P1C + c0; vb[r] = NTL((const GAS u32x4*)(pr + C_CB)); vc[r] = NTL((const GAS u32x4*)(pr + C_CC)); vu[r] = NTL((const GAS u32x4*)(pr + C_CU)); }
    { float x[8], y[8]; unpack8(hx0, x); unpack8(hy0, y);
#pragma unroll
      for (int e = 0; e < 8; ++e) p2[e] = halo ? x[e] * y[e] : 0.f;
      unpack8(hx1, x); unpack8(hy1, y);
#pragma unroll
      for (int e = 0; e < 8; ++e) p1[e] = halo ? x[e] * y[e] : 0.f; }
#pragma unroll
    for (int r = 0; r < 8; ++r) {
        const int row = row0 + r;
        if (!prompt) {
            const GAS float* st = (const GAS float*)a.in[4] + (size_t)(row - MP) * 2 * CW + c0;
            const f32x4 s0 = *(const GAS f32x4*)st, s1 = *(const GAS f32x4*)(st + 4), s2 = *(const GAS f32x4*)(st + CW), s3 = *(const GAS f32x4*)(st + CW + 4);
#pragma unroll
            for (int e = 0; e < 4; ++e) { p2[e] = s0[e]; p2[e + 4] = s1[e]; p1[e] = s2[e]; p1[e + 4] = s3[e]; }
        }
        float cb[8], x[8], y[8], cx[8], ov[8];
        unpack8(vb[r], cb); unpack8(vc[r], x); unpack8(vu[r], y);
#pragma unroll
        for (int e = 0; e < 8; ++e) { cx[e] = x[e] * y[e]; ov[e] = cb[e] * (w0[e] * p2[e] + w1[e] * p1[e] + w2[e] * cx[e]); }
        *(GAS u32x4*)((GAS bf16_t*)(a.ws + WS_AB) + (size_t)row * DM + 1024 + c0) = pack8a(ov);
        GAS float* so = nullptr;
        if (prompt) { const int t = row & (SEQ - 1); if (t >= SEQ - 2) so = (GAS float*)a.out + O_CP + (size_t)((row >> 12) * 2 + (t - (SEQ - 2))) * CW + c0; }
        else so = (GAS float*)a.out + O_CS + (size_t)((row - MP) * 2 + 1) * CW + c0;
        if (so) { *(GAS f32x4*)so = (f32x4){cx[0], cx[1], cx[2], cx[3]}; *(GAS f32x4*)(so + 4) = (f32x4){cx[4], cx[5], cx[6], cx[7]}; }
#pragma unroll
        for (int e = 0; e < 8; ++e) { p2[e] = p1[e]; p1[e] = cx[e]; }
    }
}

template <bool FIRST>
__device__ __forceinline__ void resnorm_rows(const Args& a, int gw, int NGW, int lane) {
    f32x4 g1[8], g2[8];
    { const GAS f32x4* p1 = (const GAS f32x4*)a.in[FIRST ? 9 : 11] + lane; const GAS f32x4* p2 = (const GAS f32x4*)a.in[10] + lane;
#pragma unroll
      for (int j = 0; j < 8; ++j) { g1[j] = p1[64 * j]; g2[j] = FIRST ? p2[64 * j] : (f32x4){0.f, 0.f, 0.f, 0.f}; } }
    int m = gw; if (m >= MT) return;
    const GAS bf16_t* SRC = (const GAS bf16_t*)(a.ws + (FIRST ? WS_MO : WS_F));
    const GAS bf16_t* X1B = (const GAS bf16_t*)(a.ws + WS_X1B);
    f32x4 v[8], x[8];
    { const GAS u32x2* sr = (const GAS u32x2*)(SRC + (size_t)m * DM) + lane;
#pragma unroll
      for (int j = 0; j < 8; ++j) { const u32x2 w = NTL(sr + 64 * j); v[j] = (f32x4){bflo(w.x), bfhi(w.x), bflo(w.y), bfhi(w.y)}; }
      if (FIRST) { const GAS f32x4* xr = (const GAS f32x4*)x_row(a, m) + lane;
#pragma unroll
        for (int j = 0; j < 8; ++j) x[j] = NTL(xr + 64 * j); }
      else { const GAS u32x2* xr = (const GAS u32x2*)(X1B + (size_t)m * DM) + lane;
#pragma unroll
        for (int j = 0; j < 8; ++j) { const u32x2 w = NTL(xr + 64 * j); x[j] = (f32x4){bflo(w.x), bfhi(w.x), bflo(w.y), bfhi(w.y)}; } } }
    for (;;) {
        const int mn = m + NGW; const bool has = mn < MT; const int mp = has ? mn : m;
        u32x2 nw[8]; f32x4 nx[8]; u32x2 nxb[8];
        { const GAS u32x2* sr = (const GAS u32x2*)(SRC + (size_t)mp * DM) + lane;
#pragma unroll
          for (int j = 0; j < 8; ++j) nw[j] = NTL(sr + 64 * j);
          if (FIRST) { const GAS f32x4* xr = (const GAS f32x4*)x_row(a, mp) + lane;
#pragma unroll
            for (int j = 0; j < 8; ++j) nx[j] = NTL(xr + 64 * j); }
          else { const GAS u32x2* xr = (const GAS u32x2*)(X1B + (size_t)mp * DM) + lane;
#pragma unroll
            for (int j = 0; j < 8; ++j) nxb[j] = NTL(xr + 64 * j); } }
        float s = 0.f;
#pragma unroll
        for (int j = 0; j < 8; ++j) s += (v[j].x * v[j].x + v[j].y * v[j].y) + (v[j].z * v[j].z + v[j].w * v[j].w);
        const float rstd = 1.f / sqrtf(wave_sum(s) * (1.f / DM) + EPS);
        float s2 = 0.f;
        GAS u32x2* xo = (GAS u32x2*)((GAS bf16_t*)(a.ws + (FIRST ? WS_X1B : WS_H)) + (size_t)m * DM) + lane;
#pragma unroll
        for (int j = 0; j < 8; ++j) { v[j] = x[j] + v[j] * rstd * g1[j]; u32x2 w; w.x = cvt_pk_bf16(v[j].x, v[j].y); w.y = cvt_pk_bf16(v[j].z, v[j].w); xo[64 * j] = w;
            s2 += (v[j].x * v[j].x + v[j].y * v[j].y) + (v[j].z * v[j].z + v[j].w * v[j].w); }
        if (FIRST) {
            GAS u32x2* ho = (GAS u32x2*)((GAS bf16_t*)(a.ws + WS_H) + (size_t)m * DM) + lane;
            const float rstd2 = 1.f / sqrtf(wave_sum(s2) * (1.f / DM) + EPS);
#pragma unroll
            for (int j = 0; j < 8; ++j) { u32x2 w; w.x = cvt_pk_bf16(v[j].x * rstd2 * g2[j].x, v[j].y * rstd2 * g2[j].y); w.y = cvt_pk_bf16(v[j].z * rstd2 * g2[j].z, v[j].w * rstd2 * g2[j].w); ho[64 * j] = w; }
        }
        if (!has) break;
#pragma unroll
        for (int j = 0; j < 8; ++j) { v[j] = (f32x4){bflo(nw[j].x), bfhi(nw[j].x), bflo(nw[j].y), bfhi(nw[j].y)};
            x[j] = FIRST ? nx[j] : (f32x4){bflo(nxb[j].x), bfhi(nxb[j].x), bflo(nxb[j].y), bfhi(nxb[j].y)}; }
        m = mn;
    }
}

__device__ __forceinline__ void ffnfix_item(const Args& a, int item, int lane) {
    const int c0 = (item % 11) * 512 + lane * 8, q = item / 11;
    const GAS float* cw = (const GAS float*)a.in[20] + c0;
    const GAS float* cbp = (const GAS float*)a.in[21] + c0;
    float w0[8], w1[8], w2[8], bb[8];
    { const f32x4 a0 = *(const GAS f32x4*)cw, a1 = *(const GAS f32x4*)(cw + 4), b0 = *(const GAS f32x4*)(cw + DFF), b1 = *(const GAS f32x4*)(cw + DFF + 4), c0v = *(const GAS f32x4*)(cw + 2 * DFF), c1v = *(const GAS f32x4*)(cw + 2 * DFF + 4),
                  d0 = *(const GAS f32x4*)cbp, d1 = *(const GAS f32x4*)(cbp + 4);
#pragma unroll
      for (int e = 0; e < 4; ++e) { w0[e] = a0[e]; w0[e + 4] = a1[e]; w1[e] = b0[e]; w1[e + 4] = b1[e]; w2[e] = c0v[e]; w2[e + 4] = c1v[e]; bb[e] = d0[e]; bb[e + 4] = d1[e]; } }
    GAS bf16_t* FIN = (GAS bf16_t*)(a.ws + WS_FIN);
    float p2[8], p1[8], x0[8], x1[8], g0[8], g1[8], ov[8];
    if (q < 128) {
        const GAS bf16_t* SA = (const GAS bf16_t*)(a.ws + WS_SA); const GAS bf16_t* SG = (const GAS bf16_t*)(a.ws + WS_SG);
        const int r0 = q * 64; const bool halo = (r0 & (SEQ - 1)) != 0; const int qp = halo ? q - 1 : q;
        const u32x4 h0 = *(const GAS u32x4*)(SA + ((size_t)qp * 4 + 0) * DFF + c0), h1 = *(const GAS u32x4*)(SA + ((size_t)qp * 4 + 1) * DFF + c0);
        const u32x4 a0 = *(const GAS u32x4*)(SA + ((size_t)q * 4 + 2) * DFF + c0), a1 = *(const GAS u32x4*)(SA + ((size_t)q * 4 + 3) * DFF + c0);
        const u32x4 gg0 = *(const GAS u32x4*)(SG + ((size_t)q * 2 + 0) * DFF + c0), gg1 = *(const GAS u32x4*)(SG + ((size_t)q * 2 + 1) * DFF + c0);
        unpack8(h0, p2); unpack8(h1, p1); unpack8(a0, x0); unpack8(a1, x1); unpack8(gg0, g0); unpack8(gg1, g1);
#pragma unroll
        for (int e = 0; e < 8; ++e) { p2[e] = halo ? p2[e] : 0.f; p1[e] = halo ? p1[e] : 0.f; }
#pragma unroll
        for (int e = 0; e < 8; ++e) ov[e] = gelu_tanh(w0[e] * p2[e] + w1[e] * p1[e] + w2[e] * x0[e] + bb[e]) * g0[e];
        *(GAS u32x4*)(FIN + (size_t)r0 * DFF + c0) = pack8a(ov);
#pragma unroll
        for (int e = 0; e < 8; ++e) ov[e] = gelu_tanh(w0[e] * p1[e] + w1[e] * x0[e] + w2[e] * x1[e] + bb[e]) * g1[e];
        *(GAS u32x4*)(FIN + (size_t)(r0 + 1) * DFF + c0) = pack8a(ov);
    } else {
        const int b = q - 128;
        const GAS float* st = (const GAS float*)a.in[5] + (size_t)b * 2 * DFF + c0;
        const f32x4 s0 = *(const GAS f32x4*)st, s1 = *(const GAS f32x4*)(st + 4), s2 = *(const GAS f32x4*)(st + DFF), s3 = *(const GAS f32x4*)(st + DFF + 4);
        const u32x4 a0 = *(const GAS u32x4*)((const GAS bf16_t*)(a.ws + WS_UAS) + (size_t)b * DFF + c0), gg0 = *(const GAS u32x4*)((const GAS bf16_t*)(a.ws + WS_UGS) + (size_t)b * DFF + c0);
        unpack8(a0, x0); unpack8(gg0, g0);
#pragma unroll
        for (int e = 0; e < 4; ++e) { p2[e] = s0[e]; p2[e + 4] = s1[e]; p1[e] = s2[e]; p1[e + 4] = s3[e]; }
#pragma unroll
        for (int e = 0; e < 8; ++e) ov[e] = gelu_tanh(w0[e] * p2[e] + w1[e] * p1[e] + w2[e] * x0[e] + bb[e]) * g0[e];
        *(GAS u32x4*)(FIN + (size_t)(MP + b) * DFF + c0) = pack8a(ov);
    }
}

#define XB_TMO      128
#define XB_XCNT(j)  (256  + 64 * (j))
#define XB_XSUB(j)  (1280 + 64 * (j))
#define XB_XGEN(j)  (2304 + 64 * (j))
#define XB_TOP      3328
#define XB_TOPGEN   3392
#define XCD_BAR_WORDS 3456
#define XB_SPIN_CAP (1u << 18)
__device__ __forceinline__ unsigned xb_ld(unsigned* p)              { return __hip_atomic_load(p, __ATOMIC_RELAXED, __HIP_MEMORY_SCOPE_AGENT); }
__device__ __forceinline__ unsigned xb_add(unsigned* p, unsigned v) { return __hip_atomic_fetch_add(p, v, __ATOMIC_RELAXED, __HIP_MEMORY_SCOPE_AGENT); }
__device__ __forceinline__ unsigned xb_xcc_id() { return (unsigned)__builtin_amdgcn_s_getreg((3 << 11) | 20) & 0xFu; }
#define XB_SPIN(cond, bar) do { unsigned _sp = 0; while (cond) { __builtin_amdgcn_s_sleep(1); \
    if ((++_sp & 255u) == 0u) { if (xb_ld(&(bar)[XB_TMO])) break; if (_sp > XB_SPIN_CAP) { atomicAdd(&(bar)[XB_TMO], 1u); break; } } } } while (0)
__device__ __forceinline__ void xcd_barrier_complete(unsigned* bar, unsigned x, unsigned G, unsigned& nloc, unsigned& nx) {
    unsigned sum, cnt, mine, sp = 0u;
    for (;;) {
        sum = 0u; cnt = 0u; mine = 0u;
#pragma unroll
        for (unsigned j = 0; j < 16; ++j) { const unsigned c = xb_ld(&bar[XB_XCNT(j)]); sum += c; cnt += (c > 0u) ? 1u : 0u; mine = (j == x) ? c : mine; }
        if (sum == G) break;
        __builtin_amdgcn_s_sleep(1);
        if ((++sp & 255u) == 0u) { if (xb_ld(&bar[XB_TMO])) break; if (sp > XB_SPIN_CAP) { atomicAdd(&bar[XB_TMO], 1u); break; } }
    }
    nloc = mine > 0u ? mine : 1u; nx = cnt > 0u ? cnt : 1u;
}
__device__ __forceinline__ void grid_barrier(unsigned* bar, volatile LAS unsigned* st, unsigned G, int wid_in) {
    asm volatile("s_waitcnt vmcnt(0)" ::: "memory");
    __syncthreads();
    if (wid_in == 0 && fresh_lane() == 0) {
        __builtin_amdgcn_s_waitcnt(0);
        const unsigned x = xb_xcc_id();
        unsigned nloc = st[0], nx = st[1];
        if (nloc == 0u) { xcd_barrier_complete(bar, x, G, nloc, nx); st[0] = nloc; st[1] = nx; }
        const unsigned old = xb_add(&bar[XB_XSUB(x)], 1u);
        const unsigned gen = old / nloc;
        if (old + 1u == (gen + 1u) * nloc) {
            __builtin_amdgcn_fence(__ATOMIC_RELEASE, "agent");
            asm volatile("s_waitcnt vmcnt(0)" ::: "memory");
            const unsigned og = xb_add(&bar[XB_TOP], 1u);
            const unsigned tg = og / nx;
            if (og + 1u == (tg + 1u) * nx) xb_add(&bar[XB_TOPGEN], 1u);
            else XB_SPIN(xb_ld(&bar[XB_TOPGEN]) == tg, bar);
            __builtin_amdgcn_fence(__ATOMIC_ACQUIRE, "agent");
            xb_add(&bar[XB_XGEN(x)], 1u);
            asm volatile("s_waitcnt vmcnt(0)" ::: "memory");
        } else {
            XB_SPIN(xb_ld(&bar[XB_XGEN(x)]) == gen, bar);
            __builtin_amdgcn_fence(__ATOMIC_ACQUIRE, "agent");
            asm volatile("s_waitcnt vmcnt(0)" ::: "memory");
        }
    }
    __syncthreads();
}

template <int MODE, int N, int K>
__device__ __forceinline__ void gemm_job(LAS unsigned char* lds, const Args& a, size_t offA, size_t offB, int G, int bid, int wid) {
    const bf16_t* A = (const bf16_t*)(a.ws + offA); const bf16_t* Bt = (const bf16_t*)(a.ws + offB);
    pg8::gemm_phase<MODE, N, K>(lds, a, A, Bt, G, bid, wid);
    skinny_gemm<MODE, N, K>(lds, a, A + (size_t)MP * K, Bt, G, bid, wid);
}

__global__ void __launch_bounds__(512, 2) hybrid_fwd(Args a) {
    __shared__ __attribute__((aligned(16))) unsigned char lds_raw[LDS_BYTES];
    LAS unsigned char* lds = (LAS unsigned char*)lds_raw;
    const int wid = __builtin_amdgcn_readfirstlane((int)threadIdx.x >> 6);
    const int G = gridDim.x, bid = blockIdx.x, gw = bid * 8 + wid, NGW = G * 8;
    const int lo = a.ph_lo, hi = a.ph_hi;
    if (lo > 1000) { __threadfence(); cg::this_grid().sync(); }
    if (hi - lo > 1) {
        if (wid == 0) { const int l = fresh_lane(); if (l < 2) ((volatile LAS unsigned*)(lds + 131072))[l] = 0u; if (l == 0) (void)xb_add((unsigned*)a.ws + XB_XCNT(xb_xcc_id()), 1u); }
        __syncthreads();
    }
#define IN(k) (lo <= (k) && (k) < hi)
#define SEAM(k) do { if (IN(k) && IN((k) + 1)) grid_barrier((unsigned*)a.ws, (volatile LAS unsigned*)(lds + 131072), (unsigned)G, wid); } while (0)
#ifdef PROBE_PHASE
    if (IN(100)) {
        const int gtid = bid * 512 + wid * 64 + fresh_lane(), GT = G * 512;
        const GAS bf16_t* b16 = (const GAS bf16_t*)(a.ws + 4 * MiB); const size_t n = (size_t)(341 * MiB / 2), NOUT = 16842752;
        for (size_t i = gtid; i < NOUT; i += GT) { float acc = 0.f; for (size_t k = i; k < n; k += NOUT) acc += bf1(b16[k]); ((GAS float*)a.out)[i] = acc; }
    }
#endif
    if (IN(0)) p0_prologue(a, lds, bid, G, wid);
    SEAM(0);
    if (IN(1)) {
        gemm_job<1, INC, 2048>(lds, a, WS_H, WS_WIN, G, bid, wid);
        constexpr int NFULL = (MP / 256) * (INC / 256) % 256;
        const int first = (G == 256) ? NFULL : 0;
        if (bid >= first) late_weights<1>(a, lds, (bid - first) * 8 + wid, (G - first) * 8, wid);
    }
    SEAM(1);
    if (IN(2)) {
#ifndef SKIP_PA
        for (int u = bid; u < 256; u += G) attn_prompt_unit(a, lds, u, wid);
#endif
        if (bid >= G - MS) attn_sample_unit(a, lds, G - 1 - bid, wid);
        for (int it = gw; it < (MT / 8) * 2; it += NGW) convb_item(a, it, fresh_lane());
    }
    SEAM(2);
    if (IN(3)) gemm_job<3, 2048, 2048>(lds, a, WS_AB, WS_WM, G, bid, wid);
    SEAM(3);
    if (IN(4)) gemm_job<4, 2048, 2048>(lds, a, WS_MERGED, WS_WO, G, bid, wid);
    SEAM(4);
    if (IN(5)) resnorm_rows<true>(a, gw, NGW, fresh_lane());
    SEAM(5);
    if (IN(6)) {
        gemm_job<6, 2 * DFF, 2048>(lds, a, WS_H, WS_WUP, G, bid, wid);
        constexpr int NFULL = (MP / 256) * (2 * DFF / 256) % 256;
        const int first = (G == 256) ? NFULL : 0;
        if (bid >= first) {
            late_weights<2>(a, lds, (bid - first) * 8 + wid, (G - first) * 8, wid);
            __syncthreads();
            gemm_job<9, 2048, PLE>(lds, a, WS_PB, WS_WP, G - first, bid - first, wid);
        }
    }
    SEAM(6);
    if (IN(7)) { for (int it = gw; it < (128 + MS) * 11; it += NGW) ffnfix_item(a, it, fresh_lane()); }
    SEAM(7);
    if (IN(8)) gemm_job<8, 2048, DFF>(lds, a, WS_FIN, WS_WDN, G, bid, wid);
    SEAM(8);
    if (IN(9)) resnorm_rows<false>(a, gw, NGW, fresh_lane());
    SEAM(9);
    if (IN(10)) gemm_job<10, 2048, 2048>(lds, a, WS_H, WS_WG, G, bid, wid);
#undef IN
#undef SEAM
}

extern "C" void kernel_launch(void* const* d_in, const int* in_sizes, int n_in, void* d_out, int out_size, void* d_ws, size_t ws_size, hipStream_t stream) {
    static int grid = 0;
    if (grid == 0) {
        if (n_in != 25 || ws_size < WS_END) { fprintf(stderr, "kernel_launch: unexpected n_in %d / ws_size %zu\n", n_in, ws_size); grid = -1; return; }
        int dev = 0, cus = 0, per_cu = 0;
        if (hipGetDevice(&dev) != hipSuccess || hipDeviceGetAttribute(&cus, hipDeviceAttributeMultiprocessorCount, dev) != hipSuccess) { grid = -1; return; }
        if (hipOccupancyMaxActiveBlocksPerMultiprocessor(&per_cu, (const void*)hybrid_fwd, 512, 0) != hipSuccess || per_cu < 1) { fprintf(stderr, "kernel_launch: occupancy query says %d\n", per_cu); per_cu = 1; }
        (void)hipGetLastError();
        grid = cus;
    }
    if (grid < 0) return;
    if (hipMemsetAsync(d_ws, 0, 16384, stream) != hipSuccess) { fprintf(stderr, "kernel_launch: memset failed\n"); return; }
    Args a{};
    for (int i = 0; i < 25; ++i) a.in[i] = (const float*)d_in[i];
    a.out = (float*)d_out; a.ws = (unsigned char*)d_ws;
#if MK_N_LAUNCHES == 1
    a.ph_lo = 0; a.ph_hi = NPHASE;
    void* kargs[] = {&a};
    hipError_t e = hipLaunchCooperativeKernel((const void*)hybrid_fwd, dim3(grid), dim3(512), kargs, 0, stream);
    if (e != hipSuccess) fprintf(stderr, "cooperative launch failed: %s (grid %d)\n", hipGetErrorString(e), grid);
#else
#ifdef PROBE_PHASE
    for (int ph = 0; ph <= PROBE_PHASE; ++ph) { a.ph_lo = ph; a.ph_hi = ph + 1; hipLaunchKernelGGL(hybrid_fwd, dim3(grid), dim3(512), 0, stream, a); }
    a.ph_lo = 100; a.ph_hi = 101; hipLaunchKernelGGL(hybrid_fwd, dim3(grid), dim3(512), 0, stream, a);
#else
    for (int ph = 0; ph < NPHASE; ++ph) {
        a.ph_lo = ph; a.ph_hi = ph + 1;
        for (int rep = 0; rep < 1 + ((REPMASK >> ph) & 1); ++rep)
            hipLaunchKernelGGL(hybrid_fwd, dim3(grid), dim3(512), 0, stream, a);
    }
#endif
#endif
}
```

```cpp
#include <hip/hip_runtime.h>
#include <hip/hip_cooperative_groups.h>
#include <cstdio>
#include <cstdint>
namespace cg = cooperative_groups;


#ifndef MK_N_LAUNCHES
#define MK_N_LAUNCHES 1
#define REPMASK 0x00
#endif

#define LAS __attribute__((address_space(3)))
#define GAS __attribute__((address_space(1)))
typedef unsigned short bf16_t;
typedef short bf16x8 __attribute__((ext_vector_type(8)));
typedef float f32x4 __attribute__((ext_vector_type(4)));
typedef float f32x16 __attribute__((ext_vector_type(16)));
typedef unsigned u32x4 __attribute__((ext_vector_type(4)));
typedef unsigned u32x2 __attribute__((ext_vector_type(2)));

constexpr int DM = 2048, SEQ = 4096, MP = 8192, MS = 32, MT = MP + MS;
constexpr int DFF = 5632, INC = 8448, CW = 1024, PLE = 256;
constexpr int P1C = 4352;
constexpr int C_K = 1024, C_V = 1152, C_CB = 1280, C_CC = 2304, C_CU = 3328;
constexpr float EPS = 1e-6f;
constexpr size_t O_YP = 0, O_YS = 16777216, O_KP = 16842752, O_VP = 16875520, O_CP = 16908288, O_FP = 16912384,
                 O_KS = 16934912, O_VS = 17459200, O_CS = 17983488, O_FS = 18049024;
constexpr size_t MiB = 1u << 20;
constexpr size_t WS_ROPE = 1 * MiB;
constexpr size_t WS_WIN = 4 * MiB, WS_WM = 37 * MiB, WS_WO = 45 * MiB, WS_WUP = 53 * MiB, WS_WDN = 97 * MiB, WS_WG = 119 * MiB, WS_WP = 127 * MiB;
constexpr size_t WS_H = 128 * MiB;
constexpr size_t WS_R = 161 * MiB;
constexpr size_t WS_PROJ1 = WS_R, WS_PROJ2 = 230 * MiB, WS_AB = 295 * MiB;
constexpr size_t WS_MERGED = WS_R, WS_MO = 230 * MiB;
constexpr size_t WS_SA = 4 * MiB;
constexpr size_t WS_SG = 10 * MiB;
constexpr size_t WS_UAS = 13 * MiB, WS_UGS = 13 * MiB + 512 * 1024;
constexpr size_t WS_PP = 16 * MiB;
constexpr size_t WS_FIN = WS_R;
constexpr size_t WS_F = 250 * MiB;
constexpr size_t WS_X1B = 295 * MiB;
constexpr size_t WS_PB = 340 * MiB;
constexpr size_t WS_END = 345 * MiB;
constexpr int LDS_BYTES = 147456;
constexpr int NPHASE = 11;

struct Args { const float* in[25]; float* out; unsigned char* ws; int ph_lo, ph_hi; };

typedef float f32x2_t __attribute__((ext_vector_type(2)));
typedef __bf16 bf16x2_t __attribute__((ext_vector_type(2)));
__device__ __forceinline__ unsigned cvt_pk_bf16(float lo, float hi) { const f32x2_t v = {lo, hi}; const bf16x2_t b = __builtin_convertvector(v, bf16x2_t); return __builtin_bit_cast(unsigned, b); }
__device__ __forceinline__ float bflo(unsigned w) { return __uint_as_float(w << 16); }
__device__ __forceinline__ float bfhi(unsigned w) { return __uint_as_float(w & 0xffff0000u); }
__device__ __forceinline__ float bf1(bf16_t b) { return __uint_as_float(((unsigned)b) << 16); }
__device__ __forceinline__ void unpack8(u32x4 w, float* f) { f[0] = bflo(w.x); f[1] = bfhi(w.x); f[2] = bflo(w.y); f[3] = bfhi(w.y); f[4] = bflo(w.z); f[5] = bfhi(w.z); f[6] = bflo(w.w); f[7] = bfhi(w.w); }
__device__ __forceinline__ u32x4 pack8(f32x4 lo, f32x4 hi) { u32x4 w; w.x = cvt_pk_bf16(lo[0], lo[1]); w.y = cvt_pk_bf16(lo[2], lo[3]); w.z = cvt_pk_bf16(hi[0], hi[1]); w.w = cvt_pk_bf16(hi[2], hi[3]); return w; }
__device__ __forceinline__ u32x4 pack8a(const float* f) { u32x4 w; w.x = cvt_pk_bf16(f[0], f[1]); w.y = cvt_pk_bf16(f[2], f[3]); w.z = cvt_pk_bf16(f[4], f[5]); w.w = cvt_pk_bf16(f[6], f[7]); return w; }
__device__ __forceinline__ int fresh_lane() { int l; asm volatile("v_mbcnt_lo_u32_b32 %0, -1, 0\n\tv_mbcnt_hi_u32_b32 %0, -1, %0" : "=v"(l)); return l; }
#define NTL(p) __builtin_nontemporal_load(p)
__device__ __forceinline__ float wave_sum(float v) {
#pragma unroll
    for (int o = 1; o < 64; o <<= 1) v += __shfl_xor(v, o);
    return v;
}
__device__ __forceinline__ float wave_max(float v) {
#pragma unroll
    for (int o = 1; o < 64; o <<= 1) v = fmaxf(v, __shfl_xor(v, o));
    return v;
}
__device__ __forceinline__ float rcpf_(float x) { return __builtin_amdgcn_rcpf(x); }
__device__ __forceinline__ float sigm(float x) { return rcpf_(1.f + __expf(-x)); }
__device__ __forceinline__ float gelu_tanh(float x) { const float u = 0.7978845608028654f * (x + 0.044715f * x * x * x); return x * rcpf_(1.f + __expf(-2.f * u)); }
__device__ __forceinline__ const GAS float* x_row(const Args& a, int row) {
    return row < MP ? (const GAS float*)a.in[0] + (size_t)row * DM : (const GAS float*)a.in[1] + (size_t)(row - MP) * DM;
}

__device__ __forceinline__ void load_gates(const Args& a, int row, int col0, float* ea, float* eb) {
    const GAS bf16_t* p2 = (const GAS bf16_t*)(a.ws + WS_PROJ2) + (size_t)row * 4096 + col0;
    const u32x4 wa = *(const GAS u32x4*)p2, wb = *(const GAS u32x4*)(p2 + 2048);
    const GAS float* bg = (const GAS float*)a.in[17] + col0;
    const f32x4 b0l = *(const GAS f32x4*)bg, b0h = *(const GAS f32x4*)(bg + 4), b1l = *(const GAS f32x4*)(bg + 2048), b1h = *(const GAS f32x4*)(bg + 2052);
    float ga[8], gb[8]; unpack8(wa, ga); unpack8(wb, gb);
#pragma unroll
    for (int e = 0; e < 4; ++e) {
        ea[e] = fminf(__expf(-(ga[e] + b0l[e])), 1e30f); ea[e + 4] = fminf(__expf(-(ga[e + 4] + b0h[e])), 1e30f);
        eb[e] = fminf(__expf(-(gb[e] + b1l[e])), 1e30f); eb[e + 4] = fminf(__expf(-(gb[e + 4] + b1h[e])), 1e30f);
    }
}

template <int MODE>
__device__ __forceinline__ void epi8(const Args& a, int row, int col0, f32x4 lo, f32x4 hi) {
    unsigned char* ws = a.ws;
    if constexpr (MODE == 1) {
        GAS bf16_t* p = col0 < P1C ? (GAS bf16_t*)(ws + WS_PROJ1) + (size_t)row * P1C + col0 : (GAS bf16_t*)(ws + WS_PROJ2) + (size_t)row * 4096 + (col0 - P1C);
        *(GAS u32x4*)p = pack8(lo, hi);
    } else if constexpr (MODE == 3) {
        float ea[8], eb[8]; load_gates(a, row, col0, ea, eb);
#pragma unroll
        for (int e = 0; e < 4; ++e) { lo[e] = lo[e] * rcpf_(1.f + eb[e]); hi[e] = hi[e] * rcpf_(1.f + eb[e + 4]); }
        *(GAS u32x4*)((GAS bf16_t*)(ws + WS_MERGED) + (size_t)row * DM + col0) = pack8(lo, hi);
    } else if constexpr (MODE == 30) {
        *(GAS u32x4*)((GAS bf16_t*)(ws + WS_MERGED) + (size_t)row * DM + col0) = pack8(lo, hi);
    } else if constexpr (MODE == 4) {
        *(GAS u32x4*)((GAS bf16_t*)(ws + WS_MO) + (size_t)row * DM + col0) = pack8(lo, hi);
    } else if constexpr (MODE == 6) {
        const int ch = (col0 >> 8) * 128 + (col0 & 127);
        if (((col0 >> 7) & 1) == 0) {
            *(GAS u32x4*)((GAS bf16_t*)(ws + WS_UAS) + (size_t)(row - MP) * DFF + ch) = pack8(lo, hi);
            GAS float* o = (GAS float*)a.out + O_FS + (size_t)((row - MP) * 2 + 1) * DFF + ch; *(GAS f32x4*)o = lo; *(GAS f32x4*)(o + 4) = hi;
        } else {
            *(GAS u32x4*)((GAS bf16_t*)(ws + WS_UGS) + (size_t)(row - MP) * DFF + ch) = pack8(lo, hi);
        }
    } else if constexpr (MODE == 8) {
        *(GAS u32x4*)((GAS bf16_t*)(ws + WS_F) + (size_t)row * DM + col0) = pack8(lo, hi);
    } else if constexpr (MODE == 9) {
        *(GAS u32x4*)((GAS bf16_t*)(ws + WS_PP) + (size_t)row * DM + col0) = pack8(lo, hi);
    } else if constexpr (MODE == 10) {
        GAS float* o = (GAS float*)a.out + (size_t)row * DM + col0;
        const u32x4 xw = *(const GAS u32x4*)((const GAS bf16_t*)(ws + WS_H) + (size_t)row * DM + col0);
        const u32x4 pw = NTL((const GAS u32x4*)((const GAS bf16_t*)(ws + WS_PP) + (size_t)row * DM + col0));
        float pp[8], xx[8]; unpack8(pw, pp); unpack8(xw, xx); f32x4 y0, y1;
#pragma unroll
        for (int e = 0; e < 4; ++e) { y0[e] = xx[e] + sigm(lo[e]) * pp[e]; y1[e] = xx[e + 4] + sigm(hi[e]) * pp[e + 4]; }
        *(GAS f32x4*)o = y0; *(GAS f32x4*)(o + 4) = y1;
    }
}

__device__ __forceinline__ void glds_s(const char* sbase, unsigned voff, unsigned lds_dst) {
    unsigned keep;
    asm volatile("s_mov_b32 %0, m0\n\ts_mov_b32 m0, %3\n\ts_nop 0\n\tglobal_load_lds_dwordx4 %1, %2\n\ts_mov_b32 m0, %0" : "=&s"(keep) : "v"(voff), "s"(sbase), "s"(lds_dst) : "memory");
}
namespace pg8 {
constexpr int BM = 256, BK = 64, HALF = 128, HTB = HALF * BK * 2, STAGE_BYTES = 8 * HTB, NXCD = 8, WGM = 8;
__host__ __device__ __forceinline__ int lds_byte(int r, int c) { const int st = (r >> 4) * 2 + (c >> 5), rr = r & 15, cc = c & 31, ob = rr * 64 + cc * 2; return st * 1024 + (ob ^ (((ob >> 9) & 1) << 5)); }
__host__ __device__ __forceinline__ void stage_rc(int b, int& R, int& C) { const int st = b / 1024, sb = b % 1024, swz = sb ^ (((sb >> 9) & 1) << 5); R = (st >> 1) * 16 + swz / 64; C = (st & 1) * 32 + (swz % 64) / 2; }
__host__ __device__ __forceinline__ int perm32(int rho) { const int n = rho >> 4, i = rho & 15; return 8 * (i >> 2) + 4 * n + (i & 3); }
struct Unit { int pm, pn; };
struct StaticOrder {
    int nM, nN, nwg, G, c;
    __device__ void init(int M, int N, int G_, int c_) { nM = M / BM; nN = N / BM; nwg = nM * nN; G = G_; c = c_; }
    __device__ bool next(int i, Unit& u) const {
        const long L = (long)i * G + c; if (L >= nwg) return false;
        int wgid = (int)L; { const int q = nwg / NXCD, r = nwg % NXCD, xcd = wgid % NXCD, off = wgid / NXCD; wgid = (xcd < r ? xcd * (q + 1) : r * (q + 1) + (xcd - r) * q) + off; }
        const int nig = WGM * nN, gid = wgid / nig, fm = gid * WGM, gsz = (nM - fm) < WGM ? (nM - fm) : WGM;
        u.pm = fm + ((wgid % nig) % gsz); u.pn = (wgid % nig) / gsz; return true;
    }
};

template <int MODE>
__device__ __forceinline__ void tile_epi(const Args& a, const f32x4 (&acc)[2][2][4][2], const Unit& u, int wr, int wc, int fr, int fq) {
#pragma unroll
    for (int ai = 0; ai < 2; ++ai)
#pragma unroll
        for (int m = 0; m < 4; ++m)
#pragma unroll
            for (int bj = 0; bj < 2; ++bj)
                epi8<MODE>(a, u.pm * BM + ai * HALF + wr * 64 + m * 16 + fr, u.pn * BM + bj * HALF + wc * 32 + 8 * fq, acc[ai][bj][m][0], acc[ai][bj][m][1]);
}
template <int CTRL> __device__ __forceinline__ float dppf(float old, float src) {
    return __int_as_float(__builtin_amdgcn_update_dpp(__float_as_int(old), __float_as_int(src), CTRL, 0xf, 0xf, false));
}
__device__ __forceinline__ void tile_epi6(const Args& a, const f32x4 (&acc)[2][2][4][2], const Unit& u, int wr, int wc, int fr, int fq) {
    const int ch0 = u.pn * 128 + wc * 32 + 8 * fq;
    const GAS float* cw = (const GAS float*)a.in[20] + ch0; const GAS float* cbp = (const GAS float*)a.in[21] + ch0;
    float w0[8], w1[8], w2[8], bb[8];
    { const f32x4 a0 = *(const GAS f32x4*)cw, a1 = *(const GAS f32x4*)(cw + 4), b0 = *(const GAS f32x4*)(cw + DFF), b1 = *(const GAS f32x4*)(cw + DFF + 4), c0v = *(const GAS f32x4*)(cw + 2 * DFF), c1v = *(const GAS f32x4*)(cw + 2 * DFF + 4),
                  d0 = *(const GAS f32x4*)cbp, d1 = *(const GAS f32x4*)(cbp + 4);
#pragma unroll
      for (int e = 0; e < 4; ++e) { w0[e] = a0[e]; w0[e + 4] = a1[e]; w1[e] = b0[e]; w1[e + 4] = b1[e]; w2[e] = c0v[e]; w2[e + 4] = c1v[e]; bb[e] = d0[e]; bb[e + 4] = d1[e]; } }
    GAS bf16_t* FIN = (GAS bf16_t*)(a.ws + WS_FIN); GAS bf16_t* SA = (GAS bf16_t*)(a.ws + WS_SA); GAS bf16_t* SG = (GAS bf16_t*)(a.ws + WS_SG);
#pragma unroll
    for (int ai = 0; ai < 2; ++ai)
#pragma unroll
        for (int m = 0; m < 4; ++m) {
            const int row = u.pm * BM + ai * HALF + wr * 64 + m * 16 + fr, grp = row >> 6;
            float ov[8];
#pragma unroll
            for (int n = 0; n < 2; ++n)
#pragma unroll
                for (int e = 0; e < 4; ++e) {
                    const float cur = acc[ai][0][m][n][e];
                    float r1 = 0.f, r2 = 0.f;
                    if (m > 0) { const float pv = acc[ai][0][m > 0 ? m - 1 : 0][n][e]; r1 = dppf<0x121>(0.f, pv); r2 = dppf<0x122>(0.f, pv); }
                    const float p1 = dppf<0x111>(r1, cur), p2 = dppf<0x112>(r2, cur);
                    const int k = 4 * n + e;
                    ov[k] = gelu_tanh(w0[k] * p2 + w1[k] * p1 + w2[k] * cur + bb[k]) * acc[ai][1][m][n][e];
                }
            if (m == 0 && fr < 2) {
                *(GAS u32x4*)(SA + ((size_t)grp * 4 + 2 + fr) * DFF + ch0) = pack8(acc[ai][0][m][0], acc[ai][0][m][1]);
                *(GAS u32x4*)(SG + ((size_t)grp * 2 + fr) * DFF + ch0) = pack8(acc[ai][1][m][0], acc[ai][1][m][1]);
            } else {
                *(GAS u32x4*)(FIN + (size_t)row * DFF + ch0) = pack8a(ov);
            }
            if (m == 3 && fr >= 14) {
                *(GAS u32x4*)(SA + ((size_t)grp * 4 + (fr - 14)) * DFF + ch0) = pack8(acc[ai][0][m][0], acc[ai][0][m][1]);
                const int t = row & (SEQ - 1);
                if (t >= SEQ - 2) { GAS float* o = (GAS float*)a.out + O_FP + (size_t)((row >> 12) * 2 + (t - (SEQ - 2))) * DFF + ch0; *(GAS f32x4*)o = acc[ai][0][m][0]; *(GAS f32x4*)(o + 4) = acc[ai][0][m][1]; }
            }
        }
}
__device__ __forceinline__ void mid_scale(const Args& a, f32x4 (&acc)[2][2][4][2], const Unit& u, int wr, int wc, int fr, int fq) {
    int z = 0; asm volatile("" : "+v"(z));
    fr += z;
#pragma unroll
    for (int ai = 0; ai < 2; ++ai)
#pragma unroll
        for (int m = 0; m < 4; ++m)
#pragma unroll
            for (int bj = 0; bj < 2; ++bj) {
                float ea[8], eb[8]; load_gates(a, u.pm * BM + ai * HALF + wr * 64 + m * 16 + fr, u.pn * BM + bj * HALF + wc * 32 + 8 * fq, ea, eb);
#pragma unroll
                for (int e = 0; e < 4; ++e) { acc[ai][bj][m][0][e] *= (1.f + eb[e]) * rcpf_(1.f + ea[e]); acc[ai][bj][m][1][e] *= (1.f + eb[e + 4]) * rcpf_(1.f + ea[e + 4]); }
                __builtin_amdgcn_sched_barrier(0);
            }
}

template <int MODE, int N, int K>
__device__ __forceinline__ void gemm_phase(LAS unsigned char* lds, const Args& args, const bf16_t* gA, const bf16_t* gBt, int G, int bid, int wid_in) {
    const int wid = wid_in, lane = fresh_lane(), tid = wid * 64 + lane, wr = wid >> 2, wc = wid & 3, fr = lane & 15, fq = lane >> 4;
    const int nt = K / BK;
    StaticOrder S; S.init(MP, N, G, bid);
    unsigned voffA, voffB;
    { int R, C; stage_rc(tid * 16, R, C); const int Rb = (R & ~31) + perm32(R & 31); voffA = (unsigned)(R * K + C) * 2u; voffB = (unsigned)(Rb * K + C) * 2u; }
    const unsigned ldsbase = (unsigned)(size_t)lds;
    const size_t kstep = (size_t)(BK * 2);
    const size_t hstep = (size_t)HALF * K * 2;
    const size_t tstep = 2 * hstep;
    const unsigned ldsw = (unsigned)wid * 1024u;
    const int aoff = lds_byte(wr * 64 + fr, fq * 8), boff = lds_byte(wc * 32 + fr, fq * 8);
#define PG8_SA(b, h) (((b) * 2 + (h)) * HTB)
#define PG8_SB(b, h) ((4 + (b) * 2 + (h)) * HTB)
#define PG8_STAGE(bufoff, gbase, voff) do { glds_s((const char*)(gbase), (voff), ldsbase + (unsigned)(bufoff) + ldsw); \
        glds_s((const char*)(gbase) + (size_t)64 * K * 2, (voff), ldsbase + (unsigned)(bufoff) + ldsw + 8192u); } while (0)
#define PG8_LDA(dst, b, h) do { _Pragma("unroll") for (int m = 0; m < 4; ++m) _Pragma("unroll") for (int k = 0; k < 2; ++k) dst[m][k] = *(const LAS bf16x8*)(lds + PG8_SA(b, h) + aoff + m * 2048 + k * 1024); } while (0)
#define PG8_LDB(dst, b, h) do { _Pragma("unroll") for (int n = 0; n < 2; ++n) _Pragma("unroll") for (int k = 0; k < 2; ++k) dst[n][k] = *(const LAS bf16x8*)(lds + PG8_SB(b, h) + boff + n * 2048 + k * 1024); } while (0)
#define PG8_MMA(ai, bj, At, Bt) do { __builtin_amdgcn_s_setprio(1); _Pragma("unroll") for (int m = 0; m < 4; ++m) _Pragma("unroll") for (int n = 0; n < 2; ++n) _Pragma("unroll") for (int k = 0; k < 2; ++k) \
        acc[ai][bj][m][n] = __builtin_amdgcn_mfma_f32_16x16x32_bf16(Bt[n][k], At[m][k], acc[ai][bj][m][n], 0, 0, 0); __builtin_amdgcn_s_setprio(0); } while (0)
#define PG8_WAIT_V(n) asm volatile("s_waitcnt vmcnt(" #n ")" ::: "memory")
#define PG8_WAIT_L(n) asm volatile("s_waitcnt lgkmcnt(" #n ")" ::: "memory")
#define PG8_BAR __builtin_amdgcn_s_barrier()
#define PG8_SCHED __builtin_amdgcn_sched_barrier(0)
    Unit cur, nxt; int ui = 0;
    if (!S.next(0, cur)) return;
    f32x4 acc[2][2][4][2];
#pragma unroll
    for (int a = 0; a < 2; ++a)
#pragma unroll
        for (int b = 0; b < 2; ++b)
#pragma unroll
            for (int m = 0; m < 4; ++m)
#pragma unroll
                for (int n = 0; n < 2; ++n) acc[a][b][m][n] = (f32x4){0.f, 0.f, 0.f, 0.f};
    bf16x8 At[4][2], B0[2][2], B1[2][2];
    const char* cA = (const char*)gA + (size_t)cur.pm * tstep; const char* cB = (const char*)gBt + (size_t)cur.pn * tstep;
    PG8_STAGE(PG8_SB(0, 0), cB, voffB); PG8_STAGE(PG8_SB(0, 1), cB + hstep, voffB); PG8_STAGE(PG8_SA(0, 0), cA, voffA); PG8_STAGE(PG8_SA(0, 1), cA + hstep, voffA);
    if (wr == 1) PG8_BAR;
    PG8_WAIT_V(2); PG8_BAR;
    PG8_STAGE(PG8_SB(1, 0), cB + kstep, voffB); PG8_STAGE(PG8_SA(1, 0), cA + kstep, voffA); PG8_STAGE(PG8_SB(1, 1), cB + hstep + kstep, voffB);
    PG8_WAIT_V(6); PG8_BAR;
    for (;;) {
        const bool has_next = S.next(ui + 1, nxt);
        const char* nA = has_next ? (const char*)gA + (size_t)nxt.pm * tstep : cA; const char* nB = has_next ? (const char*)gBt + (size_t)nxt.pn * tstep : cB;
        for (int t = 0; t < nt; t += 2) {
            const bool last = (t == nt - 2);
            const char* a1 = cA + (size_t)(t + 1) * kstep;
            const char* a2 = last ? nA : cA + (size_t)(t + 2) * kstep; const char* b2 = last ? nB : cB + (size_t)(t + 2) * kstep;
            const char* a3 = a2 + kstep; const char* b3 = b2 + kstep;
            if constexpr (MODE == 3) { if (t == (nt >> 1)) { mid_scale(args, acc, cur, wr, wc, fr, fq); PG8_SCHED; } }
            PG8_LDB(B0, 0, 0); PG8_LDB(B1, 0, 1); PG8_SCHED; PG8_LDA(At, 0, 0); PG8_STAGE(PG8_SA(1, 1), a1 + hstep, voffA);
            PG8_WAIT_V(8); PG8_WAIT_L(0); PG8_BAR; PG8_MMA(0, 0, At, B0); PG8_MMA(0, 1, At, B1); PG8_BAR; PG8_SCHED;
            PG8_LDA(At, 0, 1); PG8_STAGE(PG8_SB(0, 0), b2, voffB); PG8_STAGE(PG8_SB(0, 1), b2 + hstep, voffB); PG8_STAGE(PG8_SA(0, 0), a2, voffA);
            PG8_WAIT_V(8); PG8_WAIT_L(0); PG8_BAR; PG8_MMA(1, 0, At, B0); PG8_MMA(1, 1, At, B1); PG8_BAR; PG8_SCHED;
            PG8_LDB(B0, 1, 0); PG8_LDB(B1, 1, 1); PG8_SCHED; PG8_LDA(At, 1, 0); PG8_STAGE(PG8_SA(0, 1), a2 + hstep, voffA);
            PG8_WAIT_V(8); PG8_WAIT_L(0); PG8_BAR; PG8_MMA(0, 0, At, B0); PG8_MMA(0, 1, At, B1); PG8_BAR; PG8_SCHED;
            PG8_LDA(At, 1, 1); PG8_STAGE(PG8_SB(1, 0), b3, voffB); PG8_STAGE(PG8_SB(1, 1), b3 + hstep, voffB); PG8_STAGE(PG8_SA(1, 0), a3, voffA);
            PG8_WAIT_V(8); PG8_WAIT_L(0); PG8_BAR; PG8_MMA(1, 0, At, B0); PG8_MMA(1, 1, At, B1); PG8_BAR; PG8_SCHED;
        }
        if (wr == 0) PG8_BAR;
        if constexpr (MODE == 6) tile_epi6(args, acc, cur, wr, wc, fr, fq); else tile_epi<MODE>(args, acc, cur, wr, wc, fr, fq);
        if (!has_next) break;
#pragma unroll
        for (int a = 0; a < 2; ++a)
#pragma unroll
            for (int b = 0; b < 2; ++b)
#pragma unroll
                for (int m = 0; m < 4; ++m)
#pragma unroll
                    for (int n = 0; n < 2; ++n) acc[a][b][m][n] = (f32x4){0.f, 0.f, 0.f, 0.f};
        cur = nxt; cA = nA; cB = nB; ++ui;
        if (wr == 1) PG8_BAR;
    }
    PG8_WAIT_V(0);
    PG8_BAR;
#undef PG8_SA
#undef PG8_SB
#undef PG8_STAGE
#undef PG8_LDA
#undef PG8_LDB
#undef PG8_MMA
#undef PG8_WAIT_V
#undef PG8_WAIT_L
#undef PG8_BAR
#undef PG8_SCHED
}
}

template <int MODE, int N, int K>
__device__ __forceinline__ void skinny_gemm(LAS unsigned char* lds, const Args& args, const bf16_t* A, const bf16_t* Bt, int G, int bid, int wid_in) {
    const int wid = wid_in, lane = fresh_lane(), tid = wid * 64 + lane, fr = lane & 15, fq = lane >> 4;
    LAS float* P = (LAS float*)lds;
    constexpr int nitems = N / 16, kw = K / 8, NS = kw / 32;
    constexpr int GRP = (NS % 11 == 0) ? 11 : ((NS % 8 == 0) ? 8 : NS);
    static_assert(kw % 32 == 0 && NS % GRP == 0, "skinny K split");
    for (int it = G - 1 - bid; it < nitems; it += G) {
        const int n0 = it * 16;
        const GAS bf16_t* ap = (const GAS bf16_t*)A + (size_t)fr * K + wid * kw + 8 * fq;
        const GAS bf16_t* bp = (const GAS bf16_t*)Bt + (size_t)(n0 + fr) * K + wid * kw + 8 * fq;
        f32x4 acc0 = {0.f, 0.f, 0.f, 0.f}, acc1 = acc0;
#pragma unroll 1
        for (int g = 0; g < NS; g += GRP) {
            bf16x8 a0[GRP], a1[GRP], bv[GRP];
#pragma unroll
            for (int i = 0; i < GRP; ++i) { const int k = (g + i) * 32; a0[i] = *(const GAS bf16x8*)(ap + k); a1[i] = *(const GAS bf16x8*)(ap + (size_t)16 * K + k); bv[i] = *(const GAS bf16x8*)(bp + k); }
#pragma unroll
            for (int i = 0; i < GRP; ++i) { acc0 = __builtin_amdgcn_mfma_f32_16x16x32_bf16(a0[i], bv[i], acc0, 0, 0, 0); acc1 = __builtin_amdgcn_mfma_f32_16x16x32_bf16(a1[i], bv[i], acc1, 0, 0, 0); }
        }
#pragma unroll
        for (int j = 0; j < 4; ++j) { P[(wid * 32 + 4 * fq + j) * 17 + fr] = acc0[j]; P[(wid * 32 + 16 + 4 * fq + j) * 17 + fr] = acc1[j]; }
        __syncthreads();
        if (tid < 64) {
            const int r = tid >> 1, c0 = (tid & 1) * 8;
            f32x4 l0 = {0.f, 0.f, 0.f, 0.f}, h0 = l0, l1 = l0, h1 = l0;
#pragma unroll
            for (int w = 0; w < 4; ++w)
#pragma unroll
                for (int e = 0; e < 4; ++e) {
                    l0[e] += P[(w * 32 + r) * 17 + c0 + e]; h0[e] += P[(w * 32 + r) * 17 + c0 + 4 + e];
                    l1[e] += P[((w + 4) * 32 + r) * 17 + c0 + e]; h1[e] += P[((w + 4) * 32 + r) * 17 + c0 + 4 + e];
                }
            const int row = MP + r, col0 = n0 + c0;
            if constexpr (MODE == 3) {
                float ea[8], eb[8]; load_gates(args, row, col0, ea, eb); f32x4 lo, hi;
#pragma unroll
                for (int e = 0; e < 4; ++e) { lo[e] = l0[e] * rcpf_(1.f + ea[e]) + l1[e] * rcpf_(1.f + eb[e]); hi[e] = h0[e] * rcpf_(1.f + ea[e + 4]) + h1[e] * rcpf_(1.f + eb[e + 4]); }
                epi8<30>(args, row, col0, lo, hi);
            } else {
                epi8<MODE>(args, row, col0, l0 + l1, h0 + h1);
            }
        }
        __syncthreads();
    }
}

__device__ __forceinline__ void p0_transpose_item(const GAS float* W, int K, int N, GAS bf16_t* WT, int ldt, int k_off, int up_mode, LAS float* scr, int item, int lane) {
    const int nblk = N / 32, kb = item / nblk, nb = item % nblk, k0 = 64 * kb, n0 = 32 * nb;
    int rowbase = n0;
    if (up_mode) rowbase = n0 < DFF ? (n0 >> 7) * 256 + (n0 & 127) : ((n0 - DFF) >> 7) * 256 + 128 + ((n0 - DFF) & 127);
    {
        const int r8 = lane >> 3, c4 = (lane & 7) * 4;
        f32x4 v[8];
#pragma unroll
        for (int i = 0; i < 8; ++i) v[i] = __builtin_nontemporal_load((const GAS f32x4*)(W + (size_t)(k0 + 8 * i + r8) * N + n0 + c4));
#pragma unroll
        for (int i = 0; i < 8; ++i) { LAS float* d = scr + (8 * i + r8) * 33 + c4; d[0] = v[i].x; d[1] = v[i].y; d[2] = v[i].z; d[3] = v[i].w; }
    }
    asm volatile("s_waitcnt lgkmcnt(0)" ::: "memory");
    const int c = lane & 7;
#pragma unroll
    for (int j = 0; j < 4; ++j) { const int n = (lane >> 3) + 8 * j; const LAS float* s = scr + (8 * c) * 33 + n;
        u32x4 o; o.x = cvt_pk_bf16(s[0 * 33], s[1 * 33]); o.y = cvt_pk_bf16(s[2 * 33], s[3 * 33]); o.z = cvt_pk_bf16(s[4 * 33], s[5 * 33]); o.w = cvt_pk_bf16(s[6 * 33], s[7 * 33]);
        *(GAS u32x4*)(WT + (size_t)(rowbase + n) * ldt + k_off + k0 + 8 * c) = o; }
    asm volatile("s_waitcnt lgkmcnt(0)" ::: "memory");
}

template <int SET>
__device__ __forceinline__ void late_weights(const Args& a, LAS unsigned char* lds, int w0, int nw, int wid_in) {
    const int lane = fresh_lane();
    unsigned char* ws = a.ws;
    LAS float* scr = (LAS float*)(lds + wid_in * 16384);
    constexpr int I_BR = 16 * 64, I_O = 32 * 64, I_UP = 32 * 352, I_DN = 88 * 64, I_G = 32 * 64, I_P = 4 * 64;
    if constexpr (SET == 1) {
        for (int it = w0; it < 2 * I_BR + I_O + I_P + I_UP; it += nw) {
            int r = it;
            if (r < I_BR) { p0_transpose_item((const GAS float*)a.in[15], 1024, 2048, (GAS bf16_t*)(ws + WS_WM), 2048, 0, 0, scr, r, lane); continue; } r -= I_BR;
            if (r < I_BR) { p0_transpose_item((const GAS float*)a.in[16], 1024, 2048, (GAS bf16_t*)(ws + WS_WM), 2048, 1024, 0, scr, r, lane); continue; } r -= I_BR;
            if (r < I_O) { p0_transpose_item((const GAS float*)a.in[18], 2048, 2048, (GAS bf16_t*)(ws + WS_WO), 2048, 0, 0, scr, r, lane); continue; } r -= I_O;
            if (r < I_P) { p0_transpose_item((const GAS float*)a.in[23], PLE, 2048, (GAS bf16_t*)(ws + WS_WP), PLE, 0, 0, scr, r, lane); continue; } r -= I_P;
            p0_transpose_item((const GAS float*)a.in[19], 2048, 2 * DFF, (GAS bf16_t*)(ws + WS_WUP), 2048, 0, 1, scr, r, lane);
        }
    } else {
        for (int it = w0; it < I_DN + I_G; it += nw) {
            int r = it;
            if (r < I_DN) { p0_transpose_item((const GAS float*)a.in[22], DFF, 2048, (GAS bf16_t*)(ws + WS_WDN), DFF, 0, 0, scr, r, lane); continue; } r -= I_DN;
            p0_transpose_item((const GAS float*)a.in[24], 2048, 2048, (GAS bf16_t*)(ws + WS_WG), 2048, 0, 0, scr, r, lane);
        }
    }
}
__device__ __forceinline__ void p0_prologue(const Args& a, LAS unsigned char* lds, int bid, int G, int wid_in) {
    const int wid = wid_in, lane = fresh_lane(), tid = wid * 64 + lane;
    const int gw = bid * 8 + wid, NGW = G * 8, gtid = bid * 512 + tid, GT = G * 512;
    unsigned char* ws = a.ws;
    LAS float* scr = (LAS float*)(lds + wid * 16384);
    if (gw < MT) {
        f32x4 g[8];
        { const GAS f32x4* gp = (const GAS f32x4*)a.in[8] + lane;
#pragma unroll
          for (int j = 0; j < 8; ++j) g[j] = gp[64 * j]; }
        int m = gw; f32x4 v[8];
        { const GAS f32x4* xr = (const GAS f32x4*)x_row(a, m) + lane;
#pragma unroll
          for (int j = 0; j < 8; ++j) v[j] = NTL(xr + 64 * j); }
        for (;;) {
            const int mn = m + NGW; const bool has = mn < MT; const int mp = has ? mn : m;
            f32x4 nv[8];
            { const GAS f32x4* xr = (const GAS f32x4*)x_row(a, mp) + lane;
#pragma unroll
              for (int j = 0; j < 8; ++j) nv[j] = NTL(xr + 64 * j); }
            float s = 0.f;
#pragma unroll
            for (int j = 0; j < 8; ++j) s += (v[j].x * v[j].x + v[j].y * v[j].y) + (v[j].z * v[j].z + v[j].w * v[j].w);
            const float rstd = 1.f / sqrtf(wave_sum(s) * (1.f / DM) + EPS);
            GAS u32x2* o = (GAS u32x2*)((GAS bf16_t*)(ws + WS_H) + (size_t)m * DM) + lane;
#pragma unroll
            for (int j = 0; j < 8; ++j) { u32x2 w; w.x = cvt_pk_bf16(v[j].x * rstd * g[j].x, v[j].y * rstd * g[j].y); w.y = cvt_pk_bf16(v[j].z * rstd * g[j].z, v[j].w * rstd * g[j].w); o[64 * j] = w; }
            if (!has) break;
#pragma unroll
            for (int j = 0; j < 8; ++j) v[j] = nv[j];
            m = mn;
        }
    }
    constexpr int I_IN = 32 * 264;
    for (int it = gw; it < I_IN; it += NGW) p0_transpose_item((const GAS float*)a.in[12], 2048, INC, (GAS bf16_t*)(ws + WS_WIN), 2048, 0, 0, scr, it, lane);
    for (int i = gtid; i < MT * 32; i += GT) {
        const int row = i >> 5, c8 = (i & 31) * 8;
        const GAS float* src = row < MP ? (const GAS float*)a.in[6] + (size_t)row * PLE + c8 : (const GAS float*)a.in[7] + (size_t)(row - MP) * PLE + c8;
        const f32x4 lo = NTL((const GAS f32x4*)src), hi = NTL((const GAS f32x4*)(src + 4));
        *(GAS u32x4*)((GAS bf16_t*)(ws + WS_PB) + (size_t)row * PLE + c8) = pack8(lo, hi);
    }
    for (int i = gtid; i < 4097 * 32; i += GT) {
        const int pi = i >> 5, fi = i & 31; const int pos = pi < 4096 ? pi : 16384;
        double inv = 1.0; for (int k = 0; k < fi; ++k) inv *= 0.7498942093324559;
        const float ang = (float)pos * (float)inv;
        double f = (double)ang * 0.15915494309189535; f -= __builtin_rint(f);
        GAS float* o = (GAS float*)(ws + WS_ROPE) + (size_t)i * 2;
        o[0] = __builtin_amdgcn_cosf((float)f); o[1] = __builtin_amdgcn_sinf((float)f);
    }
    for (int i = gtid; i < MS * CW; i += GT) { const int b = i / CW, c = i % CW; ((GAS float*)a.out)[O_CS + (size_t)(b * 2) * CW + c] = ((const GAS float*)a.in[4])[(size_t)(b * 2 + 1) * CW + c]; }
    for (int i = gtid; i < MS * DFF; i += GT) { const int b = i / DFF, c = i % DFF; ((GAS float*)a.out)[O_FS + (size_t)(b * 2) * DFF + c] = ((const GAS float*)a.in[5])[(size_t)(b * 2 + 1) * DFF + c]; }
}

constexpr int QS = 72, VS = 280;
__device__ __forceinline__ void rope8r(const f32x4* t, const float* x1, const float* x2, float sc, float* o1, float* o2) {
    const float c[8] = {t[0].x, t[0].z, t[1].x, t[1].z, t[2].x, t[2].z, t[3].x, t[3].z}, s[8] = {t[0].y, t[0].w, t[1].y, t[1].w, t[2].y, t[2].w, t[3].y, t[3].w};
#pragma unroll
    for (int e = 0; e < 8; ++e) { o1[e] = (x1[e] * c[e] - x2[e] * s[e]) * sc; o2[e] = (x2[e] * c[e] + x1[e] * s[e]) * sc; }
}
struct AttnRegs { u32x4 q1[4], q2[4], kc1, kc2, kp1, kp2, vv[4]; f32x4 rq[4], rp[4]; };
__device__ __forceinline__ void attn_load(const Args& a, int u, int tid, AttnRegs& R) {
    const int hq = u & 1, kv = (u >> 1) & 1, j = (u >> 2) & 31, n = u >> 7, h0 = kv * 8 + hq * 4;
    const GAS bf16_t* P1 = (const GAS bf16_t*)(a.ws + WS_PROJ1);
    const GAS float* ROPE = (const GAS float*)(a.ws + WS_ROPE);
    const bool hasprev = j > 0;
    const int r = tid >> 2, g = tid & 3, posq = j * 128 + r, posp = hasprev ? posq - 128 : posq;
    const GAS bf16_t* rowq = P1 + (size_t)(n * SEQ + posq) * P1C;
    const GAS bf16_t* rowp = P1 + (size_t)(n * SEQ + posp) * P1C;
#pragma unroll
    for (int i = 0; i < 4; ++i) { R.q1[i] = NTL((const GAS u32x4*)(rowq + (h0 + i) * 64 + 8 * g)); R.q2[i] = NTL((const GAS u32x4*)(rowq + (h0 + i) * 64 + 32 + 8 * g)); }
    R.kc1 = *(const GAS u32x4*)(rowq + C_K + kv * 64 + 8 * g); R.kc2 = *(const GAS u32x4*)(rowq + C_K + kv * 64 + 32 + 8 * g);
    R.kp1 = *(const GAS u32x4*)(rowp + C_K + kv * 64 + 8 * g); R.kp2 = *(const GAS u32x4*)(rowp + C_K + kv * 64 + 32 + 8 * g);
    const GAS f32x4* rq = (const GAS f32x4*)(ROPE + (size_t)(posq * 32 + 8 * g) * 2);
    const GAS f32x4* rp = (const GAS f32x4*)(ROPE + (size_t)(posp * 32 + 8 * g) * 2);
#pragma unroll
    for (int i = 0; i < 4; ++i) { R.rq[i] = rq[i]; R.rp[i] = rp[i]; }
    const int vk = tid >> 3, dg = tid & 7;
#pragma unroll
    for (int ps = 0; ps < 4; ++ps) {
        const int c = ps * 64 + vk; const int pos = (ps < 2) ? (hasprev ? j * 128 - 128 + c : j * 128 + c) : j * 128 - 128 + c;
        R.vv[ps] = *(const GAS u32x4*)(P1 + (size_t)(n * SEQ + pos) * P1C + C_V + kv * 64 + 8 * dg);
    }
}
constexpr int QBUF = 128 * QS;
__device__ __forceinline__ void attn_write_q(LAS bf16_t* Qb, const AttnRegs& R, int i, int tid) {
    const int r = tid >> 2, g = tid & 3;
    float x1[8], x2[8], o1[8], o2[8];
    unpack8(R.q1[i], x1); unpack8(R.q2[i], x2); rope8r(R.rq, x1, x2, 0.125f, o1, o2);
    *(LAS u32x4*)(Qb + r * QS + 8 * g) = pack8a(o1); *(LAS u32x4*)(Qb + r * QS + 32 + 8 * g) = pack8a(o2);
}

__device__ __forceinline__ void attn_prompt_unit(const Args& a, LAS unsigned char* lds, int u, int wid_in) {
    const int wid = wid_in, lane = fresh_lane(), tid = wid * 64 + lane, fr = lane & 15, fq = lane >> 4;
    const int hq = u & 1, kv = (u >> 1) & 1, j = (u >> 2) & 31, n = u >> 7, h0 = kv * 8 + hq * 4;
    LAS bf16_t* Qs0 = (LAS bf16_t*)lds; LAS bf16_t* Ks = Qs0 + 2 * QBUF; LAS bf16_t* Vt = Ks + 256 * QS;
    const bool wr_state = (j == 31) && (hq == 0);
    const bool hasprev = j > 0;
    AttnRegs R; attn_load(a, u, tid, R);
    {
        const int r = tid >> 2, g = tid & 3, vk = tid >> 3, dg = tid & 7;
        float x1[8], x2[8], o1[8], o2[8];
        attn_write_q(Qs0, R, 0, tid);
        unpack8(R.kc1, x1); unpack8(R.kc2, x2); rope8r(R.rq, x1, x2, 1.f, o1, o2);
        if (wr_state) {
            GAS float* o = (GAS float*)a.out + O_KP + ((size_t)(n * 128 + r) * 2 + kv) * 64 + 8 * g;
            *(GAS f32x4*)o = (f32x4){o1[0], o1[1], o1[2], o1[3]}; *(GAS f32x4*)(o + 4) = (f32x4){o1[4], o1[5], o1[6], o1[7]};
            *(GAS f32x4*)(o + 32) = (f32x4){o2[0], o2[1], o2[2], o2[3]}; *(GAS f32x4*)(o + 36) = (f32x4){o2[4], o2[5], o2[6], o2[7]};
        }
        *(LAS u32x4*)(Ks + (128 + r) * QS + 8 * g) = pack8a(o1); *(LAS u32x4*)(Ks + (128 + r) * QS + 32 + 8 * g) = pack8a(o2);
        unpack8(R.kp1, x1); unpack8(R.kp2, x2); rope8r(R.rp, x1, x2, hasprev ? 1.f : 0.f, o1, o2);
        *(LAS u32x4*)(Ks + r * QS + 8 * g) = pack8a(o1); *(LAS u32x4*)(Ks + r * QS + 32 + 8 * g) = pack8a(o2);
#pragma unroll
        for (int ps = 0; ps < 4; ++ps) {
            const int c = ps * 64 + vk;
            u32x4 w = R.vv[ps];
            if (ps < 2 && !hasprev) w = (u32x4){0u, 0u, 0u, 0u};
            const unsigned ww[4] = {w.x, w.y, w.z, w.w};
#pragma unroll
            for (int e = 0; e < 4; ++e) { Vt[(8 * dg + 2 * e) * VS + c] = (bf16_t)(ww[e] & 0xffffu); Vt[(8 * dg + 2 * e + 1) * VS + c] = (bf16_t)(ww[e] >> 16); }
            if (ps >= 2 && wr_state) {
                float v[8]; unpack8(w, v);
                GAS float* o = (GAS float*)a.out + O_VP + ((size_t)(n * 128 + (c - 128)) * 2 + kv) * 64 + 8 * dg;
                *(GAS f32x4*)o = (f32x4){v[0], v[1], v[2], v[3]}; *(GAS f32x4*)(o + 4) = (f32x4){v[4], v[5], v[6], v[7]};
            }
        }
    }
    for (int i = tid; i < 64 * 24; i += 512) Vt[(i / 24) * VS + 256 + (i % 24)] = 0;
    __syncthreads();
#pragma unroll
    for (int hi = 0; hi < 4; ++hi) {
    const int h = h0 + hi;
    LAS bf16_t* Qs = Qs0 + (hi & 1) * QBUF;
    if (hi < 3) attn_write_q(Qs0 + ((hi + 1) & 1) * QBUF, R, hi + 1, tid);
    const bf16x8 bq0 = *(const LAS bf16x8*)(Qs + (16 * wid + fr) * QS + 8 * fq), bq1 = *(const LAS bf16x8*)(Qs + (16 * wid + fr) * QS + 32 + 8 * fq);
    f32x4 s[9], s2[9];
#pragma unroll
    for (int b = 0; b < 9; ++b) {
        const int kb = wid + b;
        const bf16x8 k0 = *(const LAS bf16x8*)(Ks + (16 * kb + fr) * QS + 8 * fq), k1 = *(const LAS bf16x8*)(Ks + (16 * kb + fr) * QS + 32 + 8 * fq);
        const f32x4 z = {0.f, 0.f, 0.f, 0.f};
        s[b] = __builtin_amdgcn_mfma_f32_16x16x32_bf16(k0, bq0, z, 0, 0, 0);
        s2[b] = __builtin_amdgcn_mfma_f32_16x16x32_bf16(k1, bq1, z, 0, 0, 0);
    }
    __builtin_amdgcn_sched_barrier(0);
    asm volatile("s_nop 7\n\ts_nop 7" ::: "memory");
#pragma unroll
    for (int b = 0; b < 9; ++b) { asm volatile("" : "+v"(s[b]), "+v"(s2[b])); s[b] = s[b] + s2[b]; }
    const float sink = ((const GAS float*)a.in[13])[h];
    const int qi = 16 * wid + fr;
    float mx = sink;
#pragma unroll
    for (int b = 0; b < 9; ++b)
#pragma unroll
        for (int e = 0; e < 4; ++e) {
            const int c = 16 * (wid + b) + 4 * fq + e;
            const bool ok = (c > qi) && (c <= qi + 128) && (j > 0 || c >= 128);
            s[b][e] = ok ? s[b][e] : -1e30f;
            mx = fmaxf(mx, s[b][e]);
        }
    mx = fmaxf(mx, __shfl_xor(mx, 16)); mx = fmaxf(mx, __shfl_xor(mx, 32));
    float sum = 0.f;
#pragma unroll
    for (int b = 0; b < 9; ++b)
#pragma unroll
        for (int e = 0; e < 4; ++e) { const float p = s[b][e] > -1e29f ? __expf(s[b][e] - mx) : 0.f; s[b][e] = p; sum += p; }
    sum += __shfl_xor(sum, 16); sum += __shfl_xor(sum, 32);
    const float inv = 1.f / (sum + __expf(sink - mx));
    f32x4 ot[5][4];
#pragma unroll
    for (int pi = 0; pi < 5; ++pi) {
        const int kb0 = wid + 2 * pi, kb1 = kb0 + 1;
        u32x4 pw; pw.x = cvt_pk_bf16(s[2 * pi][0], s[2 * pi][1]); pw.y = cvt_pk_bf16(s[2 * pi][2], s[2 * pi][3]);
        if (pi < 4) { pw.z = cvt_pk_bf16(s[2 * pi + 1 < 9 ? 2 * pi + 1 : 8][0], s[2 * pi + 1 < 9 ? 2 * pi + 1 : 8][1]); pw.w = cvt_pk_bf16(s[2 * pi + 1 < 9 ? 2 * pi + 1 : 8][2], s[2 * pi + 1 < 9 ? 2 * pi + 1 : 8][3]); }
        else { pw.z = 0u; pw.w = 0u; }
        const bf16x8 pb = __builtin_bit_cast(bf16x8, pw);
#pragma unroll
        for (int d = 0; d < 4; ++d) {
            const u32x2 lo = *(const LAS u32x2*)(Vt + (16 * d + fr) * VS + 16 * kb0 + 4 * fq), hi = *(const LAS u32x2*)(Vt + (16 * d + fr) * VS + 16 * kb1 + 4 * fq);
            const u32x4 vw = {lo.x, lo.y, hi.x, hi.y};
            const f32x4 zz = {0.f, 0.f, 0.f, 0.f};
            ot[pi][d] = __builtin_amdgcn_mfma_f32_16x16x32_bf16(__builtin_bit_cast(bf16x8, vw), pb, zz, 0, 0, 0);
        }
    }
    __builtin_amdgcn_sched_barrier(0);
    asm volatile("s_nop 7\n\ts_nop 7" ::: "memory");
    f32x4 o[4];
#pragma unroll
    for (int d = 0; d < 4; ++d) {
#pragma unroll
        for (int pi = 0; pi < 5; ++pi) asm volatile("" : "+v"(ot[pi][d]));
        o[d] = ((ot[0][d] + ot[1][d]) + (ot[2][d] + ot[3][d])) + ot[4][d];
    }
    GAS bf16_t* dst = (GAS bf16_t*)(a.ws + WS_AB) + (size_t)(n * SEQ + j * 128 + qi) * DM + h * 64 + 4 * fq;
#pragma unroll
    for (int d = 0; d < 4; ++d) { u32x2 w; w.x = cvt_pk_bf16(o[d][0] * inv, o[d][1] * inv); w.y = cvt_pk_bf16(o[d][2] * inv, o[d][3] * inv); *(GAS u32x2*)(dst + 16 * d) = w; }
    __syncthreads();
    }
}

__device__ __forceinline__ void attn_sample_unit(const Args& a, LAS unsigned char* lds, int b, int wid_in) {
    const int wid = wid_in, lane = fresh_lane(), tid = wid * 64 + lane;
    LAS float* qf = (LAS float*)lds;
    LAS float* kn = qf + 1024;
    LAS float* vn = kn + 128;
    LAS float* S = vn + 128;
    LAS float* KV = (LAS float*)(lds + 16384);
    constexpr int KS_ = 129;
    const GAS bf16_t* prow = (const GAS bf16_t*)(a.ws + WS_PROJ1) + (size_t)(MP + b) * P1C;
    const GAS float* rp = (const GAS float*)(a.ws + WS_ROPE) + (size_t)4096 * 64;
    const GAS float* sk = (const GAS float*)a.in[2] + (size_t)b * 128 * 128 + 128;
    const GAS float* sv = (const GAS float*)a.in[3] + (size_t)b * 128 * 128 + 128;
    GAS float* ok = (GAS float*)a.out + O_KS + (size_t)b * 16384;
    GAS float* ov = (GAS float*)a.out + O_VS + (size_t)b * 16384;
    f32x4 kreg[8], vreg[8];
#pragma unroll
    for (int q = 0; q < 8; ++q) { const int i4 = tid + 512 * q; const bool ok_ = i4 < 127 * 32; const int j4 = ok_ ? i4 : 0;
        kreg[q] = *(const GAS f32x4*)(sk + (size_t)j4 * 4); vreg[q] = *(const GAS f32x4*)(sv + (size_t)j4 * 4); }
    {
        const int h = tid >> 5, i = tid & 31; const float c = rp[2 * i], s = rp[2 * i + 1];
        const float x1 = bf1(prow[h * 64 + i]), x2 = bf1(prow[h * 64 + 32 + i]);
        qf[h * 64 + i] = (x1 * c - x2 * s) * 0.125f; qf[h * 64 + 32 + i] = (x2 * c + x1 * s) * 0.125f;
        if (tid < 64) { const float y1 = bf1(prow[C_K + h * 64 + i]), y2 = bf1(prow[C_K + h * 64 + 32 + i]); kn[h * 64 + i] = y1 * c - y2 * s; kn[h * 64 + 32 + i] = y2 * c + y1 * s; }
        if (tid < 128) vn[tid] = bf1(prow[C_V + tid]);
    }
#pragma unroll
    for (int q = 0; q < 8; ++q) { const int i4 = tid + 512 * q; if (i4 < 127 * 32) { const int i = i4 >> 5, c4 = (i4 & 31) * 4; LAS float* d = KV + i * KS_ + c4;
        d[0] = kreg[q].x; d[1] = kreg[q].y; d[2] = kreg[q].z; d[3] = kreg[q].w; *(GAS f32x4*)(ok + (size_t)i4 * 4) = kreg[q]; *(GAS f32x4*)(ov + (size_t)i4 * 4) = vreg[q]; } }
    __syncthreads();
    if (tid < 128) { KV[127 * KS_ + tid] = kn[tid]; ok[127 * 128 + tid] = kn[tid]; ov[127 * 128 + tid] = vn[tid]; }
    __syncthreads();
#pragma unroll
    for (int cc = 0; cc < 4; ++cc) {
        const int idx = tid + 512 * cc, h = idx >> 7, i = idx & 127, kv = h >> 3;
        float d = 0.f;
#pragma unroll 16
        for (int e = 0; e < 64; ++e) d += KV[i * KS_ + kv * 64 + e] * qf[h * 64 + e];
        S[h * 128 + i] = d;
    }
    __syncthreads();
#pragma unroll
    for (int hh = 0; hh < 2; ++hh) {
        const int h = wid * 2 + hh; const float sink = ((const GAS float*)a.in[13])[h];
        const float s0 = S[h * 128 + lane], s1 = S[h * 128 + 64 + lane];
        const float mx = fmaxf(wave_max(fmaxf(s0, s1)), sink);
        const float p0 = __expf(s0 - mx), p1 = __expf(s1 - mx);
        const float inv = 1.f / (wave_sum(p0 + p1) + __expf(sink - mx));
        S[h * 128 + lane] = p0 * inv; S[h * 128 + 64 + lane] = p1 * inv;
    }
#pragma unroll
    for (int q = 0; q < 8; ++q) { const int i4 = tid + 512 * q; if (i4 < 127 * 32) { const int i = i4 >> 5, c4 = (i4 & 31) * 4; LAS float* d = KV + i * KS_ + c4;
        d[0] = vreg[q].x; d[1] = vreg[q].y; d[2] = vreg[q].z; d[3] = vreg[q].w; } }
    if (tid < 128) KV[127 * KS_ + tid] = vn[tid];
    __syncthreads();
#pragma unroll
    for (int cc = 0; cc < 2; ++cc) {
        const int idx = tid + 512 * cc, h = idx >> 6, d = idx & 63, kv = h >> 3;
        float acc = 0.f;
#pragma unroll 16
        for (int i = 0; i < 128; ++i) acc += S[h * 128 + i] * KV[i * KS_ + kv * 64 + d];
        ((GAS bf16_t*)(a.ws + WS_AB))[(size_t)(MP + b) * DM + h * 64 + d] = (bf16_t)(cvt_pk_bf16(acc, 0.f) & 0xffffu);
    }
    __syncthreads();
}

__device__ __forceinline__ void convb_item(const Args& a, int item, int lane) {
    const int rb = item >> 1, c0 = (item & 1) * 512 + lane * 8, row0 = rb * 8;
    const GAS bf16_t* P1 = (const GAS bf16_t*)(a.ws + WS_PROJ1);
    const GAS float* cw = (const GAS float*)a.in[14] + c0;
    float w0[8], w1[8], w2[8];
    { const f32x4 a0 = *(const GAS f32x4*)cw, a1 = *(const GAS f32x4*)(cw + 4), b0 = *(const GAS f32x4*)(cw + CW), b1 = *(const GAS f32x4*)(cw + CW + 4), c0v = *(const GAS f32x4*)(cw + 2 * CW), c1v = *(const GAS f32x4*)(cw + 2 * CW + 4);
#pragma unroll
      for (int e = 0; e < 4; ++e) { w0[e] = a0[e]; w0[e + 4] = a1[e]; w1[e] = b0[e]; w1[e + 4] = b1[e]; w2[e] = c0v[e]; w2[e + 4] = c1v[e]; } }
    float p2[8], p1[8];
    const bool prompt = row0 < MP;
    const bool halo = prompt && (row0 & (SEQ - 1)) != 0;
    const int hr = halo ? row0 - 2 : row0;
    const u32x4 hx0 = *(const GAS u32x4*)(P1 + (size_t)hr * P1C + C_CC + c0), hy0 = *(const GAS u32x4*)(P1 + (size_t)hr * P1C + C_CU + c0);
    const u32x4 hx1 = *(const GAS u32x4*)(P1 + (size_t)(hr + 1) * P1C + C_CC + c0), hy1 = *(const GAS u32x4*)(P1 + (size_t)(hr + 1) * P1C + C_CU + c0);
    u32x4 vb[8], vc[8], vu[8];
#pragma unroll
    for (int r = 0; r < 8; ++r) { const GAS bf16_t* pr = P1 + (size_t)(row0 + r) * P1C + c0; vb[r] = NTL((const GAS u32x4*)(pr + C_CB)); vc[r] = NTL((const GAS u32x4*)(pr + C_CC)); vu[r] = NTL((const GAS u32x4*)(pr + C_CU)); }
    { float x[8], y[8]; unpack8(hx0, x); unpack8(hy0, y);
#pragma unroll
      for (int e = 0; e < 8; ++e) p2[e] = halo ? x[e] * y[e] : 0.f;
      unpack8(hx1, x); unpack8(hy1, y);
#pragma unroll
      for (int e = 0; e < 8; ++e) p1[e] = halo ? x[e] * y[e] : 0.f; }
#pragma unroll
    for (int r = 0; r < 8; ++r) {
        const int row = row0 + r;
        if (!prompt) {
            const GAS float* st = (const GAS float*)a.in[4] + (size_t)(row - MP) * 2 * CW + c0;
            const f32x4 s0 = *(const GAS f32x4*)st, s1 = *(const GAS f32x4*)(st + 4), s2 = *(const GAS f32x4*)(st + CW), s3 = *(const GAS f32x4*)(st + CW + 4);
#pragma unroll
            for (int e = 0; e < 4; ++e) { p2[e] = s0[e]; p2[e + 4] = s1[e]; p1[e] = s2[e]; p1[e + 4] = s3[e]; }
        }
        float cb[8], x[8], y[8], cx[8], ov[8];
        unpack8(vb[r], cb); unpack8(vc[r], x); unpack8(vu[r], y);
#pragma unroll
        for (int e = 0; e < 8; ++e) { cx[e] = x[e] * y[e]; ov[e] = cb[e] * (w0[e] * p2[e] + w1[e] * p1[e] + w2[e] * cx[e]); }
        *(GAS u32x4*)((GAS bf16_t*)(a.ws + WS_AB) + (size_t)row * DM + 1024 + c0) = pack8a(ov);
        GAS float* so = nullptr;
        if (prompt) { const int t = row & (SEQ - 1); if (t >= SEQ - 2) so = (GAS float*)a.out + O_CP + (size_t)((row >> 12) * 2 + (t - (SEQ - 2))) * CW + c0; }
        else so = (GAS float*)a.out + O_CS + (size_t)((row - MP) * 2 + 1) * CW + c0;
        if (so) { *(GAS f32x4*)so = (f32x4){cx[0], cx[1], cx[2], cx[3]}; *(GAS f32x4*)(so + 4) = (f32x4){cx[4], cx[5], cx[6], cx[7]}; }
#pragma unroll
        for (int e = 0; e < 8; ++e) { p2[e] = p1[e]; p1[e] = cx[e]; }
    }
}

template <bool FIRST>
__device__ __forceinline__ void resnorm_rows(const Args& a, int gw, int NGW, int lane) {
    f32x4 g1[8], g2[8];
    { const GAS f32x4* p1 = (const GAS f32x4*)a.in[FIRST ? 9 : 11] + lane; const GAS f32x4* p2 = (const GAS f32x4*)a.in[10] + lane;
#pragma unroll
      for (int j = 0; j < 8; ++j) { g1[j] = p1[64 * j]; g2[j] = FIRST ? p2[64 * j] : (f32x4){0.f, 0.f, 0.f, 0.f}; } }
    int m = gw; if (m >= MT) return;
    const GAS bf16_t* SRC = (const GAS bf16_t*)(a.ws + (FIRST ? WS_MO : WS_F));
    const GAS bf16_t* X1B = (const GAS bf16_t*)(a.ws + WS_X1B);
    f32x4 v[8], x[8];
    { const GAS u32x2* sr = (const GAS u32x2*)(SRC + (size_t)m * DM) + lane;
#pragma unroll
      for (int j = 0; j < 8; ++j) { const u32x2 w = NTL(sr + 64 * j); v[j] = (f32x4){bflo(w.x), bfhi(w.x), bflo(w.y), bfhi(w.y)}; }
      if (FIRST) { const GAS f32x4* xr = (const GAS f32x4*)x_row(a, m) + lane;
#pragma unroll
        for (int j = 0; j < 8; ++j) x[j] = NTL(xr + 64 * j); }
      else { const GAS u32x2* xr = (const GAS u32x2*)(X1B + (size_t)m * DM) + lane;
#pragma unroll
        for (int j = 0; j < 8; ++j) { const u32x2 w = NTL(xr + 64 * j); x[j] = (f32x4){bflo(w.x), bfhi(w.x), bflo(w.y), bfhi(w.y)}; } } }
    for (;;) {
        const int mn = m + NGW; const bool has = mn < MT; const int mp = has ? mn : m;
        u32x2 nw[8]; f32x4 nx[8]; u32x2 nxb[8];
        { const GAS u32x2* sr = (const GAS u32x2*)(SRC + (size_t)mp * DM) + lane;
#pragma unroll
          for (int j = 0; j < 8; ++j) nw[j] = NTL(sr + 64 * j);
          if (FIRST) { const GAS f32x4* xr = (const GAS f32x4*)x_row(a, mp) + lane;
#pragma unroll
            for (int j = 0; j < 8; ++j) nx[j] = NTL(xr + 64 * j); }
          else { const GAS u32x2* xr = (const GAS u32x2*)(X1B + (size_t)mp * DM) + lane;
#pragma unroll
            for (int j = 0; j < 8; ++j) nxb[j] = NTL(xr + 64 * j); } }
        float s = 0.f;
#pragma unroll
        for (int j = 0; j < 8; ++j) s += (v[j].x * v[j].x + v[j].y * v[j].y) + (v[j].z * v[j].z + v[j].w * v[j].w);
        const float rstd = 1.f / sqrtf(wave_sum(s) * (1.f / DM) + EPS);
        float s2 = 0.f;
        GAS u32x2* xo = (GAS u32x2*)((GAS bf16_t*)(a.ws + (FIRST ? WS_X1B : WS_H)) + (size_t)m * DM) + lane;
#pragma unroll
        for (int j = 0; j < 8; ++j) { v[j] = x[j] + v[j] * rstd * g1[j]; u32x2 w; w.x = cvt_pk_bf16(v[j].x, v[j].y); w.y = cvt_pk_bf16(v[j].z, v[j].w); xo[64 * j] = w;
            s2 += (v[j].x * v[j].x + v[j].y * v[j].y) + (v[j].z * v[j].z + v[j].w * v[j].w); }
        if (FIRST) {
            GAS u32x2* ho = (GAS u32x2*)((GAS bf16_t*)(a.ws + WS_H) + (size_t)m * DM) + lane;
            const float rstd2 = 1.f / sqrtf(wave_sum(s2) * (1.f / DM) + EPS);
#pragma unroll
            for (int j = 0; j < 8; ++j) { u32x2 w; w.x = cvt_pk_bf16(v[j].x * rstd2 * g2[j].x, v[j].y * rstd2 * g2[j].y); w.y = cvt_pk_bf16(v[j].z * rstd2 * g2[j].z, v[j].w * rstd2 * g2[j].w); ho[64 * j] = w; }
        }
        if (!has) break;
#pragma unroll
        for (int j = 0; j < 8; ++j) { v[j] = (f32x4){bflo(nw[j].x), bfhi(nw[j].x), bflo(nw[j].y), bfhi(nw[j].y)};
            x[j] = FIRST ? nx[j] : (f32x4){bflo(nxb[j].x), bfhi(nxb[j].x), bflo(nxb[j].y), bfhi(nxb[j].y)}; }
        m = mn;
    }
}

__device__ __forceinline__ void ffnfix_item(const Args& a, int item, int lane) {
    const int c0 = (item % 11) * 512 + lane * 8, q = item / 11;
    const GAS float* cw = (const GAS float*)a.in[20] + c0;
    const GAS float* cbp = (const GAS float*)a.in[21] + c0;
    float w0[8], w1[8], w2[8], bb[8];
    { const f32x4 a0 = *(const GAS f32x4*)cw, a1 = *(const GAS f32x4*)(cw + 4), b0 = *(const GAS f32x4*)(cw + DFF), b1 = *(const GAS f32x4*)(cw + DFF + 4), c0v = *(const GAS f32x4*)(cw + 2 * DFF), c1v = *(const GAS f32x4*)(cw + 2 * DFF + 4),
                  d0 = *(const GAS f32x4*)cbp, d1 = *(const GAS f32x4*)(cbp + 4);
#pragma unroll
      for (int e = 0; e < 4; ++e) { w0[e] = a0[e]; w0[e + 4] = a1[e]; w1[e] = b0[e]; w1[e + 4] = b1[e]; w2[e] = c0v[e]; w2[e + 4] = c1v[e]; bb[e] = d0[e]; bb[e + 4] = d1[e]; } }
    GAS bf16_t* FIN = (GAS bf16_t*)(a.ws + WS_FIN);
    float p2[8], p1[8], x0[8], x1[8], g0[8], g1[8], ov[8];
    if (q < 128) {
        const GAS bf16_t* SA = (const GAS bf16_t*)(a.ws + WS_SA); const GAS bf16_t* SG = (const GAS bf16_t*)(a.ws + WS_SG);
        const int r0 = q * 64; const bool halo = (r0 & (SEQ - 1)) != 0; const int qp = halo ? q - 1 : q;
        const u32x4 h0 = *(const GAS u32x4*)(SA + ((size_t)qp * 4 + 0) * DFF + c0), h1 = *(const GAS u32x4*)(SA + ((size_t)qp * 4 + 1) * DFF + c0);
        const u32x4 a0 = *(const GAS u32x4*)(SA + ((size_t)q * 4 + 2) * DFF + c0), a1 = *(const GAS u32x4*)(SA + ((size_t)q * 4 + 3) * DFF + c0);
        const u32x4 gg0 = *(const GAS u32x4*)(SG + ((size_t)q * 2 + 0) * DFF + c0), gg1 = *(const GAS u32x4*)(SG + ((size_t)q * 2 + 1) * DFF + c0);
        unpack8(h0, p2); unpack8(h1, p1); unpack8(a0, x0); unpack8(a1, x1); unpack8(gg0, g0); unpack8(gg1, g1);
#pragma unroll
        for (int e = 0; e < 8; ++e) { p2[e] = halo ? p2[e] : 0.f; p1[e] = halo ? p1[e] : 0.f; }
#pragma unroll
        for (int e = 0; e < 8; ++e) ov[e] = gelu_tanh(w0[e] * p2[e] + w1[e] * p1[e] + w2[e] * x0[e] + bb[e]) * g0[e];
        *(GAS u32x4*)(FIN + (size_t)r0 * DFF + c0) = pack8a(ov);
#pragma unroll
        for (int e = 0; e < 8; ++e) ov[e] = gelu_tanh(w0[e] * p1[e] + w1[e] * x0[e] + w2[e] * x1[e] + bb[e]) * g1[e];
        *(GAS u32x4*)(FIN + (size_t)(r0 + 1) * DFF + c0) = pack8a(ov);
    } else {
        const int b = q - 128;
        const GAS float* st = (const GAS float*)a.in[5] + (size_t)b * 2 * DFF + c0;
        const f32x4 s0 = *(const GAS f32x4*)st, s1 = *(const GAS f32x4*)(st + 4), s2 = *(const GAS f32x4*)(st + DFF), s3 = *(const GAS f32x4*)(st + DFF + 4);
        const u32x4 a0 = *(const GAS u32x4*)((const GAS bf16_t*)(a.ws + WS_UAS) + (size_t)b * DFF + c0), gg0 = *(const GAS u32x4*)((const GAS bf16_t*)(a.ws + WS_UGS) + (size_t)b * DFF + c0);
        unpack8(a0, x0); unpack8(gg0, g0);
#pragma unroll
        for (int e = 0; e < 4; ++e) { p2[e] = s0[e]; p2[e + 4] = s1[e]; p1[e] = s2[e]; p1[e + 4] = s3[e]; }
#pragma unroll
        for (int e = 0; e < 8; ++e) ov[e] = gelu_tanh(w0[e] * p2[e] + w1[e] * p1[e] + w2[e] * x0[e] + bb[e]) * g0[e];
        *(GAS u32x4*)(FIN + (size_t)(MP + b) * DFF + c0) = pack8a(ov);
    }
}

#define XB_TMO      128
#define XB_XCNT(j)  (256  + 64 * (j))
#define XB_XSUB(j)  (1280 + 64 * (j))
#define XB_XGEN(j)  (2304 + 64 * (j))
#define XB_TOP      3328
#define XB_TOPGEN   3392
#define XCD_BAR_WORDS 3456
#define XB_SPIN_CAP (1u << 18)
__device__ __forceinline__ unsigned xb_ld(unsigned* p)              { return __hip_atomic_load(p, __ATOMIC_RELAXED, __HIP_MEMORY_SCOPE_AGENT); }
__device__ __forceinline__ unsigned xb_add(unsigned* p, unsigned v) { return __hip_atomic_fetch_add(p, v, __ATOMIC_RELAXED, __HIP_MEMORY_SCOPE_AGENT); }
__device__ __forceinline__ unsigned xb_xcc_id() { return (unsigned)__builtin_amdgcn_s_getreg((3 << 11) | 20) & 0xFu; }
#define XB_SPIN(cond, bar) do { unsigned _sp = 0; while (cond) { __builtin_amdgcn_s_sleep(1); \
    if ((++_sp & 255u) == 0u) { if (xb_ld(&(bar)[XB_TMO])) break; if (_sp > XB_SPIN_CAP) { atomicAdd(&(bar)[XB_TMO], 1u); break; } } } } while (0)
__device__ __forceinline__ void xcd_barrier_complete(unsigned* bar, unsigned x, unsigned G, unsigned& nloc, unsigned& nx) {
    unsigned sum, cnt, mine, sp = 0u;
    for (;;) {
        sum = 0u; cnt = 0u; mine = 0u;
#pragma unroll
        for (unsigned j = 0; j < 16; ++j) { const unsigned c = xb_ld(&bar[XB_XCNT(j)]); sum += c; cnt += (c > 0u) ? 1u : 0u; mine = (j == x) ? c : mine; }
        if (sum == G) break;
        __builtin_amdgcn_s_sleep(1);
        if ((++sp & 255u) == 0u) { if (xb_ld(&bar[XB_TMO])) break; if (sp > XB_SPIN_CAP) { atomicAdd(&bar[XB_TMO], 1u); break; } }
    }
    nloc = mine > 0u ? mine : 1u; nx = cnt > 0u ? cnt : 1u;
}
__device__ __forceinline__ void grid_barrier(unsigned* bar, volatile LAS unsigned* st, unsigned G, int wid_in) {
    asm volatile("s_waitcnt vmcnt(0)" ::: "memory");
    __syncthreads();
    if (wid_in == 0 && fresh_lane() == 0) {
        __builtin_amdgcn_s_waitcnt(0);
        const unsigned x = xb_xcc_id();
        unsigned nloc = st[0], nx = st[1];
        if (nloc == 0u) { xcd_barrier_complete(bar, x, G, nloc, nx); st[0] = nloc; st[1] = nx; }
        const unsigned old = xb_add(&bar[XB_XSUB(x)], 1u);
        const unsigned gen = old / nloc;
        if (old + 1u == (gen + 1u) * nloc) {
            __builtin_amdgcn_fence(__ATOMIC_RELEASE, "agent");
            asm volatile("s_waitcnt vmcnt(0)" ::: "memory");
            const unsigned og = xb_add(&bar[XB_TOP], 1u);
            const unsigned tg = og / nx;
            if (og + 1u == (tg + 1u) * nx) xb_add(&bar[XB_TOPGEN], 1u);
            else XB_SPIN(xb_ld(&bar[XB_TOPGEN]) == tg, bar);
            __builtin_amdgcn_fence(__ATOMIC_ACQUIRE, "agent");
            xb_add(&bar[XB_XGEN(x)], 1u);
            asm volatile("s_waitcnt vmcnt(0)" ::: "memory");
        } else {
            XB_SPIN(xb_ld(&bar[XB_XGEN(x)]) == gen, bar);
            __builtin_amdgcn_fence(__ATOMIC_ACQUIRE, "agent");
            asm volatile("s_waitcnt vmcnt(0)" ::: "memory");
        }
    }
    __syncthreads();
}

template <int MODE, int N, int K>
__device__ __forceinline__ void gemm_job(LAS unsigned char* lds, const Args& a, size_t offA, size_t offB, int G, int bid, int wid) {
    const bf16_t* A = (const bf16_t*)(a.ws + offA); const bf16_t* Bt = (const bf16_t*)(a.ws + offB);
    pg8::gemm_phase<MODE, N, K>(lds, a, A, Bt, G, bid, wid);
    skinny_gemm<MODE, N, K>(lds, a, A + (size_t)MP * K, Bt, G, bid, wid);
}

__global__ void __launch_bounds__(512, 2) hybrid_fwd(Args a) {
    __shared__ __attribute__((aligned(16))) unsigned char lds_raw[LDS_BYTES];
    LAS unsigned char* lds = (LAS unsigned char*)lds_raw;
    const int wid = __builtin_amdgcn_readfirstlane((int)threadIdx.x >> 6);
    const int G = gridDim.x, bid = blockIdx.x, gw = bid * 8 + wid, NGW = G * 8;
    const int lo = a.ph_lo, hi = a.ph_hi;
    if (lo > 1000) { __threadfence(); cg::this_grid().sync(); }
    if (hi - lo > 1) {
        if (wid == 0) { const int l = fresh_lane(); if (l < 2) ((volatile LAS unsigned*)(lds + 131072))[l] = 0u; if (l == 0) (void)xb_add((unsigned*)a.ws + XB_XCNT(xb_xcc_id()), 1u); }
        __syncthreads();
    }
#define IN(k) (lo <= (k) && (k) < hi)
#define SEAM(k) do { if (IN(k) && IN((k) + 1)) grid_barrier((unsigned*)a.ws, (volatile LAS unsigned*)(lds + 131072), (unsigned)G, wid); } while (0)
#ifdef PROBE_PHASE
    if (IN(100)) {
        const int gtid = bid * 512 + wid * 64 + fresh_lane(), GT = G * 512;
        const GAS bf16_t* b16 = (const GAS bf16_t*)(a.ws + 4 * MiB); const size_t n = (size_t)(341 * MiB / 2), NOUT = 16842752;
        for (size_t i = gtid; i < NOUT; i += GT) { float acc = 0.f; for (size_t k = i; k < n; k += NOUT) acc += bf1(b16[k]); ((GAS float*)a.out)[i] = acc; }
    }
#endif
    if (IN(0)) p0_prologue(a, lds, bid, G, wid);
    SEAM(0);
    if (IN(1)) {
        gemm_job<1, INC, 2048>(lds, a, WS_H, WS_WIN, G, bid, wid);
        constexpr int NFULL = (MP / 256) * (INC / 256) % 256;
        const int first = (G == 256) ? NFULL : 0;
        if (bid >= first) late_weights<1>(a, lds, (bid - first) * 8 + wid, (G - first) * 8, wid);
    }
    SEAM(1);
    if (IN(2)) {
#ifndef SKIP_PA
        for (int u = bid; u < 256; u += G) attn_prompt_unit(a, lds, u, wid);
#endif
        if (bid >= G - MS) attn_sample_unit(a, lds, G - 1 - bid, wid);
        for (int it = gw; it < (MT / 8) * 2; it += NGW) convb_item(a, it, fresh_lane());
    }
    SEAM(2);
    if (IN(3)) gemm_job<3, 2048, 2048>(lds, a, WS_AB, WS_WM, G, bid, wid);
    SEAM(3);
    if (IN(4)) gemm_job<4, 2048, 2048>(lds, a, WS_MERGED, WS_WO, G, bid, wid);
    SEAM(4);
    if (IN(5)) resnorm_rows<true>(a, gw, NGW, fresh_lane());
    SEAM(5);
    if (IN(6)) {
        gemm_job<6, 2 * DFF, 2048>(lds, a, WS_H, WS_WUP, G, bid, wid);
        constexpr int NFULL = (MP / 256) * (2 * DFF / 256) % 256;
        const int first = (G == 256) ? NFULL : 0;
        if (bid >= first) {
            late_weights<2>(a, lds, (bid - first) * 8 + wid, (G - first) * 8, wid);
            __syncthreads();
            gemm_job<9, 2048, PLE>(lds, a, WS_PB, WS_WP, G - first, bid - first, wid);
        }
    }
    SEAM(6);
    if (IN(7)) { for (int it = gw; it < (128 + MS) * 11; it += NGW) ffnfix_item(a, it, fresh_lane()); }
    SEAM(7);
    if (IN(8)) gemm_job<8, 2048, DFF>(lds, a, WS_FIN, WS_WDN, G, bid, wid);
    SEAM(8);
    if (IN(9)) resnorm_rows<false>(a, gw, NGW, fresh_lane());
    SEAM(9);
    if (IN(10)) gemm_job<10, 2048, 2048>(lds, a, WS_H, WS_WG, G, bid, wid);
#undef IN
#undef SEAM
}

extern "C" void kernel_launch(void* const* d_in, const int* in_sizes, int n_in, void* d_out, int out_size, void* d_ws, size_t ws_size, hipStream_t stream) {
    static int grid = 0;
    if (grid == 0) {
        if (n_in != 25 || ws_size < WS_END) { fprintf(stderr, "kernel_launch: unexpected n_in %d / ws_size %zu\n", n_in, ws_size); grid = -1; return; }
        int dev = 0, cus = 0, per_cu = 0;
        if (hipGetDevice(&dev) != hipSuccess || hipDeviceGetAttribute(&cus, hipDeviceAttributeMultiprocessorCount, dev) != hipSuccess) { grid = -1; return; }
        if (hipOccupancyMaxActiveBlocksPerMultiprocessor(&per_cu, (const void*)hybrid_fwd, 512, 0) != hipSuccess || per_cu < 1) { fprintf(stderr, "kernel_launch: occupancy query says %d\n", per_cu); per_cu = 1; }
        (void)hipGetLastError();
        grid = cus;
    }
    if (grid < 0) return;
    if (hipMemsetAsync(d_ws, 0, 16384, stream) != hipSuccess) { fprintf(stderr, "kernel_launch: memset failed\n"); return; }
    Args a{};
    for (int i = 0; i < 25; ++i) a.in[i] = (const float*)d_in[i];
    a.out = (float*)d_out; a.ws = (unsigned char*)d_ws;
#if MK_N_LAUNCHES == 1
    a.ph_lo = 0; a.ph_hi = NPHASE;
    void* kargs[] = {&a};
    hipError_t e = hipLaunchCooperativeKernel((const void*)hybrid_fwd, dim3(grid), dim3(512), kargs, 0, stream);
    if (e != hipSuccess) fprintf(stderr, "cooperative launch failed: %s (grid %d)\n", hipGetErrorString(e), grid);
#else
#ifdef PROBE_PHASE
    for (int ph = 0; ph <= PROBE_PHASE; ++ph) { a.ph_lo = ph; a.ph_hi = ph + 1; hipLaunchKernelGGL(hybrid_fwd, dim3(grid), dim3(512), 0, stream, a); }
    a.ph_lo = 100; a.ph_hi = 101; hipLaunchKernelGGL(hybrid_fwd, dim3(grid), dim3(512), 0, stream, a);
#else
    for (int ph = 0; ph < NPHASE; ++ph) {
        a.ph_lo = ph; a.ph_hi = ph + 1;
        for (int rep = 0; rep < 1 + ((REPMASK >> ph) & 1); ++rep)
            hipLaunchKernelGGL(hybrid_fwd, dim3(grid), dim3(512), 0, stream, a);
    }
#endif
#endif
}
```
